# Optimizing an MI355X kernel written in HIP

```python
import jax, jax.numpy as jnp
from jax import lax
import numpy as np

D_MODEL = 1024
BATCH = 8
SEQ = 4096
DEPTH = 2

N_MIXERS = 2
N_A_LAYERS = (DEPTH + 1) // 2
N_B_LAYERS = DEPTH // 2
CONV_W = 3
A_GROUPS = 16
CHUNK = 128
D_INNER = D_MODEL
B_HEADS = 8
B_HEAD_DIM = D_INNER // B_HEADS
N_GROUPS = 4
EXPERTS_PER_GROUP = 8
N_EXPERTS = N_GROUPS * EXPERTS_PER_GROUP
TOP_K = 2
D_EXPERT = 512
ROUTE_BLOCK = 128
EPS = 1e-6

kernel_name = "hybrid_shortconv_chunkgmlp_hiermoe"


def rmsnorm(x, g):
    xf = x.astype(jnp.float32)
    y = xf * lax.rsqrt(jnp.mean(xf * xf, axis=-1, keepdims=True) + EPS)
    return (y * g.astype(jnp.float32)).astype(x.dtype)


def layernorm(x, g, b):
    xf = x.astype(jnp.float32)
    mu = jnp.mean(xf, axis=-1, keepdims=True)
    var = jnp.mean(jnp.square(xf - mu), axis=-1, keepdims=True)
    y = (xf - mu) * lax.rsqrt(var + EPS)
    return (y * g.astype(jnp.float32) + b.astype(jnp.float32)).astype(x.dtype)


def short_conv_mixer(x, w_in, conv_w, w_out):
    d = x.shape[-1]
    proj = x @ w_in
    b_gate, c_gate, h = proj[..., :d], proj[..., d:2 * d], proj[..., 2 * d:]
    z = c_gate * h
    zp = jnp.pad(z, ((0, 0), (CONV_W - 1, 0), (0, 0)))
    s = z.shape[1]
    conv = sum(conv_w[k] * zp[:, k:k + s] for k in range(CONV_W))
    return (b_gate * conv) @ w_out


def chunk_sgu_mixer(x, w_in, b_in, v_g, v_b, w_s, b_s, w_out):
    bsz, s, _ = x.shape
    z = jax.nn.gelu(x @ w_in + b_in)
    u, v = z[..., :D_INNER], z[..., D_INNER:]
    v = layernorm(v, v_g, v_b)
    n_chunks = s // CHUNK
    v = v.reshape(bsz, n_chunks, CHUNK, B_HEADS, B_HEAD_DIM)
    causal = jnp.tril(jnp.ones((CHUNK, CHUNK), dtype=w_s.dtype))
    mixed = jnp.einsum('hts,bcshd->bcthd', w_s * causal, v)
    mixed = mixed + b_s.T[None, None, :, :, None]
    mixed = mixed.reshape(bsz, s, D_INNER)
    return (u * mixed) @ w_out


def hier_moe(x, w_group, b_group, w_expert, b_expert, w_gate, w_up, w_down):
    bsz, s, d = x.shape
    xt = x.reshape(-1, d)
    t = xt.shape[0]
    g_probs = jax.nn.softmax((xt @ w_group + b_group).astype(jnp.float32), axis=-1)
    g_idx = jnp.argmax(g_probs, axis=-1)
    g_p = jnp.take_along_axis(g_probs, g_idx[:, None], axis=1)[:, 0]
    e_logits = (xt @ w_expert + b_expert).astype(jnp.float32).reshape(t, N_GROUPS, EXPERTS_PER_GROUP)
    e_logits = jnp.take_along_axis(e_logits, g_idx[:, None, None], axis=1)[:, 0]
    e_probs = jax.nn.softmax(e_logits, axis=-1)
    top_p, top_i = lax.top_k(e_probs, TOP_K)
    gates = g_p[:, None] * top_p / jnp.sum(top_p, axis=-1, keepdims=True)
    expert_id = (g_idx[:, None] * EXPERTS_PER_GROUP + top_i).reshape(-1)
    flat_tok = jnp.repeat(jnp.arange(t, dtype=jnp.int32), TOP_K)
    flat_gate = gates.reshape(-1)
    n_assign = t * TOP_K
    order = jnp.argsort(expert_id, stable=True)
    se = expert_id[order]
    counts = jnp.bincount(expert_id, length=N_EXPERTS)
    padded = ((counts + ROUTE_BLOCK - 1) // ROUTE_BLOCK) * ROUTE_BLOCK
    pad_end = jnp.cumsum(padded)
    pad_start = pad_end - padded
    start = jnp.cumsum(counts) - counts
    slot = pad_start[se] + jnp.arange(n_assign) - start[se]
    n_slots = n_assign + N_EXPERTS * ROUTE_BLOCK
    n_blocks = n_slots // ROUTE_BLOCK
    slot_tok = jnp.zeros((n_slots,), jnp.int32).at[slot].set(flat_tok[order])
    slot_gate = jnp.zeros((n_slots,), x.dtype).at[slot].set(flat_gate[order].astype(x.dtype))
    block_e = jnp.minimum(
        jnp.searchsorted(pad_end, jnp.arange(n_blocks) * ROUTE_BLOCK, side='right'), N_EXPERTS - 1)
    xs = xt[slot_tok].reshape(n_blocks, ROUTE_BLOCK, d)

    def expert_block(args):
        xb, e = args
        h = jax.nn.silu(xb @ w_gate[e]) * (xb @ w_up[e])
        return h @ w_down[e]

    ys = lax.map(expert_block, (xs, block_e)).reshape(n_slots, d)
    y = jnp.zeros((t, d), x.dtype).at[slot_tok].add(ys * slot_gate[:, None])
    return y.reshape(bsz, s, d)


def setup_inputs(seed: int = 0) -> dict:
    key = jax.random.key(seed)
    ks = jax.random.split(key, 24)
    f32 = jnp.float32
    D, F, E, G = D_MODEL, D_EXPERT, N_EXPERTS, N_GROUPS

    def nrm(k, shape, scale):
        return jax.random.normal(k, shape, f32) * scale

    return {
        "x": jax.random.normal(ks[0], (BATCH, SEQ, D), f32),
        "ln_a": 1.0 + nrm(ks[1], (N_A_LAYERS, D), 0.02),
        "w_in_a": nrm(ks[2], (N_A_LAYERS, D, 3 * D), D ** -0.5),
        "conv_w_a": nrm(ks[3], (N_A_LAYERS, CONV_W, D), CONV_W ** -0.5),
        "w_out_a": nrm(ks[4], (N_A_LAYERS, D, D), D ** -0.5),
        "ln_b": 1.0 + nrm(ks[5], (N_B_LAYERS, D), 0.02),
        "w_in_b": nrm(ks[6], (N_B_LAYERS, D, 2 * D_INNER), D ** -0.5),
        "b_in_b": nrm(ks[7], (N_B_LAYERS, 2 * D_INNER), 0.02),
        "v_ln_g": 1.0 + nrm(ks[8], (N_B_LAYERS, D_INNER), 0.02),
        "v_ln_b": nrm(ks[9], (N_B_LAYERS, D_INNER), 0.02),
        "w_s": nrm(ks[10], (N_B_LAYERS, B_HEADS, CHUNK, CHUNK), CHUNK ** -0.5),
        "b_s": 1.0 + nrm(ks[11], (N_B_LAYERS, B_HEADS, CHUNK), 0.02),
        "w_out_b": nrm(ks[12], (N_B_LAYERS, D_INNER, D), D_INNER ** -0.5),
        "ln2": 1.0 + nrm(ks[13], (DEPTH, D), 0.02),
        "w_group": nrm(ks[14], (DEPTH, D, G), D ** -0.5),
        "b_group": nrm(ks[15], (DEPTH, G), 0.01),
        "w_expert": nrm(ks[16], (DEPTH, D, E), D ** -0.5),
        "b_expert": nrm(ks[17], (DEPTH, E), 0.01),
        "w_gate": nrm(ks[18], (DEPTH, E, D, F), D ** -0.5),
        "w_up": nrm(ks[19], (DEPTH, E, D, F), D ** -0.5),
        "w_down": nrm(ks[20], (DEPTH, E, F, D), F ** -0.5),
        "ln_f": 1.0 + nrm(ks[21], (D,), 0.02),
    }


def reference(x, ln_a, w_in_a, conv_w_a, w_out_a, ln_b, w_in_b, b_in_b, v_ln_g, v_ln_b,
              w_s, b_s, w_out_b, ln2, w_group, b_group, w_expert, b_expert,
              w_gate, w_up, w_down, ln_f):
    for i in range(DEPTH):
        j = i // N_MIXERS
        if i % N_MIXERS == 0:
            x = x + short_conv_mixer(rmsnorm(x, ln_a[j]), w_in_a[j], conv_w_a[j], w_out_a[j])
        else:
            x = x + chunk_sgu_mixer(rmsnorm(x, ln_b[j]), w_in_b[j], b_in_b[j], v_ln_g[j],
                                    v_ln_b[j], w_s[j], b_s[j], w_out_b[j])
        x = x + hier_moe(rmsnorm(x, ln2[i]), w_group[i], b_group[i], w_expert[i], b_expert[i],
                         w_gate[i], w_up[i], w_down[i])
    return rmsnorm(x, ln_f)
```

```cpp
#include <hip/hip_runtime.h>
#include <cstdint>
#include <cstdio>

namespace {
#define LAS __attribute__((address_space(3)))
typedef unsigned short bf16_t;
typedef short bf16x8 __attribute__((ext_vector_type(8)));
typedef float f32x4 __attribute__((ext_vector_type(4)));
typedef unsigned u32x4 __attribute__((ext_vector_type(4)));
typedef unsigned u32x2 __attribute__((ext_vector_type(2)));

constexpr int BATCH = 8, SEQ = 4096, D = 1024, T = BATCH * SEQ;
constexpr int NE = 32, NG = 4, EPG = 8, F = 512, CHUNK = 128, NH = 8;
constexpr float EPS = 1e-6f;
constexpr int NASSIGN = 2 * T;

constexpr size_t MiB = 1u << 20;
constexpr size_t WS_CTL = 0;
constexpr size_t CTL_BYTES = 65536;
constexpr size_t WS_RS = 1 * MiB;
constexpr size_t WS_ASG = 2 * MiB;
constexpr size_t WS_LNS = 3 * MiB;
constexpr size_t WS_LTOK = 4 * MiB;
constexpr size_t WS_LGATE = 8 * MiB;
constexpr size_t WS_WR = 12 * MiB;
constexpr size_t WS_WM = 13 * MiB;
constexpr size_t WS_WA_IN = 16 * MiB;
constexpr size_t WS_WA_OUT = 22 * MiB;
constexpr size_t WS_WB_IN = 24 * MiB;
constexpr size_t WS_WB_OUT = 28 * MiB;
constexpr size_t WS_WGU = 32 * MiB;
constexpr size_t WS_WD = 96 * MiB;
constexpr size_t WS_A = 128 * MiB;
constexpr size_t WS_B = 256 * MiB;
constexpr size_t WS_C = 320 * MiB;
constexpr size_t WS_D = 384 * MiB;
constexpr size_t WS_END = 449 * MiB;
constexpr int CW_CNT = 0;

__device__ __forceinline__ float bf2f(unsigned b) { return __uint_as_float(b << 16); }
__device__ __forceinline__ unsigned f2bf(float f) { unsigned u = __float_as_uint(f); return (u + 0x7fffu + ((u >> 16) & 1u)) >> 16; }
__device__ __forceinline__ unsigned pk2(float lo, float hi) { return f2bf(lo) | (f2bf(hi) << 16); }
__device__ __forceinline__ float wave_sum(float v) {
#pragma unroll
    for (int o = 1; o < 64; o <<= 1) v += __shfl_xor(v, o);
    return v;
}
__device__ __forceinline__ void unpack8(const u32x4 v, float (&f)[8]) {
    f[0] = bf2f(v.x & 0xffffu); f[1] = bf2f(v.x >> 16); f[2] = bf2f(v.y & 0xffffu); f[3] = bf2f(v.y >> 16);
    f[4] = bf2f(v.z & 0xffffu); f[5] = bf2f(v.z >> 16); f[6] = bf2f(v.w & 0xffffu); f[7] = bf2f(v.w >> 16);
}
__device__ __forceinline__ u32x4 pack8(const float (&f)[8]) {
    u32x4 o; o.x = pk2(f[0], f[1]); o.y = pk2(f[2], f[3]); o.z = pk2(f[4], f[5]); o.w = pk2(f[6], f[7]); return o;
}
__device__ __forceinline__ float gelu_tanh(float x) {
    const float u = 0.7978845608028654f * (x + 0.044715f * x * x * x);
    const float e = __expf(2.0f * u);
    const float th = 1.0f - 2.0f / (e + 1.0f);
    return 0.5f * x * (1.0f + th);
}
__device__ __forceinline__ float silu(float x) { return x / (1.0f + __expf(-x)); }

__global__ void __launch_bounds__(256) k_prep_x(const float* __restrict__ x, const float* __restrict__ g, bf16_t* __restrict__ xn) {
    const int lane = threadIdx.x & 63, gw = (blockIdx.x * 256 + threadIdx.x) >> 6, ngw = (gridDim.x * 256) >> 6;
    for (int row = gw; row < T; row += ngw) {
        const f32x4* xr = (const f32x4*)(x + (size_t)row * D) + lane;
        f32x4 v[4]; float s = 0.f;
#pragma unroll
        for (int j = 0; j < 4; ++j) { v[j] = xr[64 * j]; s += (v[j].x * v[j].x + v[j].y * v[j].y) + (v[j].z * v[j].z + v[j].w * v[j].w); }
        const float r = rsqrtf(wave_sum(s) * (1.0f / D) + EPS);
        u32x2* o = (u32x2*)(xn + (size_t)row * D) + lane;
#pragma unroll
        for (int j = 0; j < 4; ++j) { const f32x4 gv = ((const f32x4*)g)[lane + 64 * j];
            u32x2 w; w.x = pk2(v[j].x * r * gv.x, v[j].y * r * gv.y); w.y = pk2(v[j].z * r * gv.z, v[j].w * r * gv.w); o[64 * j] = w; }
    }
}

__device__ __forceinline__ int map_row(int mapkind, int n) {
    if (mapkind == 0) return n;
    if (mapkind == 1) { if (n < D) return 2 * D + n; const int ch = (n - D) & (D - 1), second = (n >= 2 * D); return 256 * (ch >> 7) + 128 * second + (ch & 127); }
    return 256 * (n >> 7) + (mapkind == 3 ? 128 : 0) + (n & 127);
}
struct TrJob { const float* src; bf16_t* dst; const float* kscale; int K, N, mapkind, pad; size_t src_bstride, dst_bstride; };
__global__ void __launch_bounds__(256) k_transpose(TrJob j) {
    __shared__ float tile[64][65];
    const int nblk = j.N / 64, kb = blockIdx.x / nblk, nb = blockIdx.x % nblk, k0 = kb * 64, n0 = nb * 64;
    const float* src = j.src + (size_t)blockIdx.y * j.src_bstride; bf16_t* dst = j.dst + (size_t)blockIdx.y * j.dst_bstride;
    const int tid = threadIdx.x;
#pragma unroll
    for (int i = 0; i < 16; ++i) { const int kk = i * 4 + (tid >> 6), nn = tid & 63; float v = src[(size_t)(k0 + kk) * j.N + n0 + nn]; if (j.kscale) v *= j.kscale[k0 + kk]; tile[kk][nn] = v; }
    __syncthreads();
#pragma unroll
    for (int p = 0; p < 2; ++p) { const int nn = (tid >> 3) + 32 * p, kc = tid & 7;
        u32x4 o; o.x = pk2(tile[kc * 8 + 0][nn], tile[kc * 8 + 1][nn]); o.y = pk2(tile[kc * 8 + 2][nn], tile[kc * 8 + 3][nn]);
        o.z = pk2(tile[kc * 8 + 4][nn], tile[kc * 8 + 5][nn]); o.w = pk2(tile[kc * 8 + 6][nn], tile[kc * 8 + 7][nn]);
        *(u32x4*)(dst + (size_t)map_row(j.mapkind, n0 + nn) * j.K + k0 + kc * 8) = o; }
}
__global__ void k_prep_router(const float* __restrict__ ln2, const float* __restrict__ wg, const float* __restrict__ we, float* __restrict__ wr) {
    const int i = blockIdx.x * blockDim.x + threadIdx.x; if (i >= 2 * 36 * D) return;
    const int l = i / (36 * D), j = (i / D) % 36, k = i % D;
    const float w = j < 4 ? wg[((size_t)l * D + k) * NG + j] : we[((size_t)l * D + k) * NE + (j - 4)];
    wr[i] = w * ln2[l * D + k];
}
__global__ void k_prep_wm(const float* __restrict__ ws, bf16_t* __restrict__ wm) {
    const int i = blockIdx.x * blockDim.x + threadIdx.x; if (i >= NH * CHUNK * CHUNK) return;
    const int t = (i / CHUNK) % CHUNK, s = i % CHUNK;
    wm[i] = (bf16_t)f2bf(t >= s ? ws[i] : 0.f);
}

constexpr int G1_BM = 128, G1_BK = 32;
template <class P> __global__ void __launch_bounds__(256, 2) k_gemm128(P p) {
    __shared__ __attribute__((aligned(16))) unsigned char shm[2 * G1_BM * G1_BK * 2];
    typename P::Ctx c;
    if (!p.setup(blockIdx.x, c)) return;
    const int tid = threadIdx.x, wid = tid >> 6, lane = tid & 63, wr = wid >> 1, wc = wid & 1, fr = lane & 15, fq = lane >> 4;
    const bf16_t* ap[2]; const bf16_t* bp[2];
#pragma unroll
    for (int i = 0; i < 2; ++i) { const int r = (tid >> 2) + 64 * i, cc = (tid & 3) * 8; ap[i] = p.arow(c, r) + cc; bp[i] = p.brow(c, r) + cc; }
    LAS unsigned char* SA = (LAS unsigned char*)shm; LAS unsigned char* SB = SA + G1_BM * G1_BK * 2;
    f32x4 acc[4][4];
#pragma unroll
    for (int m = 0; m < 4; ++m)
#pragma unroll
        for (int n = 0; n < 4; ++n) acc[m][n] = (f32x4){0.f, 0.f, 0.f, 0.f};
    const int K = p.K;
    for (int t = 0; t < K / G1_BK; ++t) {
#pragma unroll
        for (int i = 0; i < 2; ++i) {
            __builtin_amdgcn_global_load_lds((const unsigned*)(ap[i] + t * G1_BK), (LAS unsigned*)(SA + tid * 16 + i * 4096), 16, 0, 0);
            __builtin_amdgcn_global_load_lds((const unsigned*)(bp[i] + t * G1_BK), (LAS unsigned*)(SB + tid * 16 + i * 4096), 16, 0, 0);
        }
        asm volatile("s_waitcnt vmcnt(0)" ::: "memory"); __syncthreads();
        bf16x8 At[4], Bt[4];
#pragma unroll
        for (int m = 0; m < 4; ++m) { At[m] = *(const LAS bf16x8*)(SA + (wr * 64 + m * 16 + fr) * 64 + fq * 16); Bt[m] = *(const LAS bf16x8*)(SB + (wc * 64 + m * 16 + fr) * 64 + fq * 16); }
#pragma unroll
        for (int m = 0; m < 4; ++m)
#pragma unroll
            for (int n = 0; n < 4; ++n) acc[m][n] = __builtin_amdgcn_mfma_f32_16x16x32_bf16(At[m], Bt[n], acc[m][n], 0, 0, 0);
        __syncthreads();
    }
    p.epi(c, acc, wr, wc, fr, fq);
}
__device__ __forceinline__ int paired_brow(int cb, int jj) { const int pn = cb >> 1, q = cb & 1, w = jj >> 6, n = (jj >> 4) & 3, f = jj & 15; return 256 * pn + ((n >> 1) ? 128 : 0) + 64 * q + 32 * w + (n & 1) * 16 + f; }
__device__ __forceinline__ int paired_ch(int cb, int wc, int n01, int fr) { return 128 * (cb >> 1) + 64 * (cb & 1) + 32 * wc + n01 * 16 + fr; }

struct PG1 {
    struct Ctx { int tm, cb; };
    const bf16_t* A; const bf16_t* Bt; bf16_t* ZB; int K, pad;
    __device__ bool setup(int bid, Ctx& c) const { c.tm = bid / 24; c.cb = bid % 24; return true; }
    __device__ const bf16_t* arow(const Ctx& c, int r) const { return A + (size_t)(c.tm * 128 + r) * D; }
    __device__ const bf16_t* brow(const Ctx& c, int jj) const { return Bt + (size_t)(c.cb < 16 ? paired_brow(c.cb, jj) : c.cb * 128 + jj) * D; }
    __device__ void epi(const Ctx& c, f32x4 (&acc)[4][4], int wr, int wc, int fr, int fq) const {
        if (c.cb < 16) {
#pragma unroll
            for (int m = 0; m < 4; ++m)
#pragma unroll
                for (int n = 0; n < 2; ++n)
#pragma unroll
                    for (int j = 0; j < 4; ++j) { const int row = c.tm * 128 + wr * 64 + m * 16 + fq * 4 + j; ZB[(size_t)row * 2048 + paired_ch(c.cb, wc, n, fr)] = (bf16_t)f2bf(acc[m][n][j] * acc[m][n + 2][j]); }
        } else {
#pragma unroll
            for (int m = 0; m < 4; ++m)
#pragma unroll
                for (int n = 0; n < 4; ++n)
#pragma unroll
                    for (int j = 0; j < 4; ++j) { const int row = c.tm * 128 + wr * 64 + m * 16 + fq * 4 + j; ZB[(size_t)row * 2048 + D + (c.cb - 16) * 128 + wc * 64 + n * 16 + fr] = (bf16_t)f2bf(acc[m][n][j]); }
        }
    }
};
template <bool RESF32> struct PGOut {
    struct Ctx { int tm, cb; };
    const bf16_t* A; const bf16_t* Bt; const void* res; bf16_t* X; int K, pad;
    __device__ bool setup(int bid, Ctx& c) const { c.tm = bid / 8; c.cb = bid % 8; return true; }
    __device__ const bf16_t* arow(const Ctx& c, int r) const { return A + (size_t)(c.tm * 128 + r) * D; }
    __device__ const bf16_t* brow(const Ctx& c, int jj) const { return Bt + (size_t)(c.cb * 128 + jj) * D; }
    __device__ void epi(const Ctx& c, f32x4 (&acc)[4][4], int wr, int wc, int fr, int fq) const {
#pragma unroll
        for (int m = 0; m < 4; ++m)
#pragma unroll
            for (int n = 0; n < 4; ++n)
#pragma unroll
                for (int j = 0; j < 4; ++j) { const size_t o = (size_t)(c.tm * 128 + wr * 64 + m * 16 + fq * 4 + j) * D + c.cb * 128 + wc * 64 + n * 16 + fr;
                    const float r = RESF32 ? ((const float*)res)[o] : bf2f(((const bf16_t*)res)[o]); X[o] = (bf16_t)f2bf(r + acc[m][n][j]); }
    }
};
struct MoeTile { int e, row0, nrows, slot0; };
template <int TM> __device__ __forceinline__ bool moe_tile(const unsigned* cnt, int ti, MoeTile& mt) {
    int tacc = 0, sacc = 0;
    for (int e = 0; e < NE; ++e) { const int n = (int)cnt[e], nt = (n + TM - 1) / TM;
        if (ti < tacc + nt) { const int j = ti - tacc; mt.e = e; mt.row0 = j * TM; mt.nrows = min(TM, n - j * TM); mt.slot0 = sacc + j * TM; return true; }
        tacc += nt; sacc += n; }
    return false;
}
struct PG3 {
    struct Ctx { MoeTile mt; int cb; };
    const bf16_t* X; const bf16_t* W; const unsigned* cnt; const int* ltok; const float* rs; bf16_t* H; int K, pad;
    __device__ bool setup(int bid, Ctx& c) const { c.cb = bid & 7; return moe_tile<128>(cnt, bid >> 3, c.mt); }
    __device__ const bf16_t* arow(const Ctx& c, int r) const { const int rr = min(r, c.mt.nrows - 1); return X + (size_t)ltok[(size_t)c.mt.e * T + c.mt.row0 + rr] * D; }
    __device__ const bf16_t* brow(const Ctx& c, int jj) const { return W + ((size_t)c.mt.e * 1024 + paired_brow(c.cb, jj)) * D; }
    __device__ void epi(const Ctx& c, f32x4 (&acc)[4][4], int wr, int wc, int fr, int fq) const {
#pragma unroll
        for (int m = 0; m < 4; ++m)
#pragma unroll
            for (int j = 0; j < 4; ++j) { const int r = wr * 64 + m * 16 + fq * 4 + j; if (r < c.mt.nrows) {
                const float sc = rs[ltok[(size_t)c.mt.e * T + c.mt.row0 + r]];
#pragma unroll
                for (int n = 0; n < 2; ++n) H[(size_t)(c.mt.slot0 + r) * F + paired_ch(c.cb, wc, n, fr)] = (bf16_t)f2bf(silu(sc * acc[m][n][j]) * (sc * acc[m][n + 2][j])); } }
    }
};
struct PG4 {
    struct Ctx { MoeTile mt; int cb; };
    const bf16_t* H; const bf16_t* W; const unsigned* cnt; const float* lgate; bf16_t* YS; int K, pad;
    __device__ bool setup(int bid, Ctx& c) const { c.cb = bid & 7; return moe_tile<128>(cnt, bid >> 3, c.mt); }
    __device__ const bf16_t* arow(const Ctx& c, int r) const { return H + (size_t)(c.mt.slot0 + r) * F; }
    __device__ const bf16_t* brow(const Ctx& c, int jj) const { return W + ((size_t)c.mt.e * 1024 + c.cb * 128 + jj) * F; }
    __device__ void epi(const Ctx& c, f32x4 (&acc)[4][4], int wr, int wc, int fr, int fq) const {
#pragma unroll
        for (int m = 0; m < 4; ++m)
#pragma unroll
            for (int j = 0; j < 4; ++j) { const int r = wr * 64 + m * 16 + fq * 4 + j; if (r < c.mt.nrows) {
                const float g = lgate[(size_t)c.mt.e * T + c.mt.row0 + r];
#pragma unroll
                for (int n = 0; n < 4; ++n) YS[(size_t)(c.mt.slot0 + r) * D + c.cb * 128 + wc * 64 + n * 16 + fr] = (bf16_t)f2bf(g * acc[m][n][j]); } }
    }
};
struct PG5 {
    struct Ctx { int tm, cb; };
    const bf16_t* A; const bf16_t* Bt; const float* rs; const float* bias; bf16_t* UV; int K, pad;
    __device__ bool setup(int bid, Ctx& c) const { c.tm = bid / 16; c.cb = bid % 16; return true; }
    __device__ const bf16_t* arow(const Ctx& c, int r) const { return A + (size_t)(c.tm * 128 + r) * D; }
    __device__ const bf16_t* brow(const Ctx& c, int jj) const { return Bt + (size_t)(c.cb * 128 + jj) * D; }
    __device__ void epi(const Ctx& c, f32x4 (&acc)[4][4], int wr, int wc, int fr, int fq) const {
#pragma unroll
        for (int m = 0; m < 4; ++m)
#pragma unroll
            for (int j = 0; j < 4; ++j) { const int row = c.tm * 128 + wr * 64 + m * 16 + fq * 4 + j; const float sc = rs[row];
#pragma unroll
                for (int n = 0; n < 4; ++n) { const int col = c.cb * 128 + wc * 64 + n * 16 + fr; UV[(size_t)row * 2048 + col] = (bf16_t)f2bf(gelu_tanh(sc * acc[m][n][j] + bias[col])); } }
    }
};

__global__ void __launch_bounds__(256) k_conv(const bf16_t* __restrict__ ZB, const float* __restrict__ cw, bf16_t* __restrict__ Y) {
    constexpr int RB = 8;
    const int nitems = (T / RB) * (D / 8);
    for (int it = blockIdx.x * 256 + threadIdx.x; it < nitems; it += gridDim.x * 256) {
        const int cg = it & 127, rb = it >> 7, r0 = rb * RB, ch = cg * 8, t0 = r0 & (SEQ - 1);
        float w[3][8];
#pragma unroll
        for (int k = 0; k < 3; ++k)
#pragma unroll
            for (int i = 0; i < 8; ++i) w[k][i] = cw[k * D + ch + i];
        float zm2[8], zm1[8];
        if (t0 >= 2) { unpack8(*(const u32x4*)(ZB + (size_t)(r0 - 2) * 2048 + ch), zm2); unpack8(*(const u32x4*)(ZB + (size_t)(r0 - 1) * 2048 + ch), zm1); }
        else {
#pragma unroll
            for (int i = 0; i < 8; ++i) { zm2[i] = 0.f; zm1[i] = 0.f; } }
#pragma unroll
        for (int r = 0; r < RB; ++r) {
            float z[8], b[8], o[8];
            unpack8(*(const u32x4*)(ZB + (size_t)(r0 + r) * 2048 + ch), z); unpack8(*(const u32x4*)(ZB + (size_t)(r0 + r) * 2048 + D + ch), b);
#pragma unroll
            for (int i = 0; i < 8; ++i) { o[i] = b[i] * (w[0][i] * zm2[i] + w[1][i] * zm1[i] + w[2][i] * z[i]); zm2[i] = zm1[i]; zm1[i] = z[i]; }
            *(u32x4*)(Y + (size_t)(r0 + r) * D + ch) = pack8(o);
        }
    }
}

__global__ void __launch_bounds__(256) k_route(const bf16_t* __restrict__ X, const float* __restrict__ wr, const float* __restrict__ bg, const float* __restrict__ be,
                                                unsigned* __restrict__ cnt, float* __restrict__ rs, unsigned* __restrict__ asg, int* __restrict__ ltok, float* __restrict__ lgate) {
    __shared__ int s_e[128]; __shared__ float s_g[128]; __shared__ unsigned s_cnt[NE]; __shared__ unsigned s_base[NE]; __shared__ unsigned s_rank[128];
    const int tid = threadIdx.x, wid = tid >> 6, lane = tid & 63;
    for (int tb = blockIdx.x * 64; tb < T; tb += gridDim.x * 64) {
        if (tid < NE) s_cnt[tid] = 0u;
        for (int i = 0; i < 16; ++i) {
            const int tl = wid * 16 + i, tok = tb + tl;
            float xv[16];
            unpack8(*(const u32x4*)(X + (size_t)tok * D + lane * 8), *(float(*)[8])&xv[0]);
            unpack8(*(const u32x4*)(X + (size_t)tok * D + 512 + lane * 8), *(float(*)[8])&xv[8]);
            float ss = 0.f;
#pragma unroll
            for (int q = 0; q < 16; ++q) ss += xv[q] * xv[q];
            const float r = rsqrtf(wave_sum(ss) * (1.0f / D) + EPS);
            float mylg = 0.f;
#pragma unroll 2
            for (int j = 0; j < 36; ++j) {
                const f32x4* w0 = (const f32x4*)(wr + (size_t)j * D + lane * 8); const f32x4* w1 = (const f32x4*)(wr + (size_t)j * D + 512 + lane * 8);
                const f32x4 a = w0[0], b = w0[1], c2 = w1[0], d = w1[1];
                float s = xv[0] * a.x + xv[1] * a.y + xv[2] * a.z + xv[3] * a.w + xv[4] * b.x + xv[5] * b.y + xv[6] * b.z + xv[7] * b.w
                        + xv[8] * c2.x + xv[9] * c2.y + xv[10] * c2.z + xv[11] * c2.w + xv[12] * d.x + xv[13] * d.y + xv[14] * d.z + xv[15] * d.w;
                s = wave_sum(s);
                mylg = (lane == j) ? s : mylg;
            }
            mylg = mylg * r + (lane < 4 ? bg[lane] : (lane < 36 ? be[lane - 4] : 0.f));
            float lg[36];
#pragma unroll
            for (int j = 0; j < 36; ++j) lg[j] = __shfl(mylg, j);
            int gi = 0; float gm = lg[0];
#pragma unroll
            for (int j = 1; j < 4; ++j) if (lg[j] > gm) { gm = lg[j]; gi = j; }
            float gs = 0.f;
#pragma unroll
            for (int j = 0; j < 4; ++j) gs += __expf(lg[j] - gm);
            const float gp = 1.0f / gs;
            float el[8];
#pragma unroll
            for (int j = 0; j < 8; ++j) { el[j] = lg[4 + j];
#pragma unroll
                for (int g = 1; g < 4; ++g) el[j] = (gi == g) ? lg[4 + g * 8 + j] : el[j]; }
            int i0 = 0; float m0 = el[0];
#pragma unroll
            for (int j = 1; j < 8; ++j) if (el[j] > m0) { m0 = el[j]; i0 = j; }
            int i1 = -1; float m1 = -3.0e38f;
#pragma unroll
            for (int j = 0; j < 8; ++j) if (j != i0 && el[j] > m1) { m1 = el[j]; i1 = j; }
            const float eb = __expf(m1 - m0), den = 1.0f / (1.0f + eb);
            if (lane == 0) { s_e[2 * tl] = gi * 8 + i0; s_e[2 * tl + 1] = gi * 8 + i1; s_g[2 * tl] = gp * den; s_g[2 * tl + 1] = gp * eb * den; rs[tok] = r; }
        }
        __syncthreads();
        if (tid < 128) s_rank[tid] = atomicAdd(&s_cnt[s_e[tid]], 1u);
        __syncthreads();
        if (tid < NE) s_base[tid] = s_cnt[tid] ? atomicAdd(&cnt[tid], s_cnt[tid]) : 0u;
        __syncthreads();
        if (tid < 128) { const int e = s_e[tid], tok = tb + (tid >> 1); const unsigned pos = s_base[e] + s_rank[tid];
            ltok[(size_t)e * T + pos] = tok; lgate[(size_t)e * T + pos] = s_g[tid];
            asg[(size_t)tok * 4 + (tid & 1) * 2] = ((unsigned)e << 24) | pos; asg[(size_t)tok * 4 + (tid & 1) * 2 + 1] = __float_as_uint(s_g[tid]); }
        __syncthreads();
    }
}

template <bool FINAL> __global__ void __launch_bounds__(256) k_combine(const bf16_t* __restrict__ X, const bf16_t* __restrict__ YS, const unsigned* __restrict__ cnt, const unsigned* __restrict__ asg,
                                                                        bf16_t* __restrict__ Xo, float* __restrict__ rs, const float* __restrict__ g, float* __restrict__ out) {
    const int lane = threadIdx.x & 63, gw = (blockIdx.x * 256 + threadIdx.x) >> 6, ngw = (gridDim.x * 256) >> 6;
    unsigned c = lane < NE ? cnt[lane] : 0u, inc = c;
#pragma unroll
    for (int o = 1; o < 32; o <<= 1) { const unsigned t = __shfl_up(inc, o); if (lane >= o) inc += t; }
    const unsigned excl = inc - c;
    for (int row = gw; row < T; row += ngw) {
        const unsigned ca = asg[(size_t)row * 4], cb = asg[(size_t)row * 4 + 2];
        const unsigned sa = __shfl(excl, (int)(ca >> 24)) + (ca & 0xffffffu), sb = __shfl(excl, (int)(cb >> 24)) + (cb & 0xffffffu);
        float v[16], a[8], b[8];
#pragma unroll
        for (int h = 0; h < 2; ++h) {
            float x8[8];
            unpack8(*(const u32x4*)(X + (size_t)row * D + h * 512 + lane * 8), x8);
            unpack8(*(const u32x4*)(YS + (size_t)sa * D + h * 512 + lane * 8), a);
            unpack8(*(const u32x4*)(YS + (size_t)sb * D + h * 512 + lane * 8), b);
#pragma unroll
            for (int i = 0; i < 8; ++i) v[h * 8 + i] = x8[i] + (a[i] + b[i]);
        }
        if (!FINAL) {
            float ss = 0.f;
#pragma unroll
            for (int h = 0; h < 2; ++h) { float o8[8];
#pragma unroll
                for (int i = 0; i < 8; ++i) { o8[i] = bf2f(f2bf(v[h * 8 + i])); ss += o8[i] * o8[i]; }
                *(u32x4*)(Xo + (size_t)row * D + h * 512 + lane * 8) = pack8(o8); }
            const float r = rsqrtf(wave_sum(ss) * (1.0f / D) + EPS);
            if (lane == 0) rs[row] = r;
        } else {
            float ss = 0.f;
#pragma unroll
            for (int i = 0; i < 16; ++i) ss += v[i] * v[i];
            const float r = rsqrtf(wave_sum(ss) * (1.0f / D) + EPS);
#pragma unroll
            for (int h = 0; h < 2; ++h) { const f32x4 g0 = *(const f32x4*)(g + h * 512 + lane * 8), g1 = *(const f32x4*)(g + h * 512 + lane * 8 + 4);
                f32x4 o0, o1; o0.x = v[h * 8 + 0] * r * g0.x; o0.y = v[h * 8 + 1] * r * g0.y; o0.z = v[h * 8 + 2] * r * g0.z; o0.w = v[h * 8 + 3] * r * g0.w;
                o1.x = v[h * 8 + 4] * r * g1.x; o1.y = v[h * 8 + 5] * r * g1.y; o1.z = v[h * 8 + 6] * r * g1.z; o1.w = v[h * 8 + 7] * r * g1.w;
                *(f32x4*)(out + (size_t)row * D + h * 512 + lane * 8) = o0; *(f32x4*)(out + (size_t)row * D + h * 512 + lane * 8 + 4) = o1; }
        }
    }
}

__global__ void __launch_bounds__(256) k_lnstats(const bf16_t* __restrict__ UV, float* __restrict__ lns) {
    const int lane = threadIdx.x & 63, gw = (blockIdx.x * 256 + threadIdx.x) >> 6, ngw = (gridDim.x * 256) >> 6;
    for (int row = gw; row < T; row += ngw) {
        float v[16];
        unpack8(*(const u32x4*)(UV + (size_t)row * 2048 + D + lane * 8), *(float(*)[8])&v[0]);
        unpack8(*(const u32x4*)(UV + (size_t)row * 2048 + D + 512 + lane * 8), *(float(*)[8])&v[8]);
        float s = 0.f;
#pragma unroll
        for (int i = 0; i < 16; ++i) s += v[i];
        const float mu = wave_sum(s) * (1.0f / D); float q = 0.f;
#pragma unroll
        for (int i = 0; i < 16; ++i) { const float d = v[i] - mu; q += d * d; }
        const float rstd = rsqrtf(wave_sum(q) * (1.0f / D) + EPS);
        if (lane == 0) { lns[2 * row] = mu; lns[2 * row + 1] = rstd; }
    }
}
__global__ void __launch_bounds__(256) k_mix(const bf16_t* __restrict__ UV, const float* __restrict__ lns, const float* __restrict__ vg, const float* __restrict__ vb,
                                             const bf16_t* __restrict__ wm, const float* __restrict__ bs, bf16_t* __restrict__ YM) {
    __shared__ float vs[CHUNK][CHUNK];
    const int h = blockIdx.x & 7, bc = blockIdx.x >> 3, row0 = bc * CHUNK, tid = threadIdx.x;
    for (int i = tid; i < CHUNK * CHUNK / 8; i += 256) { const int s = i >> 4, d8 = (i & 15) * 8; float v[8];
        unpack8(*(const u32x4*)(UV + (size_t)(row0 + s) * 2048 + D + h * 128 + d8), v);
        const float mu = lns[2 * (row0 + s)], rstd = lns[2 * (row0 + s) + 1];
#pragma unroll
        for (int q = 0; q < 8; ++q) vs[s][d8 + q] = bf2f(f2bf((v[q] - mu) * rstd * vg[h * 128 + d8 + q] + vb[h * 128 + d8 + q])); }
    __syncthreads();
    const int d = tid & 127, th = tid >> 7;
    for (int t = th * 64; t < th * 64 + 64; ++t) {
        float acc = 0.f; const bf16_t* wrow = wm + ((size_t)h * CHUNK + t) * CHUNK;
        for (int s = 0; s <= t; ++s) acc += bf2f(wrow[s]) * vs[s][d];
        const float u = bf2f(UV[(size_t)(row0 + t) * 2048 + h * 128 + d]);
        YM[(size_t)(row0 + t) * D + h * 128 + d] = (bf16_t)f2bf(u * (acc + bs[h * CHUNK + t]));
    }
}
}

extern "C" void kernel_launch(void* const* d_in, const int* in_sizes, int n_in, void* d_out, int out_size, void* d_ws, size_t ws_size, hipStream_t stream) {
    if (n_in != 22 || ws_size < WS_END) { fprintf(stderr, "kernel_launch: unexpected n_in %d / ws_size %zu\n", n_in, ws_size); return; }
    const float* x = (const float*)d_in[0]; const float* ln_a = (const float*)d_in[1]; const float* w_in_a = (const float*)d_in[2]; const float* conv_w = (const float*)d_in[3];
    const float* w_out_a = (const float*)d_in[4]; const float* ln_b = (const float*)d_in[5]; const float* w_in_b = (const float*)d_in[6]; const float* b_in_b = (const float*)d_in[7];
    const float* v_ln_g = (const float*)d_in[8]; const float* v_ln_b = (const float*)d_in[9]; const float* w_s = (const float*)d_in[10]; const float* b_s = (const float*)d_in[11];
    const float* w_out_b = (const float*)d_in[12]; const float* ln2 = (const float*)d_in[13]; const float* w_group = (const float*)d_in[14]; const float* b_group = (const float*)d_in[15];
    const float* w_expert = (const float*)d_in[16]; const float* b_expert = (const float*)d_in[17]; const float* w_gate = (const float*)d_in[18]; const float* w_up = (const float*)d_in[19];
    const float* w_down = (const float*)d_in[20]; const float* ln_f = (const float*)d_in[21];
    unsigned char* ws = (unsigned char*)d_ws; float* out = (float*)d_out;
    unsigned* ctl = (unsigned*)(ws + WS_CTL); float* RS = (float*)(ws + WS_RS); unsigned* ASG = (unsigned*)(ws + WS_ASG); float* LNS = (float*)(ws + WS_LNS);
    int* LTOK = (int*)(ws + WS_LTOK); float* LGATE = (float*)(ws + WS_LGATE); float* WR = (float*)(ws + WS_WR); bf16_t* WM = (bf16_t*)(ws + WS_WM);
    bf16_t* WA_IN = (bf16_t*)(ws + WS_WA_IN); bf16_t* WA_OUT = (bf16_t*)(ws + WS_WA_OUT); bf16_t* WB_IN = (bf16_t*)(ws + WS_WB_IN); bf16_t* WB_OUT = (bf16_t*)(ws + WS_WB_OUT);
    bf16_t* WGU = (bf16_t*)(ws + WS_WGU); bf16_t* WD = (bf16_t*)(ws + WS_WD);
    bf16_t* bufA = (bf16_t*)(ws + WS_A); bf16_t* bufB = (bf16_t*)(ws + WS_B); bf16_t* bufC = (bf16_t*)(ws + WS_C); bf16_t* bufD = (bf16_t*)(ws + WS_D);

    (void)hipMemsetAsync(ws + WS_CTL, 0, CTL_BYTES, stream);
    k_prep_x<<<2048, 256, 0, stream>>>(x, ln_a, bufB);
    { TrJob j{w_in_a, WA_IN, nullptr, D, 3 * D, 1, 0, 0, 0}; k_transpose<<<dim3((D / 64) * (3 * D / 64), 1), 256, 0, stream>>>(j); }
    { TrJob j{w_out_a, WA_OUT, nullptr, D, D, 0, 0, 0, 0}; k_transpose<<<dim3((D / 64) * (D / 64), 1), 256, 0, stream>>>(j); }
    { TrJob j{w_in_b, WB_IN, ln_b, D, 2 * D, 0, 0, 0, 0}; k_transpose<<<dim3((D / 64) * (2 * D / 64), 1), 256, 0, stream>>>(j); }
    { TrJob j{w_out_b, WB_OUT, nullptr, D, D, 0, 0, 0, 0}; k_transpose<<<dim3((D / 64) * (D / 64), 1), 256, 0, stream>>>(j); }
    k_prep_router<<<(2 * 36 * D + 255) / 256, 256, 0, stream>>>(ln2, w_group, w_expert, WR);
    k_prep_wm<<<(NH * CHUNK * CHUNK + 255) / 256, 256, 0, stream>>>(w_s, WM);

    auto moe = [&](int layer, const bf16_t* Xin) {
        { TrJob j{w_gate + (size_t)layer * NE * D * F, WGU, ln2 + layer * D, D, F, 2, 0, (size_t)D * F, (size_t)1024 * D}; k_transpose<<<dim3((D / 64) * (F / 64), NE), 256, 0, stream>>>(j); }
        { TrJob j{w_up + (size_t)layer * NE * D * F, WGU, ln2 + layer * D, D, F, 3, 0, (size_t)D * F, (size_t)1024 * D}; k_transpose<<<dim3((D / 64) * (F / 64), NE), 256, 0, stream>>>(j); }
        { TrJob j{w_down + (size_t)layer * NE * F * D, WD, nullptr, F, D, 0, 0, (size_t)F * D, (size_t)D * F}; k_transpose<<<dim3((F / 64) * (D / 64), NE), 256, 0, stream>>>(j); }
        unsigned* cnt = ctl + CW_CNT + layer * NE;
        k_route<<<512, 256, 0, stream>>>(Xin, WR + (size_t)layer * 36 * D, b_group + layer * NG, b_expert + layer * NE, cnt, RS, ASG, LTOK, LGATE);
        bf16_t* Hb = layer == 0 ? bufB : bufC;
        { PG3 p{Xin, WGU, cnt, LTOK, RS, Hb, D}; k_gemm128<PG3><<<(NASSIGN / 128 + NE) * 8, 256, 0, stream>>>(p); }
        { PG4 p{Hb, WD, cnt, LGATE, bufA, F}; k_gemm128<PG4><<<(NASSIGN / 128 + NE) * 8, 256, 0, stream>>>(p); }
    };
    { PG1 p{bufB, WA_IN, bufA, D}; k_gemm128<PG1><<<(T / 128) * 24, 256, 0, stream>>>(p); }
    k_conv<<<2048, 256, 0, stream>>>(bufA, conv_w, bufC);
    { PGOut<true> p{bufC, WA_OUT, x, bufD, D}; k_gemm128<PGOut<true>><<<(T / 128) * 8, 256, 0, stream>>>(p); }
    moe(0, bufD);
    k_combine<false><<<2048, 256, 0, stream>>>(bufD, bufA, ctl + CW_CNT, ASG, bufC, RS, nullptr, nullptr);
    { PG5 p{bufC, WB_IN, RS, b_in_b, bufA, D}; k_gemm128<PG5><<<(T / 128) * 16, 256, 0, stream>>>(p); }
    k_lnstats<<<2048, 256, 0, stream>>>(bufA, LNS);
    k_mix<<<(T / CHUNK) * NH, 256, 0, stream>>>(bufA, LNS, v_ln_g, v_ln_b, WM, b_s, bufD);
    { PGOut<false> p{bufD, WB_OUT, bufC, bufB, D}; k_gemm128<PGOut<false>><<<(T / 128) * 8, 256, 0, stream>>>(p); }
    moe(1, bufB);
    k_combine<true><<<2048, 256, 0, stream>>>(bufB, bufA, ctl + CW_CNT + NE, ASG, nullptr, nullptr, ln_f, out);
}
```

```cpp
#include <hip/hip_runtime.h>
#include <hip/hip_cooperative_groups.h>
#include <cstdint>
#include <cstdio>

namespace cg = cooperative_groups;
namespace {
#define LAS __attribute__((address_space(3)))
typedef unsigned short bf16_t;
typedef short bf16x8 __attribute__((ext_vector_type(8)));
typedef float f32x4 __attribute__((ext_vector_type(4)));
typedef float f32x2 __attribute__((ext_vector_type(2)));
typedef unsigned u32x4 __attribute__((ext_vector_type(4)));
typedef unsigned u32x2 __attribute__((ext_vector_type(2)));

constexpr int BATCH = 8, SEQ = 4096, D = 1024, T = BATCH * SEQ;
constexpr int NE = 32, NG = 4, F = 512, CHUNK = 128, NH = 8;
constexpr float EPS = 1e-6f;
constexpr int NT = 512, NWAVES = 8;

constexpr size_t MiB = 1u << 20;
constexpr size_t WS_CTL = 0;
constexpr size_t CTL_BYTES = 65536;
constexpr size_t WS_RS = 1 * MiB;
constexpr size_t WS_ASG = 1 * MiB + 512 * 1024;
constexpr size_t WS_LNS = 2 * MiB;
constexpr size_t WS_WR = 2 * MiB + 512 * 1024;
constexpr size_t WS_WM = 3 * MiB;
constexpr size_t WS_LTOK = 4 * MiB;
constexpr size_t WS_LNP = 112 * MiB;
constexpr size_t WS_LGATE = 8 * MiB;
constexpr size_t WS_LRS = 12 * MiB;
constexpr size_t WS_WA_IN = 16 * MiB;
constexpr size_t WS_WA_OUT = 22 * MiB;
constexpr size_t WS_WB_IN = 24 * MiB;
constexpr size_t WS_WB_OUT = 28 * MiB;
constexpr size_t WS_WGU = 32 * MiB;
constexpr size_t WS_WD = 64 * MiB;
constexpr size_t WS_XQ = 80 * MiB;
constexpr size_t WS_A = 128 * MiB;
constexpr size_t WS_B = 256 * MiB;
constexpr size_t WS_C = 320 * MiB;
constexpr size_t WS_D = 384 * MiB;
constexpr size_t WS_END = 449 * MiB;
constexpr int CW_CNT = 0;
constexpr int CW_BAR = 4096;

constexpr int RING_BYTES = 131072;
constexpr int TAB_OFF = RING_BYTES;
constexpr int TAB_MAX = 320;
constexpr int TABN_OFF = TAB_OFF + TAB_MAX * 16;
constexpr int BARST_OFF = TABN_OFF + 16;
constexpr int TOKTAB_OFF = RING_BYTES + 8192;
constexpr int SCTAB_OFF = TOKTAB_OFF + 1024;
constexpr int LDS_BYTES = 147456;

__device__ __forceinline__ float bf2f(unsigned b) { return __uint_as_float(b << 16); }
__device__ __forceinline__ unsigned f2bf(float f) { unsigned u = __float_as_uint(f); return (u + 0x7fffu + ((u >> 16) & 1u)) >> 16; }
__device__ __forceinline__ unsigned pk2(float lo, float hi) { return f2bf(lo) | (f2bf(hi) << 16); }
__device__ __forceinline__ unsigned cvt_pk_bf16(float lo, float hi) { unsigned r; asm volatile("v_cvt_pk_bf16_f32 %0, %1, %2" : "=v"(r) : "v"(lo), "v"(hi)); return r; }
__device__ __forceinline__ float wave_sum(float v) {
#pragma unroll
    for (int o = 1; o < 64; o <<= 1) v += __shfl_xor(v, o);
    return v;
}
__device__ __forceinline__ void unpack8(const u32x4 v, float (&f)[8]) {
    f[0] = bf2f(v.x & 0xffffu); f[1] = bf2f(v.x >> 16); f[2] = bf2f(v.y & 0xffffu); f[3] = bf2f(v.y >> 16);
    f[4] = bf2f(v.z & 0xffffu); f[5] = bf2f(v.z >> 16); f[6] = bf2f(v.w & 0xffffu); f[7] = bf2f(v.w >> 16);
}
__device__ __forceinline__ u32x4 pack8(const float (&f)[8]) {
    u32x4 o; o.x = pk2(f[0], f[1]); o.y = pk2(f[2], f[3]); o.z = pk2(f[4], f[5]); o.w = pk2(f[6], f[7]); return o;
}
__device__ __forceinline__ float gelu_tanh(float x) {
    const float x2 = x * x;
    const float t = x * (x2 * (-0.044715f * 2.0f * 0.7978845608028654f * 1.4426950408889634f) + (-2.0f * 0.7978845608028654f * 1.4426950408889634f));
    return x * __builtin_amdgcn_rcpf(1.0f + __builtin_amdgcn_exp2f(t));
}
__device__ __forceinline__ float silu(float x) { return x * __builtin_amdgcn_rcpf(1.0f + __builtin_amdgcn_exp2f(x * -1.4426950408889634f)); }
#define LDS_WAIT() asm volatile("s_waitcnt lgkmcnt(0)" ::: "memory")
__device__ __forceinline__ float clamp_fp8(float v) { return __builtin_amdgcn_fmed3f(v, -448.0f, 448.0f); }
__device__ __forceinline__ unsigned pk4_fp8(float a, float b, float c, float d) { unsigned w = 0u; a = clamp_fp8(a); b = clamp_fp8(b); c = clamp_fp8(c); d = clamp_fp8(d); w = __builtin_amdgcn_cvt_pk_fp8_f32(a, b, w, false); w = __builtin_amdgcn_cvt_pk_fp8_f32(c, d, w, true); return w; }
__device__ __forceinline__ void unpack8_fp8(const u32x2 v, float (&f)[8]) {
    const f32x2 a = __builtin_amdgcn_cvt_pk_f32_fp8(v.x, false), b = __builtin_amdgcn_cvt_pk_f32_fp8(v.x, true), c = __builtin_amdgcn_cvt_pk_f32_fp8(v.y, false), d = __builtin_amdgcn_cvt_pk_f32_fp8(v.y, true);
    f[0] = a.x; f[1] = a.y; f[2] = b.x; f[3] = b.y; f[4] = c.x; f[5] = c.y; f[6] = d.x; f[7] = d.y;
}
typedef int i32x8 __attribute__((ext_vector_type(8)));
typedef int i32x4 __attribute__((ext_vector_type(4)));
__device__ __forceinline__ int phase_tid() { int t = (int)threadIdx.x; asm volatile("" : "+v"(t)); return t; }

constexpr int BM = 256, BK = 64, HALF = 128, HTB = HALF * BK * 2, NXCD = 8, WGM = 8;
__device__ __forceinline__ int lds_byte(int r, int c) { const int st = (r >> 4) * 2 + (c >> 5), rr = r & 15, cc = c & 31, ob = rr * 64 + cc * 2; return st * 1024 + (ob ^ (((ob >> 9) & 1) << 5)); }
__device__ __forceinline__ void stage_rc(int b, int& R, int& C) { const int st = b / 1024, sb = b % 1024, swz = sb ^ (((sb >> 9) & 1) << 5); R = (st >> 1) * 16 + swz / 64; C = (st & 1) * 32 + (swz % 64) / 2; }
__device__ __forceinline__ int perm32(int rho) { const int n = rho >> 4, i = rho & 15; return 8 * (i >> 2) + 4 * n + (i & 3); }

struct Unit { int pm, pn, e, row0, nrows, slot0; };
__device__ __forceinline__ bool order_next(int i, int G, int c, int nM, int nN, int& pm, int& pn) {
    const int nwg = nM * nN; const long L = (long)i * G + c; if (L >= nwg) return false;
    int wgid = (int)L; { const int q = nwg / NXCD, r = nwg % NXCD, xcd = wgid % NXCD, off = wgid / NXCD; wgid = (xcd < r ? xcd * (q + 1) : r * (q + 1) + (xcd - r) * q) + off; }
    const int nig = WGM * nN, gid = wgid / nig, fm = gid * WGM, gsz = (nM - fm) < WGM ? (nM - fm) : WGM;
    pm = fm + ((wgid % nig) % gsz); pn = (wgid % nig) / gsz; return true;
}
struct DenseSched {
    static constexpr bool ROWTAB = false, GATHER_IDS = false;
    int nM, nN, G, c, K; const bf16_t* Bt;
    __device__ __forceinline__ bool next(int i, Unit& u) const { u.e = 0; u.row0 = 0; u.nrows = BM; u.slot0 = 0; return order_next(i, G, c, nM, nN, u.pm, u.pn); }
    __device__ __forceinline__ void aoff(const Unit& u, int tid, unsigned (&v)[2][2]) const {
        int R[2], C[2]; stage_rc(tid * 16, R[0], C[0]); stage_rc(tid * 16 + 8192, R[1], C[1]);
#pragma unroll
        for (int h = 0; h < 2; ++h)
#pragma unroll
            for (int i = 0; i < 2; ++i) v[h][i] = (unsigned)((u.pm * BM + h * HALF + R[i]) * K + C[i]) * 2u;
    }
    __device__ __forceinline__ const char* bptr(const Unit& u) const { return (const char*)Bt + (size_t)u.pn * BM * K * 2; }
};
template <bool GATHER> struct MoeSched {
    static constexpr bool ROWTAB = true, GATHER_IDS = GATHER;
    int nM, G, c, K; const unsigned char* W; const int* ltok; const LAS int* tab; const float* rowscal;
    __device__ __forceinline__ bool next(int i, Unit& u) const {
        if (G == 256) { const int rt = i * 64 + 8 * (c & 7) + ((c >> 3) & 7); if (rt >= nM) return false; u.pm = rt; u.pn = c >> 6; }
        else if (!order_next(i, G, c, nM, 4, u.pm, u.pn)) return false;
        u.e = __builtin_amdgcn_readfirstlane(tab[u.pm * 4 + 0]); u.row0 = __builtin_amdgcn_readfirstlane(tab[u.pm * 4 + 1]); u.nrows = __builtin_amdgcn_readfirstlane(tab[u.pm * 4 + 2]); u.slot0 = __builtin_amdgcn_readfirstlane(tab[u.pm * 4 + 3]); return true;
    }
    __device__ __forceinline__ void aoff(const Unit& u, int tid, unsigned (&v)[2][2]) const {
        int R[2], C[2]; stage_rc(tid * 16, R[0], C[0]); stage_rc(tid * 16 + 8192, R[1], C[1]);
#pragma unroll
        for (int h = 0; h < 2; ++h)
#pragma unroll
            for (int i = 0; i < 2; ++i) {
                if (GATHER) { const int rr = min(h * HALF + R[i], u.nrows - 1); const int tok = ltok[(size_t)u.e * T + u.row0 + rr]; v[h][i] = (unsigned)(tok * K + C[i]) * 2u; }
                else v[h][i] = (unsigned)((u.slot0 + h * HALF + R[i]) * K + C[i]) * 2u;
            }
    }
    __device__ __forceinline__ void aoff_lds(const LAS int* toktab, int tid, unsigned (&v)[2][2]) const {
        int R[2], C[2]; stage_rc(tid * 16, R[0], C[0]); stage_rc(tid * 16 + 8192, R[1], C[1]);
#pragma unroll
        for (int h = 0; h < 2; ++h)
#pragma unroll
            for (int i = 0; i < 2; ++i) v[h][i] = (unsigned)(toktab[h * HALF + R[i]] * K + C[i]) * 2u;
    }
    __device__ __forceinline__ const char* bptr(const Unit& u) const { return (const char*)W + ((size_t)u.e * 1024 + (size_t)u.pn * BM) * K * 2; }
};

template <class Epi, class Sched, bool FP8 = false>
__device__ __forceinline__ void gemm_phase(LAS unsigned char* lds, const bf16_t* Abase, const int K, const Sched& S, const Epi& E) {
    const int tid = phase_tid(), wid = __builtin_amdgcn_readfirstlane(tid >> 6), lane = tid & 63, wr = wid >> 2, wc = wid & 3, fr = lane & 15, fq = lane >> 4;
    const int nt = K / BK;
    unsigned voffB[2];
#pragma unroll
    for (int i = 0; i < 2; ++i) { int sR, sC; stage_rc(tid * 16 + i * 8192, sR, sC);
        const int Rb = Epi::WIDE ? (64 * (sR >> 5) + 16 * ((sR & 15) >> 2) + 4 * ((sR >> 4) & 1) + (sR & 3)) : ((sR & ~31) + perm32(sR & 31)); voffB[i] = (unsigned)(Rb * K + sC) * 2u; }
    const size_t kstep = (size_t)(BK * 2);
    const size_t hstepB = (size_t)(Epi::WIDE ? 8 : HALF) * K * 2;
    const unsigned ldsw = (unsigned)wid * 1024u;
    const int aoff = lds_byte(wr * 64 + fr, fq * 8), boff = lds_byte(wc * 32 + fr, fq * 8);
#define PG8_SA(b, h) (((b) * 2 + (h)) * HTB)
#define PG8_SB(b, h) ((4 + (b) * 2 + (h)) * HTB)
#define PG8_STAGE(bufoff, gbase, voff) do { _Pragma("unroll") for (int _i = 0; _i < 2; ++_i) \
        __builtin_amdgcn_global_load_lds((const unsigned*)((const char*)(gbase) + (voff)[_i]), (LAS unsigned*)(lds + (bufoff) + ldsw + _i * 8192), 16, 0, 0); } while (0)
#define PG8_LDA(dst, b, h) do { _Pragma("unroll") for (int m = 0; m < 4; ++m) { \
        const i32x4 lo_ = *(const LAS i32x4*)(lds + PG8_SA(b, h) + aoff + m * 2048), hi_ = *(const LAS i32x4*)(lds + PG8_SA(b, h) + aoff + m * 2048 + 1024); \
        if constexpr (FP8) dst##8[m] = __builtin_shufflevector(lo_, hi_, 0, 1, 2, 3, 4, 5, 6, 7); else { dst[m][0] = __builtin_bit_cast(bf16x8, lo_); dst[m][1] = __builtin_bit_cast(bf16x8, hi_); } } } while (0)
#define PG8_LDB(dst, b, h) do { _Pragma("unroll") for (int n = 0; n < 2; ++n) { \
        const i32x4 lo_ = *(const LAS i32x4*)(lds + PG8_SB(b, h) + boff + n * 2048), hi_ = *(const LAS i32x4*)(lds + PG8_SB(b, h) + boff + n * 2048 + 1024); \
        if constexpr (FP8) dst##8[n] = __builtin_shufflevector(lo_, hi_, 0, 1, 2, 3, 4, 5, 6, 7); else { dst[n][0] = __builtin_bit_cast(bf16x8, lo_); dst[n][1] = __builtin_bit_cast(bf16x8, hi_); } } } while (0)
#define PG8_MMA(ai, bj, At, Bt) do { __builtin_amdgcn_s_setprio(1); \
        if constexpr (FP8) { \
            asm volatile("s_nop 1\n\t" \
                "v_mfma_f32_16x16x128_f8f6f4 %0, %8, %10, %0\n\t" "v_mfma_f32_16x16x128_f8f6f4 %1, %9, %10, %1\n\t" \
                "v_mfma_f32_16x16x128_f8f6f4 %2, %8, %11, %2\n\t" "v_mfma_f32_16x16x128_f8f6f4 %3, %9, %11, %3\n\t" \
                "v_mfma_f32_16x16x128_f8f6f4 %4, %8, %12, %4\n\t" "v_mfma_f32_16x16x128_f8f6f4 %5, %9, %12, %5\n\t" \
                "v_mfma_f32_16x16x128_f8f6f4 %6, %8, %13, %6\n\t" "v_mfma_f32_16x16x128_f8f6f4 %7, %9, %13, %7" \
                : "+v"(acc[ai][bj][0][0]), "+v"(acc[ai][bj][0][1]), "+v"(acc[ai][bj][1][0]), "+v"(acc[ai][bj][1][1]), \
                  "+v"(acc[ai][bj][2][0]), "+v"(acc[ai][bj][2][1]), "+v"(acc[ai][bj][3][0]), "+v"(acc[ai][bj][3][1]) \
                : "v"(Bt##8[0]), "v"(Bt##8[1]), "v"(At##8[0]), "v"(At##8[1]), "v"(At##8[2]), "v"(At##8[3])); \
        } else { _Pragma("unroll") for (int m = 0; m < 4; ++m) _Pragma("unroll") for (int n = 0; n < 2; ++n) _Pragma("unroll") for (int k = 0; k < 2; ++k) \
            acc[ai][bj][m][n] = __builtin_amdgcn_mfma_f32_16x16x32_bf16(Bt[n][k], At[m][k], acc[ai][bj][m][n], 0, 0, 0); } \
        __builtin_amdgcn_s_setprio(0); } while (0)
#define PG8_WAIT_V(n) asm volatile("s_waitcnt vmcnt(" #n ")" ::: "memory")
#define PG8_WAIT_L(n) asm volatile("s_waitcnt lgkmcnt(" #n ")" ::: "memory")
#define PG8_BAR __builtin_amdgcn_s_barrier()
#define PG8_SCHED __builtin_amdgcn_sched_barrier(0)
    Unit cur, nxt; int ui = 0;
    if (!S.next(0, cur)) return;
    f32x4 acc[2][2][4][2];
#pragma unroll
    for (int a = 0; a < 2; ++a)
#pragma unroll
        for (int b = 0; b < 2; ++b)
#pragma unroll
            for (int m = 0; m < 4; ++m)
#pragma unroll
                for (int n = 0; n < 2; ++n) acc[a][b][m][n] = (f32x4){0.f, 0.f, 0.f, 0.f};
    bf16x8 At[4][2], B0[2][2], B1[2][2]; i32x8 At8[4], B08[2], B18[2];
    unsigned vA[2][2], vS[2][2];
    S.aoff(cur, tid, vA);
#pragma unroll
    for (int h = 0; h < 2; ++h)
#pragma unroll
        for (int i = 0; i < 2; ++i) vS[h][i] = vA[h][i];
    const char* const A0 = (const char*)Abase;
    const char* cB = S.bptr(cur);
    PG8_STAGE(PG8_SB(0, 0), cB, voffB); PG8_STAGE(PG8_SB(0, 1), cB + hstepB, voffB); PG8_STAGE(PG8_SA(0, 0), A0, vA[0]); PG8_STAGE(PG8_SA(0, 1), A0, vA[1]);
    if (wr == 1) PG8_BAR;
    PG8_WAIT_V(2); PG8_BAR;
    PG8_STAGE(PG8_SB(1, 0), cB + kstep, voffB); PG8_STAGE(PG8_SA(1, 0), A0 + kstep, vA[0]); PG8_STAGE(PG8_SB(1, 1), cB + hstepB + kstep, voffB);
    PG8_WAIT_V(6); PG8_BAR;
    for (;;) {
        const bool has_next = S.next(ui + 1, nxt);
        const bool full = cur.nrows > HALF;
        if constexpr (Sched::ROWTAB) {
            if (wid < 4) { const int row = wid * 64 + lane;
                __builtin_amdgcn_global_load_lds((const unsigned*)(S.rowscal + (size_t)cur.e * T + cur.row0 + min(row, cur.nrows - 1)), (LAS unsigned*)(lds + SCTAB_OFF + (ui & 1) * 1024 + wid * 256), 4, 0, 0);
                if (Sched::GATHER_IDS && has_next) __builtin_amdgcn_global_load_lds((const unsigned*)(S.ltok + (size_t)nxt.e * T + nxt.row0 + min(row, nxt.nrows - 1)), (LAS unsigned*)(lds + TOKTAB_OFF + (ui & 1) * 1024 + wid * 256), 4, 0, 0); }
        }
        const char* nB = has_next ? S.bptr(nxt) : cB;
#pragma unroll 1
        for (int t = 0; t < nt; t += 2) {
            const bool last = (t == nt - 2);
            if (last && has_next) { if constexpr (Sched::GATHER_IDS) S.aoff_lds((const LAS int*)(lds + TOKTAB_OFF + (ui & 1) * 1024), tid, vS); else S.aoff(nxt, tid, vS); }
            const char* a1 = A0 + (size_t)(t + 1) * kstep;
            const char* a2 = last ? A0 : A0 + (size_t)(t + 2) * kstep; const char* b2 = last ? nB : cB + (size_t)(t + 2) * kstep;
            const char* a3 = a2 + kstep; const char* b3 = b2 + kstep;
            PG8_LDB(B0, 0, 0); PG8_LDB(B1, 0, 1); PG8_SCHED; PG8_LDA(At, 0, 0); PG8_STAGE(PG8_SA(1, 1), a1, vA[1]);
            PG8_WAIT_V(8); PG8_WAIT_L(0); PG8_BAR; PG8_MMA(0, 0, At, B0); PG8_MMA(0, 1, At, B1); PG8_BAR; PG8_SCHED;
            PG8_LDA(At, 0, 1); PG8_STAGE(PG8_SB(0, 0), b2, voffB); PG8_STAGE(PG8_SB(0, 1), b2 + hstepB, voffB); PG8_STAGE(PG8_SA(0, 0), a2, vS[0]);
            PG8_WAIT_V(8); PG8_WAIT_L(0); PG8_BAR; if (full) { PG8_MMA(1, 0, At, B0); PG8_MMA(1, 1, At, B1); } PG8_BAR; PG8_SCHED;
            PG8_LDB(B0, 1, 0); PG8_LDB(B1, 1, 1); PG8_SCHED; PG8_LDA(At, 1, 0); PG8_STAGE(PG8_SA(0, 1), a2, vS[1]);
            PG8_WAIT_V(8); PG8_WAIT_L(0); PG8_BAR; PG8_MMA(0, 0, At, B0); PG8_MMA(0, 1, At, B1); PG8_BAR; PG8_SCHED;
            PG8_LDA(At, 1, 1); PG8_STAGE(PG8_SB(1, 0), b3, voffB); PG8_STAGE(PG8_SB(1, 1), b3 + hstepB, voffB); PG8_STAGE(PG8_SA(1, 0), a3, vS[0]);
            PG8_WAIT_V(8); PG8_WAIT_L(0); PG8_BAR; if (full) { PG8_MMA(1, 0, At, B0); PG8_MMA(1, 1, At, B1); } PG8_BAR; PG8_SCHED;
        }
        if (wr == 0) PG8_BAR;
        if constexpr (FP8) asm volatile("s_nop 7\n\ts_nop 7\n\ts_nop 7" ::: "memory");
        { const int t2 = phase_tid(), l2 = t2 & 63; E(acc, cur, wr, wc, l2 & 15, l2 >> 4, (const LAS float*)(lds + SCTAB_OFF + (ui & 1) * 1024)); }
        if (!has_next) break;
#pragma unroll
        for (int a = 0; a < 2; ++a)
#pragma unroll
            for (int b = 0; b < 2; ++b)
#pragma unroll
                for (int m = 0; m < 4; ++m)
#pragma unroll
                    for (int n = 0; n < 2; ++n) acc[a][b][m][n] = (f32x4){0.f, 0.f, 0.f, 0.f};
        cur = nxt; cB = nB; ++ui;
#pragma unroll
        for (int h = 0; h < 2; ++h)
#pragma unroll
            for (int i = 0; i < 2; ++i) vA[h][i] = vS[h][i];
        if (wr == 1) PG8_BAR;
    }
    PG8_WAIT_V(0);
    PG8_BAR;
#undef PG8_SA
#undef PG8_SB
#undef PG8_STAGE
#undef PG8_LDA
#undef PG8_LDB
#undef PG8_MMA
#undef PG8_WAIT_V
#undef PG8_WAIT_L
#undef PG8_BAR
#undef PG8_SCHED
}

__device__ __forceinline__ u32x4 pack_rows(const f32x4 v0, const f32x4 v1) { u32x4 w; w.x = cvt_pk_bf16(v0[0], v0[1]); w.y = cvt_pk_bf16(v0[2], v0[3]); w.z = cvt_pk_bf16(v1[0], v1[1]); w.w = cvt_pk_bf16(v1[2], v1[3]); return w; }
struct EpiG1 {
    static constexpr bool WIDE = false;
    bf16_t* ZB;
    __device__ __forceinline__ void operator()(const f32x4 (&acc)[2][2][4][2], const Unit& u, int wr, int wc, int fr, int fq, const LAS float* sct) const {
        const int row0 = u.pm * BM + wr * 64 + fr;
#pragma unroll
        for (int ai = 0; ai < 2; ++ai)
#pragma unroll
            for (int m = 0; m < 4; ++m) { bf16_t* rowp = ZB + (size_t)(row0 + ai * HALF + m * 16) * 2048;
                if (u.pn < 8) { *(u32x4*)(rowp + u.pn * 128 + wc * 32 + 8 * fq) = pack_rows(acc[ai][0][m][0] * acc[ai][1][m][0], acc[ai][0][m][1] * acc[ai][1][m][1]); }
                else {
#pragma unroll
                    for (int bj = 0; bj < 2; ++bj) *(u32x4*)(rowp + D + (u.pn - 8) * BM + bj * HALF + wc * 32 + 8 * fq) = pack_rows(acc[ai][bj][m][0], acc[ai][bj][m][1]); } }
    }
};
template <bool SCALED> struct EpiRes {
    static constexpr bool WIDE = true;
    const bf16_t* res; bf16_t* X; unsigned char* XQ; const float* rinv; const float* gcol;
    __device__ __forceinline__ void operator()(const f32x4 (&acc)[2][2][4][2], const Unit& u, int wr, int wc, int fr, int fq, const LAS float* sct) const {
        const int row0 = u.pm * BM + wr * 64 + fr, col0 = u.pn * BM + wc * 64 + 16 * fq;
        float gi[2][8];
        if (SCALED) {
#pragma unroll
            for (int bj = 0; bj < 2; ++bj) { const f32x4 g0 = *(const f32x4*)(gcol + col0 + 8 * bj), g1 = *(const f32x4*)(gcol + col0 + 8 * bj + 4);
                gi[bj][0] = __builtin_amdgcn_rcpf(g0.x); gi[bj][1] = __builtin_amdgcn_rcpf(g0.y); gi[bj][2] = __builtin_amdgcn_rcpf(g0.z); gi[bj][3] = __builtin_amdgcn_rcpf(g0.w);
                gi[bj][4] = __builtin_amdgcn_rcpf(g1.x); gi[bj][5] = __builtin_amdgcn_rcpf(g1.y); gi[bj][6] = __builtin_amdgcn_rcpf(g1.z); gi[bj][7] = __builtin_amdgcn_rcpf(g1.w); } }
#pragma unroll
        for (int ai = 0; ai < 2; ++ai) {
            u32x4 rb[4][2]; float ri[4];
#pragma unroll
            for (int m = 0; m < 4; ++m) { const size_t off = (size_t)(row0 + ai * HALF + m * 16) * D + col0; ri[m] = SCALED ? rinv[row0 + ai * HALF + m * 16] : 1.0f;
#pragma unroll
                for (int bj = 0; bj < 2; ++bj) rb[m][bj] = __builtin_nontemporal_load((const u32x4*)(res + off + 8 * bj)); }
#pragma unroll
            for (int m = 0; m < 4; ++m) { const size_t off = (size_t)(row0 + ai * HALF + m * 16) * D + col0; u32x4 q;
#pragma unroll
                for (int bj = 0; bj < 2; ++bj) { float f[8]; unpack8(rb[m][bj], f);
                    if (SCALED) {
#pragma unroll
                        for (int e = 0; e < 8; ++e) f[e] = f[e] * ri[m] * gi[bj][e]; }
                    const f32x4 o0 = (f32x4){f[0], f[1], f[2], f[3]} + acc[ai][bj][m][0], o1 = (f32x4){f[4], f[5], f[6], f[7]} + acc[ai][bj][m][1];
                    *(u32x4*)(X + off + 8 * bj) = pack_rows(o0, o1);
                    q[2 * bj] = pk4_fp8(2.f * o0[0], 2.f * o0[1], 2.f * o0[2], 2.f * o0[3]); q[2 * bj + 1] = pk4_fp8(2.f * o1[0], 2.f * o1[1], 2.f * o1[2], 2.f * o1[3]); }
                *(u32x4*)(XQ + off) = q; }
        }
    }
};
struct EpiG3 {
    static constexpr bool WIDE = false;
    const float* lrs; unsigned char* H;
    __device__ __forceinline__ void operator()(const f32x4 (&acc)[2][2][4][2], const Unit& u, int wr, int wc, int fr, int fq, const LAS float* sct) const {
        float scv[2][4];
#pragma unroll
        for (int ai = 0; ai < 2; ++ai)
#pragma unroll
            for (int m = 0; m < 4; ++m) { const int r = ai * HALF + wr * 64 + m * 16 + fr; scv[ai][m] = sct[r]; }
#pragma unroll
        for (int ai = 0; ai < 2; ++ai)
#pragma unroll
            for (int m = 0; m < 4; ++m) { const int r = ai * HALF + wr * 64 + m * 16 + fr;
                if (r < u.nrows) { const float sc = scv[ai][m] * (1.0f / 64.0f); f32x4 o[2];
#pragma unroll
                    for (int n = 0; n < 2; ++n)
#pragma unroll
                        for (int j = 0; j < 4; ++j) o[n][j] = 4.0f * silu(sc * acc[ai][0][m][n][j]) * (sc * acc[ai][1][m][n][j]);
                    u32x2 q; q.x = pk4_fp8(o[0][0], o[0][1], o[0][2], o[0][3]); q.y = pk4_fp8(o[1][0], o[1][1], o[1][2], o[1][3]);
                    *(u32x2*)(H + (size_t)(u.slot0 + r) * F + u.pn * 128 + wc * 32 + 8 * fq) = q; } }
    }
};
struct EpiG4 {
    static constexpr bool WIDE = true;
    const float* lgate; unsigned char* YS;
    __device__ __forceinline__ void operator()(const f32x4 (&acc)[2][2][4][2], const Unit& u, int wr, int wc, int fr, int fq, const LAS float* sct) const {
        float gv[2][4];
#pragma unroll
        for (int ai = 0; ai < 2; ++ai)
#pragma unroll
            for (int m = 0; m < 4; ++m) { const int r = ai * HALF + wr * 64 + m * 16 + fr; gv[ai][m] = sct[r]; }
#pragma unroll
        for (int ai = 0; ai < 2; ++ai)
#pragma unroll
            for (int m = 0; m < 4; ++m) { const int r = ai * HALF + wr * 64 + m * 16 + fr;
                if (r < u.nrows) { const float g = gv[ai][m] * (16.0f / 128.0f);
                    u32x4 q;
#pragma unroll
                    for (int bj = 0; bj < 2; ++bj) { const f32x4 o0 = acc[ai][bj][m][0] * g, o1 = acc[ai][bj][m][1] * g; q[2 * bj] = pk4_fp8(o0[0], o0[1], o0[2], o0[3]); q[2 * bj + 1] = pk4_fp8(o1[0], o1[1], o1[2], o1[3]); }
                    *(u32x4*)(YS + (size_t)(u.slot0 + r) * D + u.pn * BM + wc * 64 + 16 * fq) = q; } }
    }
};
struct EpiG5 {
    static constexpr bool WIDE = true;
    const float* rs; const float* bias; bf16_t* UV; f32x2* lnp;
    __device__ __forceinline__ void operator()(const f32x4 (&acc)[2][2][4][2], const Unit& u, int wr, int wc, int fr, int fq, const LAS float* sct) const {
        const int row0 = u.pm * BM + wr * 64 + fr, col0 = u.pn * BM + wc * 64 + 16 * fq;
        f32x4 bv[2][2];
#pragma unroll
        for (int bj = 0; bj < 2; ++bj)
#pragma unroll
            for (int n = 0; n < 2; ++n) bv[bj][n] = *(const f32x4*)(bias + col0 + 8 * bj + 4 * n);
        float scv[2][4];
#pragma unroll
        for (int ai = 0; ai < 2; ++ai)
#pragma unroll
            for (int m = 0; m < 4; ++m) scv[ai][m] = rs[row0 + ai * HALF + m * 16];
#pragma unroll
        for (int ai = 0; ai < 2; ++ai)
#pragma unroll
            for (int m = 0; m < 4; ++m) { const int row = row0 + ai * HALF + m * 16; const float sc = scv[ai][m];
                float ps = 0.f, pq = 0.f;
#pragma unroll
                for (int bj = 0; bj < 2; ++bj) { f32x4 o[2];
#pragma unroll
                    for (int n = 0; n < 2; ++n)
#pragma unroll
                        for (int j = 0; j < 4; ++j) { o[n][j] = gelu_tanh(sc * acc[ai][bj][m][n][j] + bv[bj][n][j]); ps += o[n][j]; pq += o[n][j] * o[n][j]; }
                    *(u32x4*)(UV + (size_t)row * 2048 + col0 + 8 * bj) = pack_rows(o[0], o[1]); }
                if (u.pn >= 4) { ps += __shfl_xor(ps, 16); ps += __shfl_xor(ps, 32); pq += __shfl_xor(pq, 16); pq += __shfl_xor(pq, 32);
                    if (fq == 0) lnp[(size_t)row * 16 + (u.pn - 4) * 4 + wc] = (f32x2){ps, pq}; } }
    }
};

__device__ __forceinline__ void ph_prep_x(const float* __restrict__ x, const float* __restrict__ g, bf16_t* __restrict__ xn, float* __restrict__ rinv) {
    const int tid = phase_tid(), lane = tid & 63, gw = ((int)blockIdx.x * NT + tid) >> 6, ngw = ((int)gridDim.x * NT) >> 6;
    f32x4 gv[4];
#pragma unroll
    for (int j = 0; j < 4; ++j) gv[j] = ((const f32x4*)g)[lane + 64 * j];
    for (int row = gw; row < T; row += 2 * ngw) {
        const int row2 = row + ngw;
        const bool has2 = row2 < T;
        const f32x4* xr = (const f32x4*)(x + (size_t)row * D) + lane; const f32x4* xr2 = (const f32x4*)(x + (size_t)(has2 ? row2 : row) * D) + lane;
        f32x4 v[4], w[4]; float s = 0.f, s2 = 0.f;
#pragma unroll
        for (int j = 0; j < 4; ++j) { v[j] = __builtin_nontemporal_load(xr + 64 * j); w[j] = __builtin_nontemporal_load(xr2 + 64 * j); }
#pragma unroll
        for (int j = 0; j < 4; ++j) { s += (v[j].x * v[j].x + v[j].y * v[j].y) + (v[j].z * v[j].z + v[j].w * v[j].w); s2 += (w[j].x * w[j].x + w[j].y * w[j].y) + (w[j].z * w[j].z + w[j].w * w[j].w); }
        const float r = rsqrtf(wave_sum(s) * (1.0f / D) + EPS), r2 = rsqrtf(wave_sum(s2) * (1.0f / D) + EPS);
        if (lane == 0) { rinv[row] = 1.0f / r; if (has2) rinv[row2] = 1.0f / r2; }
        u32x2* o = (u32x2*)(xn + (size_t)row * D) + lane; u32x2* o2 = (u32x2*)(xn + (size_t)row2 * D) + lane;
#pragma unroll
        for (int j = 0; j < 4; ++j) { u32x2 q; q.x = pk2(v[j].x * r * gv[j].x, v[j].y * r * gv[j].y); q.y = pk2(v[j].z * r * gv[j].z, v[j].w * r * gv[j].w); o[64 * j] = q; }
        if (has2) {
#pragma unroll
            for (int j = 0; j < 4; ++j) { u32x2 q; q.x = pk2(w[j].x * r2 * gv[j].x, w[j].y * r2 * gv[j].y); q.y = pk2(w[j].z * r2 * gv[j].z, w[j].w * r2 * gv[j].w); o2[64 * j] = q; } }
    }
}
__device__ __forceinline__ int map_row(int mapkind, int n) {
    if (mapkind == 0) return n;
    if (mapkind == 1) { if (n < D) return 2 * D + n; const int ch = (n - D) & (D - 1), second = (n >= 2 * D); return 256 * (ch >> 7) + 128 * second + (ch & 127); }
    return 256 * (n >> 7) + (mapkind == 3 ? 128 : 0) + (n & 127);
}
struct TrItem { const float* src; int k0, n0; };
__device__ __forceinline__ void tr_load(const float* __restrict__ W, int N, int item, int lane, f32x4 (&v)[16]) {
    const int nblk = N / 64, kb = item / nblk, nb = item % nblk, k0 = 64 * kb, n0 = 64 * nb, kq = lane >> 4, nn = 4 * (lane & 15);
#pragma unroll
    for (int i = 0; i < 16; ++i) v[i] = __builtin_nontemporal_load((const f32x4*)(W + (size_t)(k0 + 4 * i + kq) * N + n0 + nn));
}
template <bool FP8OUT> __device__ __forceinline__ void tr_process(const f32x4 (&v)[16], int K, int N, void* __restrict__ WTv, int mapkind, const float* __restrict__ kscale, LAS float* scr, int item, int lane) {
    const int nblk = N / 64, kb = item / nblk, nb = item % nblk, k0 = 64 * kb, n0 = 64 * nb, kq = lane >> 4, nn = 4 * (lane & 15);
#pragma unroll
    for (int i = 0; i < 16; ++i) { const int kk = 4 * i + kq; const float sc = (kscale ? kscale[k0 + kk] : 1.0f) * (FP8OUT ? 32.0f : 1.0f); LAS float* d = scr + kk * 65 + nn;
        d[0] = v[i].x * sc; d[1] = v[i].y * sc; d[2] = v[i].z * sc; d[3] = v[i].w * sc; }
    LDS_WAIT();
    if constexpr (!FP8OUT) {
        bf16_t* WT = (bf16_t*)WTv; const int c = lane & 7;
#pragma unroll
        for (int j = 0; j < 8; ++j) { const int n = (lane >> 3) + 8 * j; const LAS float* sp = scr + (8 * c) * 65 + n;
            u32x4 o; o.x = pk2(sp[0 * 65], sp[1 * 65]); o.y = pk2(sp[2 * 65], sp[3 * 65]); o.z = pk2(sp[4 * 65], sp[5 * 65]); o.w = pk2(sp[6 * 65], sp[7 * 65]);
            *(u32x4*)(WT + (size_t)map_row(mapkind, n0 + n) * K + k0 + 8 * c) = o; }
    } else {
        unsigned char* WT = (unsigned char*)WTv; const int c = lane & 3;
#pragma unroll
        for (int j = 0; j < 4; ++j) { const int n = (lane >> 2) + 16 * j; const LAS float* sp = scr + (16 * c) * 65 + n;
            u32x4 o; o.x = pk4_fp8(sp[0 * 65], sp[1 * 65], sp[2 * 65], sp[3 * 65]); o.y = pk4_fp8(sp[4 * 65], sp[5 * 65], sp[6 * 65], sp[7 * 65]);
            o.z = pk4_fp8(sp[8 * 65], sp[9 * 65], sp[10 * 65], sp[11 * 65]); o.w = pk4_fp8(sp[12 * 65], sp[13 * 65], sp[14 * 65], sp[15 * 65]);
            *(u32x4*)(WT + (size_t)map_row(mapkind, n0 + n) * K + k0 + 16 * c) = o; }
    }
    LDS_WAIT();
}
template <bool FP8OUT> __device__ __forceinline__ void ph_transpose(LAS unsigned char* lds, const float* W, int K, int N, void* WT, int mapkind, const float* kscale, int nbatch, size_t sstride, size_t dstride) {
    const int tid = phase_tid(), lane = tid & 63, wave = tid >> 6, gw = (int)blockIdx.x * NWAVES + wave, ngw = (int)gridDim.x * NWAVES;
    LAS float* scr = (LAS float*)(lds + wave * 16640);
    const int per = (K / 64) * (N / 64), nitems = per * nbatch;
    f32x4 v[16], vn[16];
    int it = gw;
    if (it < nitems) tr_load(W + (size_t)(it / per) * sstride, N, it % per, lane, v);
    while (it < nitems) {
        const int nx = it + ngw;
        if (nx < nitems) tr_load(W + (size_t)(nx / per) * sstride, N, nx % per, lane, vn);
        tr_process<FP8OUT>(v, K, N, (unsigned char*)WT + (size_t)(it / per) * dstride * (FP8OUT ? 1 : 2), mapkind, kscale, scr, it % per, lane);
#pragma unroll
        for (int i = 0; i < 16; ++i) v[i] = vn[i];
        it = nx;
    }
}
__device__ __forceinline__ void ph_prep_experts(LAS unsigned char* lds, int layer, const float* w_gate, const float* w_up, const float* w_down, const float* ln2, unsigned char* WGU, unsigned char* WD) {
    ph_transpose<true>(lds, w_gate + (size_t)layer * NE * D * F, D, F, WGU, 2, ln2 + layer * D, NE, (size_t)D * F, (size_t)1024 * D);
    ph_transpose<true>(lds, w_up + (size_t)layer * NE * D * F, D, F, WGU, 3, ln2 + layer * D, NE, (size_t)D * F, (size_t)1024 * D);
    ph_transpose<true>(lds, w_down + (size_t)layer * NE * F * D, F, D, WD, 0, nullptr, NE, (size_t)F * D, (size_t)D * F);
}
__device__ __forceinline__ void ph_prep_router(const float* __restrict__ ln2, const float* __restrict__ wg, const float* __restrict__ we, bf16_t* __restrict__ wr) {
    for (int i = (int)blockIdx.x * NT + phase_tid(); i < 2 * 48 * D; i += (int)gridDim.x * NT) {
        const int l = i / (48 * D), j = (i / D) % 48, k = i % D;
        float w = 0.f;
        if (j < 4) w = wg[((size_t)l * D + k) * NG + j]; else if (j < 36) w = we[((size_t)l * D + k) * NE + (j - 4)];
        w *= ln2[l * D + k];
        const unsigned hi = f2bf(w); const unsigned lo = f2bf(w - bf2f(hi));
        wr[((size_t)l * 2 + 0) * 48 * D + (size_t)j * D + k] = (bf16_t)hi; wr[((size_t)l * 2 + 1) * 48 * D + (size_t)j * D + k] = (bf16_t)lo;
    }
}
__device__ __forceinline__ void ph_prep_wm(const float* __restrict__ ws, bf16_t* __restrict__ wm) {
    for (int i = (int)blockIdx.x * NT + phase_tid(); i < NH * CHUNK * CHUNK; i += (int)gridDim.x * NT) { const int t = (i / CHUNK) % CHUNK, s = i % CHUNK; wm[i] = (bf16_t)f2bf(t >= s ? ws[i] : 0.f); }
}
__device__ __forceinline__ void ph_conv(const bf16_t* __restrict__ ZB, const float* __restrict__ cw, bf16_t* __restrict__ Y) {
    constexpr int RB = 8;
    const int nitems = (T / RB) * (D / 8);
    for (int it = (int)blockIdx.x * NT + phase_tid(); it < nitems; it += (int)gridDim.x * NT) {
        const int cg8 = it & 127, rb = it >> 7, r0 = rb * RB, ch = cg8 * 8, t0 = r0 & (SEQ - 1);
        float w[3][8];
#pragma unroll
        for (int k = 0; k < 3; ++k)
#pragma unroll
            for (int i = 0; i < 8; ++i) w[k][i] = cw[k * D + ch + i];
        float zm2[8], zm1[8];
        if (t0 >= 2) { unpack8(__builtin_nontemporal_load((const u32x4*)(ZB + (size_t)(r0 - 2) * 2048 + ch)), zm2); unpack8(__builtin_nontemporal_load((const u32x4*)(ZB + (size_t)(r0 - 1) * 2048 + ch)), zm1); }
        else {
#pragma unroll
            for (int i = 0; i < 8; ++i) { zm2[i] = 0.f; zm1[i] = 0.f; } }
#pragma unroll
        for (int r = 0; r < RB; ++r) {
            float z[8], b[8], o[8];
            unpack8(__builtin_nontemporal_load((const u32x4*)(ZB + (size_t)(r0 + r) * 2048 + ch)), z); unpack8(__builtin_nontemporal_load((const u32x4*)(ZB + (size_t)(r0 + r) * 2048 + D + ch)), b);
#pragma unroll
            for (int i = 0; i < 8; ++i) { o[i] = b[i] * (w[0][i] * zm2[i] + w[1][i] * zm1[i] + w[2][i] * z[i]); zm2[i] = zm1[i]; zm1[i] = z[i]; }
            *(u32x4*)(Y + (size_t)(r0 + r) * D + ch) = pack8(o);
        }
    }
}
__device__ __forceinline__ void ph_route(LAS unsigned char* lds, const bf16_t* __restrict__ X, const bf16_t* __restrict__ wrh, const float* __restrict__ bg, const float* __restrict__ be,
                                         unsigned* __restrict__ cnt, unsigned* __restrict__ asg, int* __restrict__ ltok, float* __restrict__ lgate, float* __restrict__ lrs) {
    const int tid = phase_tid(), wave = tid >> 6, lane = tid & 63, fr = lane & 15, fq = lane >> 4;
    LAS float* lgs = (LAS float*)(lds + wave * 4096);
    LAS int* s_e = (LAS int*)(lds + 32768); LAS float* s_g = (LAS float*)(lds + 32768 + 1024); LAS float* s_r = (LAS float*)(lds + 32768 + 2048);
    LAS unsigned* s_cnt = (LAS unsigned*)(lds + 32768 + 3072); LAS unsigned* s_base = (LAS unsigned*)(lds + 32768 + 3200); LAS unsigned* s_rank = (LAS unsigned*)(lds + 32768 + 3328);
    const bf16_t* wrl = wrh + 48 * D;
    for (int tb = (int)blockIdx.x * 128; tb < T; tb += (int)gridDim.x * 128) {
        if (tid < NE) s_cnt[tid] = 0u;
        const int tok0 = tb + wave * 16;
        f32x4 acc[3]; float ss = 0.f;
#pragma unroll
        for (int n = 0; n < 3; ++n) acc[n] = (f32x4){0.f, 0.f, 0.f, 0.f};
        constexpr int WCH_PITCH = 272, WCH_BYTES = 2 * 48 * WCH_PITCH;
        LAS unsigned char* wbuf = lds + 49152;
        u32x4 wreg[3], araw[4];
#pragma unroll
        for (int p = 0; p < 3; ++p) { const int pc = tid + 512 * p, hl = pc / 768, row = (pc % 768) >> 4, kc = pc & 15; wreg[p] = *(const u32x4*)(wrh + (size_t)hl * 48 * D + (size_t)row * D + kc * 8); }
#pragma unroll
        for (int q = 0; q < 4; ++q) araw[q] = *(const u32x4*)(X + (size_t)(tok0 + fr) * D + q * 32 + fq * 8);
#pragma unroll 1
        for (int kb = 0; kb < D / 128; ++kb) {
            LAS unsigned char* wb = wbuf + (kb & 1) * WCH_BYTES;
#pragma unroll
            for (int p = 0; p < 3; ++p) { const int pc = tid + 512 * p, hl = pc / 768, row = (pc % 768) >> 4, kc = pc & 15; *(LAS u32x4*)(wb + (hl * 48 + row) * WCH_PITCH + kc * 16) = wreg[p]; }
            u32x4 acur[4];
#pragma unroll
            for (int q = 0; q < 4; ++q) acur[q] = araw[q];
            __syncthreads();
            if (kb + 1 < D / 128) {
#pragma unroll
                for (int p = 0; p < 3; ++p) { const int pc = tid + 512 * p, hl = pc / 768, row = (pc % 768) >> 4, kc = pc & 15; wreg[p] = *(const u32x4*)(wrh + (size_t)hl * 48 * D + (size_t)row * D + (kb + 1) * 128 + kc * 8); }
#pragma unroll
                for (int q = 0; q < 4; ++q) araw[q] = *(const u32x4*)(X + (size_t)(tok0 + fr) * D + ((kb + 1) * 4 + q) * 32 + fq * 8);
            }
#pragma unroll
            for (int q = 0; q < 4; ++q) {
                float af[8]; unpack8(acur[q], af);
#pragma unroll
                for (int e = 0; e < 8; ++e) ss += af[e] * af[e];
                const bf16x8 a = __builtin_bit_cast(bf16x8, acur[q]);
#pragma unroll
                for (int n = 0; n < 3; ++n) {
                    const bf16x8 bh = *(const LAS bf16x8*)(wb + (n * 16 + fr) * WCH_PITCH + (q * 32 + fq * 8) * 2);
                    const bf16x8 bl = *(const LAS bf16x8*)(wb + (48 + n * 16 + fr) * WCH_PITCH + (q * 32 + fq * 8) * 2);
                    acc[n] = __builtin_amdgcn_mfma_f32_16x16x32_bf16(a, bh, acc[n], 0, 0, 0); acc[n] = __builtin_amdgcn_mfma_f32_16x16x32_bf16(a, bl, acc[n], 0, 0, 0); }
            }
        }
        __syncthreads();
        ss += __shfl_xor(ss, 16); ss += __shfl_xor(ss, 32);
#pragma unroll
        for (int n = 0; n < 3; ++n)
#pragma unroll
            for (int j = 0; j < 4; ++j) lgs[(fq * 4 + j) * 49 + n * 16 + fr] = acc[n][j];
        if (fq == 0) lgs[16 * 49 + fr] = rsqrtf(ss * (1.0f / D) + EPS);
        LDS_WAIT();
        if (lane < 16) {
            const float r = lgs[16 * 49 + lane]; const LAS float* L = lgs + lane * 49;
            float lg[36];
#pragma unroll
            for (int j = 0; j < 36; ++j) lg[j] = L[j] * r + (j < 4 ? bg[j] : be[j - 4]);
            int gi = 0; float gm = lg[0];
#pragma unroll
            for (int j = 1; j < 4; ++j) if (lg[j] > gm) { gm = lg[j]; gi = j; }
            float gs = 0.f;
#pragma unroll
            for (int j = 0; j < 4; ++j) gs += __expf(lg[j] - gm);
            const float gp = 1.0f / gs;
            float el[8];
#pragma unroll
            for (int j = 0; j < 8; ++j) { el[j] = lg[4 + j];
#pragma unroll
                for (int g = 1; g < 4; ++g) el[j] = (gi == g) ? lg[4 + g * 8 + j] : el[j]; }
            int i0 = 0; float m0 = el[0];
#pragma unroll
            for (int j = 1; j < 8; ++j) if (el[j] > m0) { m0 = el[j]; i0 = j; }
            int i1 = 0; float m1 = -3.0e38f;
#pragma unroll
            for (int j = 0; j < 8; ++j) if (j != i0 && el[j] > m1) { m1 = el[j]; i1 = j; }
            const float eb = __expf(m1 - m0), den = 1.0f / (1.0f + eb);
            const int tl = wave * 16 + lane;
            s_e[2 * tl] = gi * 8 + i0; s_e[2 * tl + 1] = gi * 8 + i1; s_g[2 * tl] = gp * den; s_g[2 * tl + 1] = gp * eb * den; s_r[tl] = r;
        }
        __syncthreads();
        if (tid < 256) s_rank[tid] = atomicAdd((unsigned*)&s_cnt[s_e[tid]], 1u);
        __syncthreads();
        if (tid < NE) s_base[tid] = s_cnt[tid] ? atomicAdd(&cnt[tid], s_cnt[tid]) : 0u;
        __syncthreads();
        if (tid < 256) { const int e = s_e[tid], tok = tb + (tid >> 1); const unsigned pos = s_base[e] + s_rank[tid];
            ltok[(size_t)e * T + pos] = tok; lgate[(size_t)e * T + pos] = s_g[tid]; lrs[(size_t)e * T + pos] = s_r[tid >> 1];
            asg[(size_t)tok * 4 + (tid & 1) * 2] = ((unsigned)e << 24) | pos; asg[(size_t)tok * 4 + (tid & 1) * 2 + 1] = __float_as_uint(s_g[tid]); }
        __syncthreads();
    }
}
__device__ __forceinline__ int build_tile_table(LAS unsigned char* lds, const unsigned* __restrict__ cnt) {
    LAS int* tab = (LAS int*)(lds + TAB_OFF); LAS int* tabn = (LAS int*)(lds + TABN_OFF);
    const int tid = phase_tid();
    if (tid < NE) {
        int bacc = 0, sacc_small = 0, sacc = 0, mine = 0, nbig_all = 0, nsmall_all = 0;
        for (int e = 0; e < NE; ++e) { const int n = (int)cnt[e], full = n / BM, rem = n % BM, nb = full + (rem > HALF ? 1 : 0), ns = (rem > 0 && rem <= HALF) ? 1 : 0;
            if (e == tid) mine = n; if (e < tid) { bacc += nb; sacc_small += ns; sacc += n; } nbig_all += nb; nsmall_all += ns; }
        const int full = mine / BM, rem = mine % BM, nb = full + (rem > HALF ? 1 : 0);
        for (int j = 0; j < nb; ++j) { const int ti = bacc + j; if (ti < TAB_MAX) { tab[ti * 4 + 0] = tid; tab[ti * 4 + 1] = j * BM; tab[ti * 4 + 2] = min(BM, mine - j * BM); tab[ti * 4 + 3] = sacc + j * BM; } }
        if (rem > 0 && rem <= HALF) { const int ti = nbig_all + sacc_small; if (ti < TAB_MAX) { tab[ti * 4 + 0] = tid; tab[ti * 4 + 1] = full * BM; tab[ti * 4 + 2] = rem; tab[ti * 4 + 3] = sacc + full * BM; } }
        if (tid == NE - 1) tabn[0] = min(nbig_all + nsmall_all, TAB_MAX);
    }
    __syncthreads();
    return __builtin_amdgcn_readfirstlane(tabn[0]);
}
template <bool FINAL> __device__ __forceinline__ void ph_combine(const bf16_t* __restrict__ X, const unsigned char* __restrict__ YS, const unsigned* __restrict__ cnt, const unsigned* __restrict__ asg,
                                                                 bf16_t* __restrict__ Xo, float* __restrict__ rs, const float* __restrict__ g, float* __restrict__ out) {
    const int tid = phase_tid(), lane = tid & 63, gw = ((int)blockIdx.x * NT + tid) >> 6, ngw = ((int)gridDim.x * NT) >> 6;
    unsigned c = lane < NE ? cnt[lane] : 0u, inc = c;
#pragma unroll
    for (int o = 1; o < 32; o <<= 1) { const unsigned t = __shfl_up(inc, o); if (lane >= o) inc += t; }
    const unsigned excl = inc - c;
    for (int rowb = gw; rowb < T; rowb += 2 * ngw) {
        int rows[2]; rows[0] = rowb; rows[1] = (rowb + ngw < T) ? rowb + ngw : rowb;
        unsigned sa[2], sb[2];
#pragma unroll
        for (int q = 0; q < 2; ++q) { const u32x4 cw = *(const u32x4*)(asg + (size_t)rows[q] * 4); sa[q] = __shfl(excl, (int)(cw.x >> 24)) + (cw.x & 0xffffffu); sb[q] = __shfl(excl, (int)(cw.z >> 24)) + (cw.z & 0xffffffu); }
        u32x4 xr[2][2]; u32x2 ar[2][2], br[2][2];
#pragma unroll
        for (int q = 0; q < 2; ++q)
#pragma unroll
            for (int h = 0; h < 2; ++h) { xr[q][h] = __builtin_nontemporal_load((const u32x4*)(X + (size_t)rows[q] * D + h * 512 + lane * 8)); ar[q][h] = __builtin_nontemporal_load((const u32x2*)(YS + (size_t)sa[q] * D + h * 512 + lane * 8)); br[q][h] = __builtin_nontemporal_load((const u32x2*)(YS + (size_t)sb[q] * D + h * 512 + lane * 8)); }
#pragma unroll
        for (int q = 0; q < 2; ++q) {
            if (q == 1 && rows[1] == rows[0]) break;
            const int row = rows[q];
            float v[16];
#pragma unroll
            for (int h = 0; h < 2; ++h) { float x8[8], a[8], b[8]; unpack8(xr[q][h], x8); unpack8_fp8(ar[q][h], a); unpack8_fp8(br[q][h], b);
#pragma unroll
                for (int i = 0; i < 8; ++i) v[h * 8 + i] = x8[i] + (a[i] + b[i]) * (1.0f / 16.0f); }
            if (!FINAL) {
                float ss = 0.f;
#pragma unroll
                for (int h = 0; h < 2; ++h) { float o8[8];
#pragma unroll
                    for (int i = 0; i < 8; ++i) { o8[i] = bf2f(f2bf(v[h * 8 + i])); ss += o8[i] * o8[i]; }
                    *(u32x4*)(Xo + (size_t)row * D + h * 512 + lane * 8) = pack8(o8); }
                const float r = rsqrtf(wave_sum(ss) * (1.0f / D) + EPS);
                if (lane == 0) rs[row] = r;
            } else {
                float ss = 0.f;
#pragma unroll
                for (int i = 0; i < 16; ++i) ss += v[i] * v[i];
                const float r = rsqrtf(wave_sum(ss) * (1.0f / D) + EPS);
#pragma unroll
                for (int h = 0; h < 2; ++h) { const f32x4 g0 = *(const f32x4*)(g + h * 512 + lane * 8), g1 = *(const f32x4*)(g + h * 512 + lane * 8 + 4);
                    f32x4 o0, o1; o0.x = v[h * 8 + 0] * r * g0.x; o0.y = v[h * 8 + 1] * r * g0.y; o0.z = v[h * 8 + 2] * r * g0.z; o0.w = v[h * 8 + 3] * r * g0.w;
                    o1.x = v[h * 8 + 4] * r * g1.x; o1.y = v[h * 8 + 5] * r * g1.y; o1.z = v[h * 8 + 6] * r * g1.z; o1.w = v[h * 8 + 7] * r * g1.w;
                    __builtin_nontemporal_store(o0, (f32x4*)(out + (size_t)row * D + h * 512 + lane * 8)); __builtin_nontemporal_store(o1, (f32x4*)(out + (size_t)row * D + h * 512 + lane * 8 + 4)); }
            }
        }
    }
}
constexpr int MIX_PITCH = 272, MIX_BUF = CHUNK * MIX_PITCH, MIX_STAT_OFF = 2 * MIX_BUF;
typedef short s16x4 __attribute__((ext_vector_type(4)));
__device__ __forceinline__ void ph_mix(LAS unsigned char* lds, const bf16_t* __restrict__ UV, const f32x2* __restrict__ lnp, const float* __restrict__ vg, const float* __restrict__ vbeta,
                                       const bf16_t* __restrict__ wm, const float* __restrict__ bs, bf16_t* __restrict__ YM) {
    const int tid = phase_tid(), wave = tid >> 6, lane = tid & 63, fr = lane & 15, fq = lane >> 4, wt = wave >> 1, wd = wave & 1;
    LAS float* stat = (LAS float*)(lds + MIX_STAT_OFF);
    const int ch = tid & 15, srow = tid >> 4;
    const int cgrp = ch >> 2, ca = ch & 3;
    for (int bc = (int)blockIdx.x; bc < T / CHUNK; bc += (int)gridDim.x) {
        const int row0 = bc * CHUNK;
        if (tid < CHUNK) { const f32x4* pp = (const f32x4*)(lnp + (size_t)(row0 + tid) * 16); float sm = 0.f, sq = 0.f;
#pragma unroll
            for (int i = 0; i < 8; ++i) { const f32x4 pv = pp[i]; sm += pv.x + pv.z; sq += pv.y + pv.w; }
            const float mu = sm * (1.0f / D), var = fmaxf(sq * (1.0f / D) - mu * mu, 0.f);
            stat[2 * tid] = mu; stat[2 * tid + 1] = rsqrtf(var + EPS); }
        __syncthreads();
        u32x4 vraw[4];
#pragma unroll
        for (int p = 0; p < 4; ++p) vraw[p] = __builtin_nontemporal_load((const u32x4*)(UV + (size_t)(row0 + srow + 32 * p) * 2048 + D + 0 * 128 + 8 * ch));
#pragma unroll 1
        for (int h = 0; h < NH; ++h) {
            LAS unsigned char* buf = lds + (h & 1) * MIX_BUF;
            float g8[8], b8[8];
            { const f32x4 ga = *(const f32x4*)(vg + h * 128 + 8 * ch), gb = *(const f32x4*)(vg + h * 128 + 8 * ch + 4), ba = *(const f32x4*)(vbeta + h * 128 + 8 * ch), bb = *(const f32x4*)(vbeta + h * 128 + 8 * ch + 4);
              g8[0] = ga.x; g8[1] = ga.y; g8[2] = ga.z; g8[3] = ga.w; g8[4] = gb.x; g8[5] = gb.y; g8[6] = gb.z; g8[7] = gb.w;
              b8[0] = ba.x; b8[1] = ba.y; b8[2] = ba.z; b8[3] = ba.w; b8[4] = bb.x; b8[5] = bb.y; b8[6] = bb.z; b8[7] = bb.w; }
#pragma unroll
            for (int p = 0; p < 4; ++p) { const int sr = srow + 32 * p; float v[8]; unpack8(vraw[p], v);
                const float mu = stat[2 * sr], rstd = stat[2 * sr + 1];
#pragma unroll
                for (int q = 0; q < 8; ++q) v[q] = (v[q] - mu) * rstd * g8[q] + b8[q];
                u32x2 lo, hi; lo.x = pk2(v[0], v[1]); lo.y = pk2(v[2], v[3]); hi.x = pk2(v[4], v[5]); hi.y = pk2(v[6], v[7]);
                *(LAS u32x2*)(buf + sr * MIX_PITCH + (32 * cgrp + 4 * ca) * 2) = lo; *(LAS u32x2*)(buf + sr * MIX_PITCH + (32 * cgrp + 16 + 4 * ca) * 2) = hi; }
            __syncthreads();
            if (h + 1 < NH) {
#pragma unroll
                for (int p = 0; p < 4; ++p) vraw[p] = __builtin_nontemporal_load((const u32x4*)(UV + (size_t)(row0 + srow + 32 * p) * 2048 + D + (h + 1) * 128 + 8 * ch)); }
            u32x4 uraw[2][2]; float bsv[2];
#pragma unroll
            for (int m = 0; m < 2; ++m) { const int t = 32 * wt + 16 * m + fr; bsv[m] = bs[h * CHUNK + t];
#pragma unroll
                for (int cc = 0; cc < 2; ++cc) uraw[m][cc] = __builtin_nontemporal_load((const u32x4*)(UV + (size_t)(row0 + t) * 2048 + h * 128 + 32 * (2 * wd + cc) + 8 * fq)); }
            bf16x8 af[4][2];
#pragma unroll
            for (int kk = 0; kk < 4; ++kk)
#pragma unroll
                for (int m = 0; m < 2; ++m) af[kk][m] = *(const bf16x8*)(wm + ((size_t)(h * CHUNK + 32 * wt + 16 * m + fr)) * CHUNK + 32 * (kk <= wt ? kk : wt) + 8 * fq);
            f32x4 acc[2][4];
#pragma unroll
            for (int m = 0; m < 2; ++m)
#pragma unroll
                for (int n = 0; n < 4; ++n) acc[m][n] = (f32x4){0.f, 0.f, 0.f, 0.f};
            const int q4 = (lane & 15) >> 2, p4 = lane & 3;
#pragma unroll
            for (int kk = 0; kk < 4; ++kk) {
                if (kk <= wt) {
#pragma unroll
                    for (int n = 0; n < 4; ++n) {
                        const int colpos = 32 * (2 * wd + (n >> 1)) + 16 * (n & 1);
                        LAS unsigned char* base = buf + (32 * kk + 8 * fq + q4) * MIX_PITCH + colpos * 2 + 8 * p4;
                        const s16x4 t0 = __builtin_amdgcn_ds_read_tr16_b64_v4i16((LAS s16x4*)base);
                        const s16x4 t1 = __builtin_amdgcn_ds_read_tr16_b64_v4i16((LAS s16x4*)(base + 4 * MIX_PITCH));
                        bf16x8 bfrag; bfrag[0] = t0[0]; bfrag[1] = t0[1]; bfrag[2] = t0[2]; bfrag[3] = t0[3]; bfrag[4] = t1[0]; bfrag[5] = t1[1]; bfrag[6] = t1[2]; bfrag[7] = t1[3];
#pragma unroll
                        for (int m = 0; m < 2; ++m) acc[m][n] = __builtin_amdgcn_mfma_f32_16x16x32_bf16(bfrag, af[kk][m], acc[m][n], 0, 0, 0);
                    }
                }
            }
#pragma unroll
            for (int m = 0; m < 2; ++m) { const int t = 32 * wt + 16 * m + fr;
#pragma unroll
                for (int cc = 0; cc < 2; ++cc) { const int col = h * 128 + 32 * (2 * wd + cc) + 8 * fq; float u8[8], o8[8];
                    unpack8(uraw[m][cc], u8);
#pragma unroll
                    for (int n = 0; n < 2; ++n)
#pragma unroll
                        for (int r = 0; r < 4; ++r) o8[4 * n + r] = u8[4 * n + r] * (acc[m][2 * cc + n][r] + bsv[m]);
                    *(u32x4*)(YM + (size_t)(row0 + t) * D + col) = pack8(o8); } }
        }
        __syncthreads();
    }
}

#define XB_TMO      128
#define XB_XCNT(j)  (256  + 64 * (j))
#define XB_XSUB(j)  (1280 + 64 * (j))
#define XB_XGEN(j)  (2304 + 64 * (j))
#define XB_TOP      3328
#define XB_TOPGEN   3392
#define XCD_BAR_WORDS 3456
#define XB_SPIN_CAP (1u << 22)
__device__ __forceinline__ unsigned xb_ld(unsigned* p)              { return __hip_atomic_load(p, __ATOMIC_RELAXED, __HIP_MEMORY_SCOPE_AGENT); }
__device__ __forceinline__ unsigned xb_add(unsigned* p, unsigned v) { return __hip_atomic_fetch_add(p, v, __ATOMIC_RELAXED, __HIP_MEMORY_SCOPE_AGENT); }
__device__ __forceinline__ unsigned xb_xcc_id() { return (unsigned)__builtin_amdgcn_s_getreg((3 << 11) | 20) & 0xFu; }
#define XB_SPIN(cond, bar) do { unsigned _sp = 0; while (cond) { __builtin_amdgcn_s_sleep(1); \
    if ((++_sp & 255u) == 0u) { if (xb_ld(&(bar)[XB_TMO])) break; if (_sp > XB_SPIN_CAP) { atomicAdd(&(bar)[XB_TMO], 1u); break; } } } } while (0)
struct XcdBarrier { unsigned* bar; unsigned x; volatile LAS unsigned* st; };
__device__ __forceinline__ XcdBarrier xcd_barrier_post(unsigned* bar, volatile LAS unsigned* st) {
    XcdBarrier b; b.bar = bar; b.x = xb_xcc_id(); b.st = st;
    if (threadIdx.x == 0) (void)xb_add(&bar[XB_XCNT(b.x)], 1u);
    return b;
}
__device__ __forceinline__ void xcd_barrier_complete(unsigned* bar, unsigned x, unsigned& nloc, unsigned& nx) {
    const unsigned G = gridDim.x * gridDim.y * gridDim.z;
    unsigned sum, cnt, mine, sp = 0u;
    for (;;) {
        sum = 0u; cnt = 0u; mine = 0u;
#pragma unroll
        for (unsigned j = 0; j < 16; ++j) { const unsigned c = xb_ld(&bar[XB_XCNT(j)]); sum += c; cnt += (c > 0u) ? 1u : 0u; mine = (j == x) ? c : mine; }
        if (sum == G) break;
        __builtin_amdgcn_s_sleep(1);
        if ((++sp & 255u) == 0u) { if (xb_ld(&bar[XB_TMO])) break; if (sp > XB_SPIN_CAP) { atomicAdd(&bar[XB_TMO], 1u); break; } }
    }
    nloc = mine > 0u ? mine : 1u; nx = cnt > 0u ? cnt : 1u;
}
__device__ __forceinline__ void xcd_barrier(const XcdBarrier& b) {
    asm volatile("s_waitcnt vmcnt(0)" ::: "memory");
    __syncthreads();
    if (threadIdx.x == 0) {
        unsigned* bar = b.bar;
        __builtin_amdgcn_s_waitcnt(0);
        unsigned nloc = b.st[0], nx = b.st[1];
        if (nloc == 0u) { xcd_barrier_complete(bar, b.x, nloc, nx); b.st[0] = nloc; b.st[1] = nx; }
        const unsigned old = xb_add(&bar[XB_XSUB(b.x)], 1u);
        const unsigned gen = old / nloc;
        if (old + 1u == (gen + 1u) * nloc) {
            __builtin_amdgcn_fence(__ATOMIC_RELEASE, "agent");
            asm volatile("s_waitcnt vmcnt(0)" ::: "memory");
            const unsigned og = xb_add(&bar[XB_TOP], 1u);
            const unsigned tg = og / nx;
            if (og + 1u == (tg + 1u) * nx) xb_add(&bar[XB_TOPGEN], 1u);
            else XB_SPIN(xb_ld(&bar[XB_TOPGEN]) == tg, bar);
            __builtin_amdgcn_fence(__ATOMIC_ACQUIRE, "agent");
            xb_add(&bar[XB_XGEN(b.x)], 1u);
            asm volatile("s_waitcnt vmcnt(0)" ::: "memory");
        } else {
            XB_SPIN(xb_ld(&bar[XB_XGEN(b.x)]) == gen, bar);
            __builtin_amdgcn_fence(__ATOMIC_ACQUIRE, "agent");
            asm volatile("s_waitcnt vmcnt(0)" ::: "memory");
        }
    }
    __syncthreads();
}

#ifndef REP_PREP
#define REP_PREP 1
#endif
#ifndef REP_THIN
#define REP_THIN 1
#endif
#ifndef REP_GEMM
#define REP_GEMM 1
#endif
#ifndef REP_SYNC
#define REP_SYNC 1
#endif
#define REPEAT(n, ...) for (int rep_ = 0; rep_ < (n); ++rep_) { __VA_ARGS__; if (rep_ + 1 < (n)) xcd_barrier(xbar); }
#define GSYNC() do { for (int rs_ = 0; rs_ < REP_SYNC; ++rs_) xcd_barrier(xbar); } while (0)
struct Params { const float* in[22]; float* out; unsigned char* ws; };
__global__ void __launch_bounds__(NT, 2) mega_fwd(Params P) {
    extern __shared__ __attribute__((aligned(16))) unsigned char lds_raw[];
    LAS unsigned char* lds = (LAS unsigned char*)lds_raw;
    cg::grid_group grid = cg::this_grid();
    const int G = (int)gridDim.x, bid = (int)blockIdx.x;
    if (P.ws == nullptr) grid.sync();
    if (threadIdx.x < 4) ((LAS unsigned*)(lds + BARST_OFF))[threadIdx.x] = 0u;
    __syncthreads();
    const XcdBarrier xbar = xcd_barrier_post((unsigned*)(P.ws + WS_CTL) + CW_BAR, (volatile LAS unsigned*)(lds + BARST_OFF));
    const float* x = P.in[0]; const float* ln_a = P.in[1]; const float* w_in_a = P.in[2]; const float* conv_w = P.in[3];
    const float* w_out_a = P.in[4]; const float* ln_b = P.in[5]; const float* w_in_b = P.in[6]; const float* b_in_b = P.in[7];
    const float* v_ln_g = P.in[8]; const float* v_ln_b = P.in[9]; const float* w_s = P.in[10]; const float* b_s = P.in[11];
    const float* w_out_b = P.in[12]; const float* ln2 = P.in[13]; const float* w_group = P.in[14]; const float* b_group = P.in[15];
    const float* w_expert = P.in[16]; const float* b_expert = P.in[17]; const float* w_gate = P.in[18]; const float* w_up = P.in[19];
    const float* w_down = P.in[20]; const float* ln_f = P.in[21];
    unsigned char* ws = P.ws; float* out = P.out;
    unsigned* ctl = (unsigned*)(ws + WS_CTL); float* RS = (float*)(ws + WS_RS); unsigned* ASG = (unsigned*)(ws + WS_ASG); float* LNS = (float*)(ws + WS_LNS);
    int* LTOK = (int*)(ws + WS_LTOK); float* LGATE = (float*)(ws + WS_LGATE); float* LRS = (float*)(ws + WS_LRS); bf16_t* WR = (bf16_t*)(ws + WS_WR); bf16_t* WM = (bf16_t*)(ws + WS_WM);
    bf16_t* WA_IN = (bf16_t*)(ws + WS_WA_IN); bf16_t* WA_OUT = (bf16_t*)(ws + WS_WA_OUT); bf16_t* WB_IN = (bf16_t*)(ws + WS_WB_IN); bf16_t* WB_OUT = (bf16_t*)(ws + WS_WB_OUT);
    unsigned char* WGU = ws + WS_WGU; unsigned char* WD = ws + WS_WD; unsigned char* XQ = ws + WS_XQ;
    bf16_t* bufA = (bf16_t*)(ws + WS_A); bf16_t* bufB = (bf16_t*)(ws + WS_B); bf16_t* bufC = (bf16_t*)(ws + WS_C); bf16_t* bufD = (bf16_t*)(ws + WS_D);

#define DENSE_GEMM(EPI_T, epi_init, Aptr, Bptr, NCOLS) do { DenseSched S{T / BM, (NCOLS) / BM, G, bid, D, (Bptr)}; EPI_T E epi_init; gemm_phase<EPI_T, DenseSched>(lds, (Aptr), D, S, E); } while (0)
#define MOE_PHASES(layer, Xin, Hb) do { \
        unsigned* cnt_ = ctl + CW_CNT + (layer) * NE; \
        ph_route(lds, (Xin), WR + (size_t)(layer) * 2 * 48 * D, b_group + (layer) * NG, b_expert + (layer) * NE, cnt_, ASG, LTOK, LGATE, LRS); \
        GSYNC(); \
        { const int ntm = build_tile_table(lds, cnt_); \
          REPEAT(REP_GEMM, { MoeSched<true> S{ntm, G, bid, D / 2, WGU, LTOK, (const LAS int*)(lds + TAB_OFF), LRS}; EpiG3 E{LRS, (unsigned char*)(Hb)}; gemm_phase<EpiG3, MoeSched<true>, true>(lds, (const bf16_t*)XQ, D / 2, S, E); }) \
          GSYNC(); \
          REPEAT(REP_GEMM, { MoeSched<false> S{ntm, G, bid, F / 2, WD, LTOK, (const LAS int*)(lds + TAB_OFF), LGATE}; EpiG4 E{LGATE, (unsigned char*)bufA}; gemm_phase<EpiG4, MoeSched<false>, true>(lds, (const bf16_t*)(Hb), F / 2, S, E); }) } \
        GSYNC(); } while (0)

    REPEAT(REP_PREP,
    ph_prep_x(x, ln_a, bufB, RS);
    ph_transpose<false>(lds, w_in_a, D, 3 * D, WA_IN, 1, nullptr, 1, 0, 0);
    ph_transpose<false>(lds, w_out_a, D, D, WA_OUT, 0, nullptr, 1, 0, 0);
    ph_transpose<false>(lds, w_in_b, D, 2 * D, WB_IN, 0, ln_b, 1, 0, 0);
    ph_transpose<false>(lds, w_out_b, D, D, WB_OUT, 0, nullptr, 1, 0, 0);
    ph_prep_router(ln2, w_group, w_expert, WR);
    ph_prep_wm(w_s, WM);
    ph_prep_experts(lds, 0, w_gate, w_up, w_down, ln2, WGU, WD));
    GSYNC();
    REPEAT(REP_GEMM, DENSE_GEMM(EpiG1, {bufA}, bufB, WA_IN, 3 * D));
    GSYNC();
    REPEAT(REP_THIN, ph_conv(bufA, conv_w, bufC));
    GSYNC();
    REPEAT(REP_GEMM, DENSE_GEMM(EpiRes<true>, ({bufB, bufD, XQ, RS, ln_a}), bufC, WA_OUT, D));
    GSYNC();
    MOE_PHASES(0, bufD, bufB);
    REPEAT(REP_THIN, ph_combine<false>(bufD, (const unsigned char*)bufA, ctl + CW_CNT, ASG, bufC, RS, nullptr, nullptr));
    REPEAT(REP_PREP, ph_prep_experts(lds, 1, w_gate, w_up, w_down, ln2, WGU, WD));
    GSYNC();
    REPEAT(REP_GEMM, DENSE_GEMM(EpiG5, ({RS, b_in_b, bufA, (f32x2*)(ws + WS_LNP)}), bufC, WB_IN, 2 * D));
    GSYNC();
    REPEAT(REP_THIN, ph_mix(lds, bufA, (const f32x2*)(ws + WS_LNP), v_ln_g, v_ln_b, WM, b_s, bufD));
    GSYNC();
    REPEAT(REP_GEMM, DENSE_GEMM(EpiRes<false>, ({bufC, bufB, XQ, nullptr, nullptr}), bufD, WB_OUT, D));
    GSYNC();
    MOE_PHASES(1, bufB, bufC);
    REPEAT(REP_THIN, ph_combine<true>(bufB, (const unsigned char*)bufA, ctl + CW_CNT + NE, ASG, nullptr, nullptr, ln_f, out));
}
}

extern "C" void kernel_launch(void* const* d_in, const int* in_sizes, int n_in, void* d_out, int out_size, void* d_ws, size_t ws_size, hipStream_t stream) {
    if (n_in != 22 || ws_size < WS_END) { fprintf(stderr, "kernel_launch: unexpected n_in %d / ws_size %zu\n", n_in, ws_size); return; }
    static int grid_blocks = 0;
    if (!grid_blocks) {
        int dev = 0, cus = 0, per_cu = 0;
        (void)hipGetDevice(&dev);
        (void)hipDeviceGetAttribute(&cus, hipDeviceAttributeMultiprocessorCount, dev);
        (void)hipFuncSetAttribute((const void*)mega_fwd, hipFuncAttributeMaxDynamicSharedMemorySize, LDS_BYTES);
        (void)hipOccupancyMaxActiveBlocksPerMultiprocessor(&per_cu, (const void*)mega_fwd, NT, LDS_BYTES);
        if (per_cu < 1) fprintf(stderr, "kernel_launch: occupancy query says %d blocks per CU\n", per_cu);
        grid_blocks = cus;
    }
    (void)hipMemsetAsync((unsigned char*)d_ws + WS_CTL, 0, CTL_BYTES, stream);
    Params p{};
    for (int i = 0; i < 22; ++i) p.in[i] = (const float*)d_in[i];
    p.out = (float*)d_out; p.ws = (unsigned char*)d_ws;
    void* args[] = {&p};
    hipError_t e = hipLaunchCooperativeKernel((const void*)mega_fwd, dim3(grid_blocks), dim3(NT), args, LDS_BYTES, stream);
    if (e != hipSuccess) fprintf(stderr, "cooperative launch failed: %s (grid %d)\n", hipGetErrorString(e), grid_blocks);
}
```

```cpp
#include <hip/hip_runtime.h>
#include <hip/hip_cooperative_groups.h>
#include <cstdint>
#include <cstdio>

namespace cg = cooperative_groups;
namespace {
#define LAS __attribute__((address_space(3)))
typedef unsigned short bf16_t;
typedef short bf16x8 __attribute__((ext_vector_type(8)));
typedef float f32x4 __attribute__((ext_vector_type(4)));
typedef float f32x2 __attribute__((ext_vector_type(2)));
typedef unsigned u32x4 __attribute__((ext_vector_type(4)));
typedef unsigned u32x2 __attribute__((ext_vector_type(2)));

constexpr int BATCH = 8, SEQ = 4096, D = 1024, T = BATCH * SEQ;
constexpr int NE = 32, NG = 4, F = 512, CHUNK = 128, NH = 8;
constexpr float EPS = 1e-6f;
constexpr int NT = 512, NWAVES = 8;

constexpr size_t MiB = 1u << 20;
constexpr size_t WS_CTL = 0;
constexpr size_t CTL_BYTES = 65536;
constexpr size_t WS_RS = 1 * MiB;
constexpr size_t WS_ASG = 1 * MiB + 512 * 1024;
constexpr size_t WS_LNS = 2 * MiB;
constexpr size_t WS_WR = 2 * MiB + 512 * 1024;
constexpr size_t WS_WM = 3 * MiB;
constexpr size_t WS_LTOK = 4 * MiB;
constexpr size_t WS_LNP = 112 * MiB;
constexpr size_t WS_LGATE = 8 * MiB;
constexpr size_t WS_LRS = 12 * MiB;
constexpr size_t WS_WA_IN = 16 * MiB;
constexpr size_t WS_WA_OUT = 22 * MiB;
constexpr size_t WS_WB_IN = 24 * MiB;
constexpr size_t WS_WB_OUT = 28 * MiB;
constexpr size_t WS_WGU = 32 * MiB;
constexpr size_t WS_WD = 64 * MiB;
constexpr size_t WS_XQ = 80 * MiB;
constexpr size_t WS_A = 128 * MiB;
constexpr size_t WS_B = 256 * MiB;
constexpr size_t WS_C = 320 * MiB;
constexpr size_t WS_D = 384 * MiB;
constexpr size_t WS_END = 449 * MiB;
constexpr int CW_CNT = 0;
constexpr int CW_BAR = 4096;

constexpr int RING_BYTES = 131072;
constexpr int TAB_OFF = RING_BYTES;
constexpr int TAB_MAX = 320;
constexpr int TABN_OFF = TAB_OFF + TAB_MAX * 16;
constexpr int BARST_OFF = TABN_OFF + 16;
constexpr int TOKTAB_OFF = RING_BYTES + 8192;
constexpr int SCTAB_OFF = TOKTAB_OFF + 1024;
constexpr int LDS_BYTES = 147456;

__device__ __forceinline__ float bf2f(unsigned b) { return __uint_as_float(b << 16); }
__device__ __forceinline__ unsigned f2bf(float f) { unsigned u = __float_as_uint(f); return (u + 0x7fffu + ((u >> 16) & 1u)) >> 16; }
__device__ __forceinline__ unsigned pk2(float lo, float hi) { return f2bf(lo) | (f2bf(hi) << 16); }
__device__ __forceinline__ unsigned cvt_pk_bf16(float lo, float hi) { unsigned r; asm volatile("v_cvt_pk_bf16_f32 %0, %1, %2" : "=v"(r) : "v"(lo), "v"(hi)); return r; }
__device__ __forceinline__ float wave_sum(float v) {
#pragma unroll
    for (int o = 1; o < 64; o <<= 1) v += __shfl_xor(v, o);
    return v;
}
__device__ __forceinline__ void unpack8(const u32x4 v, float (&f)[8]) {
    f[0] = bf2f(v.x & 0xffffu); f[1] = bf2f(v.x >> 16); f[2] = bf2f(v.y & 0xffffu); f[3] = bf2f(v.y >> 16);
    f[4] = bf2f(v.z & 0xffffu); f[5] = bf2f(v.z >> 16); f[6] = bf2f(v.w & 0xffffu); f[7] = bf2f(v.w >> 16);
}
__device__ __forceinline__ u32x4 pack8(const float (&f)[8]) {
    u32x4 o; o.x = pk2(f[0], f[1]); o.y = pk2(f[2], f[3]); o.z = pk2(f[4], f[5]); o.w = pk2(f[6], f[7]); return o;
}
__device__ __forceinline__ float gelu_tanh(float x) {
    const float x2 = x * x;
    const float t = x * (x2 * (-0.044715f * 2.0f * 0.7978845608028654f * 1.4426950408889634f) + (-2.0f * 0.7978845608028654f * 1.4426950408889634f));
    return x * __builtin_amdgcn_rcpf(1.0f + __builtin_amdgcn_exp2f(t));
}
__device__ __forceinline__ float silu(float x) { return x * __builtin_amdgcn_rcpf(1.0f + __builtin_amdgcn_exp2f(x * -1.4426950408889634f)); }
#define LDS_WAIT() asm volatile("s_waitcnt lgkmcnt(0)" ::: "memory")
__device__ __forceinline__ float clamp_fp8(float v) { return __builtin_amdgcn_fmed3f(v, -448.0f, 448.0f); }
__device__ __forceinline__ unsigned pk4_fp8(float a, float b, float c, float d) { unsigned w = 0u; a = clamp_fp8(a); b = clamp_fp8(b); c = clamp_fp8(c); d = clamp_fp8(d); w = __builtin_amdgcn_cvt_pk_fp8_f32(a, b, w, false); w = __builtin_amdgcn_cvt_pk_fp8_f32(c, d, w, true); return w; }
__device__ __forceinline__ void unpack8_fp8(const u32x2 v, float (&f)[8]) {
    const f32x2 a = __builtin_amdgcn_cvt_pk_f32_fp8(v.x, false), b = __builtin_amdgcn_cvt_pk_f32_fp8(v.x, true), c = __builtin_amdgcn_cvt_pk_f32_fp8(v.y, false), d = __builtin_amdgcn_cvt_pk_f32_fp8(v.y, true);
    f[0] = a.x; f[1] = a.y; f[2] = b.x; f[3] = b.y; f[4] = c.x; f[5] = c.y; f[6] = d.x; f[7] = d.y;
}
typedef int i32x8 __attribute__((ext_vector_type(8)));
typedef int i32x4 __attribute__((ext_vector_type(4)));
__device__ __forceinline__ int phase_tid() { int t = (int)threadIdx.x; asm volatile("" : "+v"(t)); return t; }

constexpr int BM = 256, BK = 64, HALF = 128, HTB = HALF * BK * 2, NXCD = 8, WGM = 8;
__device__ __forceinline__ int lds_byte(int r, int c) { const int st = (r >> 4) * 2 + (c >> 5), rr = r & 15, cc = c & 31, ob = rr * 64 + cc * 2; return st * 1024 + (ob ^ (((ob >> 9) & 1) << 5)); }
__device__ __forceinline__ void stage_rc(int b, int& R, int& C) { const int st = b / 1024, sb = b % 1024, swz = sb ^ (((sb >> 9) & 1) << 5); R = (st >> 1) * 16 + swz / 64; C = (st & 1) * 32 + (swz % 64) / 2; }
__device__ __forceinline__ int perm32(int rho) { const int n = rho >> 4, i = rho & 15; return 8 * (i >> 2) + 4 * n + (i & 3); }

struct Unit { int pm, pn, e, row0, nrows, slot0; };
__device__ __forceinline__ bool order_next(int i, int G, int c, int nM, int nN, int& pm, int& pn) {
    const int nwg = nM * nN; const long L = (long)i * G + c; if (L >= nwg) return false;
    int wgid = (int)L; { const int q = nwg / NXCD, r = nwg % NXCD, xcd = wgid % NXCD, off = wgid / NXCD; wgid = (xcd < r ? xcd * (q + 1) : r * (q + 1) + (xcd - r) * q) + off; }
    const int nig = WGM * nN, gid = wgid / nig, fm = gid * WGM, gsz = (nM - fm) < WGM ? (nM - fm) : WGM;
    pm = fm + ((wgid % nig) % gsz); pn = (wgid % nig) / gsz; return true;
}
struct DenseSched {
    static constexpr bool ROWTAB = false, GATHER_IDS = false;
    int nM, nN, G, c, K; const bf16_t* Bt;
    __device__ __forceinline__ bool next(int i, Unit& u) const { u.e = 0; u.row0 = 0; u.nrows = BM; u.slot0 = 0; return order_next(i, G, c, nM, nN, u.pm, u.pn); }
    __device__ __forceinline__ void aoff(const Unit& u, int tid, unsigned (&v)[2][2]) const {
        int R[2], C[2]; stage_rc(tid * 16, R[0], C[0]); stage_rc(tid * 16 + 8192, R[1], C[1]);
#pragma unroll
        for (int h = 0; h < 2; ++h)
#pragma unroll
            for (int i = 0; i < 2; ++i) v[h][i] = (unsigned)((u.pm * BM + h * HALF + R[i]) * K + C[i]) * 2u;
    }
    __device__ __forceinline__ const char* bptr(const Unit& u) const { return (const char*)Bt + (size_t)u.pn * BM * K * 2; }
};
template <bool GATHER> struct MoeSched {
    static constexpr bool ROWTAB = true, GATHER_IDS = GATHER;
    int nM, G, c, K; const unsigned char* W; const int* ltok; const LAS int* tab; const float* rowscal;
    __device__ __forceinline__ bool next(int i, Unit& u) const {
        if (G == 256) { const int rt = i * 64 + 8 * (c & 7) + ((c >> 3) & 7); if (rt >= nM) return false; u.pm = rt; u.pn = c >> 6; }
        else if (!order_next(i, G, c, nM, 4, u.pm, u.pn)) return false;
        u.e = __builtin_amdgcn_readfirstlane(tab[u.pm * 4 + 0]); u.row0 = __builtin_amdgcn_readfirstlane(tab[u.pm * 4 + 1]); u.nrows = __builtin_amdgcn_readfirstlane(tab[u.pm * 4 + 2]); u.slot0 = __builtin_amdgcn_readfirstlane(tab[u.pm * 4 + 3]); return true;
    }
    __device__ __forceinline__ void aoff(const Unit& u, int tid, unsigned (&v)[2][2]) const {
        int R[2], C[2]; stage_rc(tid * 16, R[0], C[0]); stage_rc(tid * 16 + 8192, R[1], C[1]);
#pragma unroll
        for (int h = 0; h < 2; ++h)
#pragma unroll
            for (int i = 0; i < 2; ++i) {
                if (GATHER) { const int rr = min(h * HALF + R[i], u.nrows - 1); const int tok = ltok[(size_t)u.e * T + u.row0 + rr]; v[h][i] = (unsigned)(tok * K + C[i]) * 2u; }
                else v[h][i] = (unsigned)((u.slot0 + h * HALF + R[i]) * K + C[i]) * 2u;
            }
    }
    __device__ __forceinline__ void aoff_lds(const LAS int* toktab, int tid, unsigned (&v)[2][2]) const {
        int R[2], C[2]; stage_rc(tid * 16, R[0], C[0]); stage_rc(tid * 16 + 8192, R[1], C[1]);
#pragma unroll
        for (int h = 0; h < 2; ++h)
#pragma unroll
            for (int i = 0; i < 2; ++i) v[h][i] = (unsigned)(toktab[h * HALF + R[i]] * K + C[i]) * 2u;
    }
    __device__ __forceinline__ const char* bptr(const Unit& u) const { return (const char*)W + ((size_t)u.e * 1024 + (size_t)u.pn * BM) * K * 2; }
};

template <class Epi, class Sched, bool FP8 = false>
__device__ __forceinline__ void gemm_phase(LAS unsigned char* lds, const bf16_t* Abase, const int K, const Sched& S, const Epi& E) {
    const int tid = phase_tid(), wid = __builtin_amdgcn_readfirstlane(tid >> 6), lane = tid & 63, wr = wid >> 2, wc = wid & 3, fr = lane & 15, fq = lane >> 4;
    const int nt = K / BK;
    unsigned voffB[2];
#pragma unroll
    for (int i = 0; i < 2; ++i) { int sR, sC; stage_rc(tid * 16 + i * 8192, sR, sC);
        const int Rb = Epi::WIDE ? (64 * (sR >> 5) + 16 * ((sR & 15) >> 2) + 4 * ((sR >> 4) & 1) + (sR & 3)) : ((sR & ~31) + perm32(sR & 31)); voffB[i] = (unsigned)(Rb * K + sC) * 2u; }
    const size_t kstep = (size_t)(BK * 2);
    const size_t hstepB = (size_t)(Epi::WIDE ? 8 : HALF) * K * 2;
    const unsigned ldsw = (unsigned)wid * 1024u;
    const int aoff = lds_byte(wr * 64 + fr, fq * 8), boff = lds_byte(wc * 32 + fr, fq * 8);
#define PG8_SA(b, h) (((b) * 2 + (h)) * HTB)
#define PG8_SB(b, h) ((4 + (b) * 2 + (h)) * HTB)
#define PG8_STAGE(bufoff, gbase, voff) do { _Pragma("unroll") for (int _i = 0; _i < 2; ++_i) \
        __builtin_amdgcn_global_load_lds((const unsigned*)((const char*)(gbase) + (voff)[_i]), (LAS unsigned*)(lds + (bufoff) + ldsw + _i * 8192), 16, 0, 0); } while (0)
#define PG8_LDA(dst, b, h) do { _Pragma("unroll") for (int m = 0; m < 4; ++m) { \
        const i32x4 lo_ = *(const LAS i32x4*)(lds + PG8_SA(b, h) + aoff + m * 2048), hi_ = *(const LAS i32x4*)(lds + PG8_SA(b, h) + aoff + m * 2048 + 1024); \
        if constexpr (FP8) dst##8[m] = __builtin_shufflevector(lo_, hi_, 0, 1, 2, 3, 4, 5, 6, 7); else { dst[m][0] = __builtin_bit_cast(bf16x8, lo_); dst[m][1] = __builtin_bit_cast(bf16x8, hi_); } } } while (0)
#define PG8_LDB(dst, b, h) do { _Pragma("unroll") for (int n = 0; n < 2; ++n) { \
        const i32x4 lo_ = *(const LAS i32x4*)(lds + PG8_SB(b, h) + boff + n * 2048), hi_ = *(const LAS i32x4*)(lds + PG8_SB(b, h) + boff + n * 2048 + 1024); \
        if constexpr (FP8) dst##8[n] = __builtin_shufflevector(lo_, hi_, 0, 1, 2, 3, 4, 5, 6, 7); else { dst[n][0] = __builtin_bit_cast(bf16x8, lo_); dst[n][1] = __builtin_bit_cast(bf16x8, hi_); } } } while (0)
#define PG8_MMA(ai, bj, At, Bt) do { __builtin_amdgcn_s_setprio(1); \
        if constexpr (FP8) { \
            asm volatile("s_nop 1\n\t" \
                "v_mfma_f32_16x16x128_f8f6f4 %0, %8, %10, %0\n\t" "v_mfma_f32_16x16x128_f8f6f4 %1, %9, %10, %1\n\t" \
                "v_mfma_f32_16x16x128_f8f6f4 %2, %8, %11, %2\n\t" "v_mfma_f32_16x16x128_f8f6f4 %3, %9, %11, %3\n\t" \
                "v_mfma_f32_16x16x128_f8f6f4 %4, %8, %12, %4\n\t" "v_mfma_f32_16x16x128_f8f6f4 %5, %9, %12, %5\n\t" \
                "v_mfma_f32_16x16x128_f8f6f4 %6, %8, %13, %6\n\t" "v_mfma_f32_16x16x128_f8f6f4 %7, %9, %13, %7" \
                : "+v"(acc[ai][bj][0][0]), "+v"(acc[ai][bj][0][1]), "+v"(acc[ai][bj][1][0]), "+v"(acc[ai][bj][1][1]), \
                  "+v"(acc[ai][bj][2][0]), "+v"(acc[ai][bj][2][1]), "+v"(acc[ai][bj][3][0]), "+v"(acc[ai][bj][3][1]) \
                : "v"(Bt##8[0]), "v"(Bt##8[1]), "v"(At##8[0]), "v"(At##8[1]), "v"(At##8[2]), "v"(At##8[3])); \
        } else { _Pragma("unroll") for (int m = 0; m < 4; ++m) _Pragma("unroll") for (int n = 0; n < 2; ++n) _Pragma("unroll") for (int k = 0; k < 2; ++k) \
            acc[ai][bj][m][n] = __builtin_amdgcn_mfma_f32_16x16x32_bf16(Bt[n][k], At[m][k], acc[ai][bj][m][n], 0, 0, 0); } \
        __builtin_amdgcn_s_setprio(0); } while (0)
#define PG8_WAIT_V(n) asm volatile("s_waitcnt vmcnt(" #n ")" ::: "memory")
#define PG8_WAIT_L(n) asm volatile("s_waitcnt lgkmcnt(" #n ")" ::: "memory")
#define PG8_BAR __builtin_amdgcn_s_barrier()
#define PG8_SCHED __builtin_amdgcn_sched_barrier(0)
    Unit cur, nxt; int ui = 0;
    if (!S.next(0, cur)) return;
    f32x4 acc[2][2][4][2];
#pragma unroll
    for (int a = 0; a < 2; ++a)
#pragma unroll
        for (int b = 0; b < 2; ++b)
#pragma unroll
            for (int m = 0; m < 4; ++m)
#pragma unroll
                for (int n = 0; n < 2; ++n) acc[a][b][m][n] = (f32x4){0.f, 0.f, 0.f, 0.f};
    bf16x8 At[4][2], B0[2][2], B1[2][2]; i32x8 At8[4], B08[2], B18[2];
    unsigned vA[2][2], vS[2][2];
    S.aoff(cur, tid, vA);
#pragma unroll
    for (int h = 0; h < 2; ++h)
#pragma unroll
        for (int i = 0; i < 2; ++i) vS[h][i] = vA[h][i];
    const char* const A0 = (const char*)Abase;
    const char* cB = S.bptr(cur);
    PG8_STAGE(PG8_SB(0, 0), cB, voffB); PG8_STAGE(PG8_SB(0, 1), cB + hstepB, voffB); PG8_STAGE(PG8_SA(0, 0), A0, vA[0]); PG8_STAGE(PG8_SA(0, 1), A0, vA[1]);
    if (wr == 1) PG8_BAR;
    PG8_WAIT_V(2); PG8_BAR;
    PG8_STAGE(PG8_SB(1, 0), cB + kstep, voffB); PG8_STAGE(PG8_SA(1, 0), A0 + kstep, vA[0]); PG8_STAGE(PG8_SB(1, 1), cB + hstepB + kstep, voffB);
    PG8_WAIT_V(6); PG8_BAR;
    for (;;) {
        const bool has_next = S.next(ui + 1, nxt);
        const bool full = cur.nrows > HALF;
        if constexpr (Sched::ROWTAB) {
            if (wid < 4) { const int row = wid * 64 + lane;
                __builtin_amdgcn_global_load_lds((const unsigned*)(S.rowscal + (size_t)cur.e * T + cur.row0 + min(row, cur.nrows - 1)), (LAS unsigned*)(lds + SCTAB_OFF + (ui & 1) * 1024 + wid * 256), 4, 0, 0);
                if (Sched::GATHER_IDS && has_next) __builtin_amdgcn_global_load_lds((const unsigned*)(S.ltok + (size_t)nxt.e * T + nxt.row0 + min(row, nxt.nrows - 1)), (LAS unsigned*)(lds + TOKTAB_OFF + (ui & 1) * 1024 + wid * 256), 4, 0, 0); }
        }
        const char* nB = has_next ? S.bptr(nxt) : cB;
#pragma unroll 1
        for (int t = 0; t < nt; t += 2) {
            const bool last = (t == nt - 2);
            if (last && has_next) { if constexpr (Sched::GATHER_IDS) S.aoff_lds((const LAS int*)(lds + TOKTAB_OFF + (ui & 1) * 1024), tid, vS); else S.aoff(nxt, tid, vS); }
            const char* a1 = A0 + (size_t)(t + 1) * kstep;
            const char* a2 = last ? A0 : A0 + (size_t)(t + 2) * kstep; const char* b2 = last ? nB : cB + (size_t)(t + 2) * kstep;
            const char* a3 = a2 + kstep; const char* b3 = b2 + kstep;
            PG8_LDB(B0, 0, 0); PG8_LDB(B1, 0, 1); PG8_SCHED; PG8_LDA(At, 0, 0); PG8_STAGE(PG8_SA(1, 1), a1, vA[1]);
            PG8_WAIT_V(8); PG8_WAIT_L(0); PG8_BAR; PG8_MMA(0, 0, At, B0); PG8_MMA(0, 1, At, B1); PG8_BAR; PG8_SCHED;
            PG8_LDA(At, 0, 1); PG8_STAGE(PG8_SB(0, 0), b2, voffB); PG8_STAGE(PG8_SB(0, 1), b2 + hstepB, voffB); PG8_STAGE(PG8_SA(0, 0), a2, vS[0]);
            PG8_WAIT_V(8); PG8_WAIT_L(0); PG8_BAR; if (full) { PG8_MMA(1, 0, At, B0); PG8_MMA(1, 1, At, B1); } PG8_BAR; PG8_SCHED;
            PG8_LDB(B0, 1, 0); PG8_LDB(B1, 1, 1); PG8_SCHED; PG8_LDA(At, 1, 0); PG8_STAGE(PG8_SA(0, 1), a2, vS[1]);
            PG8_WAIT_V(8); PG8_WAIT_L(0); PG8_BAR; PG8_MMA(0, 0, At, B0); PG8_MMA(0, 1, At, B1); PG8_BAR; PG8_SCHED;
            PG8_LDA(At, 1, 1); PG8_STAGE(PG8_SB(1, 0), b3, voffB); PG8_STAGE(PG8_SB(1, 1), b3 + hstepB, voffB); PG8_STAGE(PG8_SA(1, 0), a3, vS[0]);
            PG8_WAIT_V(8); PG8_WAIT_L(0); PG8_BAR; if (full) { PG8_MMA(1, 0, At, B0); PG8_MMA(1, 1, At, B1); } PG8_BAR; PG8_SCHED;
        }
        if (wr == 0) PG8_BAR;
        if constexpr (FP8) asm volatile("s_nop 7\n\ts_nop 7\n\ts_nop 7" ::: "memory");
        { const int t2 = phase_tid(), l2 = t2 & 63; E(acc, cur, wr, wc, l2 & 15, l2 >> 4, (const LAS float*)(lds + SCTAB_OFF + (ui & 1) * 1024)); }
        if (!has_next) break;
#pragma unroll
        for (int a = 0; a < 2; ++a)
#pragma unroll
            for (int b = 0; b < 2; ++b)
#pragma unroll
                for (int m = 0; m < 4; ++m)
#pragma unroll
                    for (int n = 0; n < 2; ++n) acc[a][b][m][n] = (f32x4){0.f, 0.f, 0.f, 0.f};
        cur = nxt; cB = nB; ++ui;
#pragma unroll
        for (int h = 0; h < 2; ++h)
#pragma unroll
            for (int i = 0; i < 2; ++i) vA[h][i] = vS[h][i];
        if (wr == 1) PG8_BAR;
    }
    PG8_WAIT_V(0);
    PG8_BAR;
#undef PG8_SA
#undef PG8_SB
#undef PG8_STAGE
#undef PG8_LDA
#undef PG8_LDB
#undef PG8_MMA
#undef PG8_WAIT_V
#undef PG8_WAIT_L
#undef PG8_BAR
#undef PG8_SCHED
}

__device__ __forceinline__ u32x4 pack_rows(const f32x4 v0, const f32x4 v1) { u32x4 w; w.x = cvt_pk_bf16(v0[0], v0[1]); w.y = cvt_pk_bf16(v0[2], v0[3]); w.z = cvt_pk_bf16(v1[0], v1[1]); w.w = cvt_pk_bf16(v1[2], v1[3]); return w; }
struct EpiG1 {
    static constexpr bool WIDE = false;
    bf16_t* ZB;
    __device__ __forceinline__ void operator()(const f32x4 (&acc)[2][2][4][2], const Unit& u, int wr, int wc, int fr, int fq, const LAS float* sct) const {
        const int row0 = u.pm * BM + wr * 64 + fr;
#pragma unroll
        for (int ai = 0; ai < 2; ++ai)
#pragma unroll
            for (int m = 0; m < 4; ++m) { bf16_t* rowp = ZB + (size_t)(row0 + ai * HALF + m * 16) * 2048;
                if (u.pn < 8) { *(u32x4*)(rowp + u.pn * 128 + wc * 32 + 8 * fq) = pack_rows(acc[ai][0][m][0] * acc[ai][1][m][0], acc[ai][0][m][1] * acc[ai][1][m][1]); }
                else {
#pragma unroll
                    for (int bj = 0; bj < 2; ++bj) *(u32x4*)(rowp + D + (u.pn - 8) * BM + bj * HALF + wc * 32 + 8 * fq) = pack_rows(acc[ai][bj][m][0], acc[ai][bj][m][1]); } }
    }
};
template <bool SCALED> struct EpiRes {
    static constexpr bool WIDE = true;
    const bf16_t* res; bf16_t* X; unsigned char* XQ; const float* rinv; const float* gcol;
    __device__ __forceinline__ void operator()(const f32x4 (&acc)[2][2][4][2], const Unit& u, int wr, int wc, int fr, int fq, const LAS float* sct) const {
        const int row0 = u.pm * BM + wr * 64 + fr, col0 = u.pn * BM + wc * 64 + 16 * fq;
        float gi[2][8];
        if (SCALED) {
#pragma unroll
            for (int bj = 0; bj < 2; ++bj) { const f32x4 g0 = *(const f32x4*)(gcol + col0 + 8 * bj), g1 = *(const f32x4*)(gcol + col0 + 8 * bj + 4);
                gi[bj][0] = __builtin_amdgcn_rcpf(g0.x); gi[bj][1] = __builtin_amdgcn_rcpf(g0.y); gi[bj][2] = __builtin_amdgcn_rcpf(g0.z); gi[bj][3] = __builtin_amdgcn_rcpf(g0.w);
                gi[bj][4] = __builtin_amdgcn_rcpf(g1.x); gi[bj][5] = __builtin_amdgcn_rcpf(g1.y); gi[bj][6] = __builtin_amdgcn_rcpf(g1.z); gi[bj][7] = __builtin_amdgcn_rcpf(g1.w); } }
#pragma unroll
        for (int ai = 0; ai < 2; ++ai) {
            u32x4 rb[4][2]; float ri[4];
#pragma unroll
            for (int m = 0; m < 4; ++m) { const size_t off = (size_t)(row0 + ai * HALF + m * 16) * D + col0; ri[m] = SCALED ? rinv[row0 + ai * HALF + m * 16] : 1.0f;
#pragma unroll
                for (int bj = 0; bj < 2; ++bj) rb[m][bj] = __builtin_nontemporal_load((const u32x4*)(res + off + 8 * bj)); }
#pragma unroll
            for (int m = 0; m < 4; ++m) { const size_t off = (size_t)(row0 + ai * HALF + m * 16) * D + col0; u32x4 q;
#pragma unroll
                for (int bj = 0; bj < 2; ++bj) { float f[8]; unpack8(rb[m][bj], f);
                    if (SCALED) {
#pragma unroll
                        for (int e = 0; e < 8; ++e) f[e] = f[e] * ri[m] * gi[bj][e]; }
                    const f32x4 o0 = (f32x4){f[0], f[1], f[2], f[3]} + acc[ai][bj][m][0], o1 = (f32x4){f[4], f[5], f[6], f[7]} + acc[ai][bj][m][1];
                    *(u32x4*)(X + off + 8 * bj) = pack_rows(o0, o1);
                    q[2 * bj] = pk4_fp8(2.f * o0[0], 2.f * o0[1], 2.f * o0[2], 2.f * o0[3]); q[2 * bj + 1] = pk4_fp8(2.f * o1[0], 2.f * o1[1], 2.f * o1[2], 2.f * o1[3]); }
                *(u32x4*)(XQ + off) = q; }
        }
    }
};
struct EpiG3 {
    static constexpr bool WIDE = false;
    const float* lrs; unsigned char* H;
    __device__ __forceinline__ void operator()(const f32x4 (&acc)[2][2][4][2], const Unit& u, int wr, int wc, int fr, int fq, const LAS float* sct) const {
        float scv[2][4];
#pragma unroll
        for (int ai = 0; ai < 2; ++ai)
#pragma unroll
            for (int m = 0; m < 4; ++m) { const int r = ai * HALF + wr * 64 + m * 16 + fr; scv[ai][m] = sct[r]; }
#pragma unroll
        for (int ai = 0; ai < 2; ++ai)
#pragma unroll
            for (int m = 0; m < 4; ++m) { const int r = ai * HALF + wr * 64 + m * 16 + fr;
                if (r < u.nrows) { const float sc = scv[ai][m] * (1.0f / 64.0f); f32x4 o[2];
#pragma unroll
                    for (int n = 0; n < 2; ++n)
#pragma unroll
                        for (int j = 0; j < 4; ++j) o[n][j] = 4.0f * silu(sc * acc[ai][0][m][n][j]) * (sc * acc[ai][1][m][n][j]);
                    u32x2 q; q.x = pk4_fp8(o[0][0], o[0][1], o[0][2], o[0][3]); q.y = pk4_fp8(o[1][0], o[1][1], o[1][2], o[1][3]);
                    *(u32x2*)(H + (size_t)(u.slot0 + r) * F + u.pn * 128 + wc * 32 + 8 * fq) = q; } }
    }
};
struct EpiG4 {
    static constexpr bool WIDE = true;
    const float* lgate; unsigned char* YS;
    __device__ __forceinline__ void operator()(const f32x4 (&acc)[2][2][4][2], const Unit& u, int wr, int wc, int fr, int fq, const LAS float* sct) const {
        float gv[2][4];
#pragma unroll
        for (int ai = 0; ai < 2; ++ai)
#pragma unroll
            for (int m = 0; m < 4; ++m) { const int r = ai * HALF + wr * 64 + m * 16 + fr; gv[ai][m] = sct[r]; }
#pragma unroll
        for (int ai = 0; ai < 2; ++ai)
#pragma unroll
            for (int m = 0; m < 4; ++m) { const int r = ai * HALF + wr * 64 + m * 16 + fr;
                if (r < u.nrows) { const float g = gv[ai][m] * (16.0f / 128.0f);
                    u32x4 q;
#pragma unroll
                    for (int bj = 0; bj < 2; ++bj) { const f32x4 o0 = acc[ai][bj][m][0] * g, o1 = acc[ai][bj][m][1] * g; q[2 * bj] = pk4_fp8(o0[0], o0[1], o0[2], o0[3]); q[2 * bj + 1] = pk4_fp8(o1[0], o1[1], o1[2], o1[3]); }
                    *(u32x4*)(YS + (size_t)(u.slot0 + r) * D + u.pn * BM + wc * 64 + 16 * fq) = q; } }
    }
};
struct EpiG5 {
    static constexpr bool WIDE = true;
    const float* rs; const float* bias; bf16_t* UV; f32x2* lnp;
    __device__ __forceinline__ void operator()(const f32x4 (&acc)[2][2][4][2], const Unit& u, int wr, int wc, int fr, int fq, const LAS float* sct) const {
        const int row0 = u.pm * BM + wr * 64 + fr, col0 = u.pn * BM + wc * 64 + 16 * fq;
        f32x4 bv[2][2];
#pragma unroll
        for (int bj = 0; bj < 2; ++bj)
#pragma unroll
            for (int n = 0; n < 2; ++n) bv[bj][n] = *(const f32x4*)(bias + col0 + 8 * bj + 4 * n);
        float scv[2][4];
#pragma unroll
        for (int ai = 0; ai < 2; ++ai)
#pragma unroll
            for (int m = 0; m < 4; ++m) scv[ai][m] = rs[row0 + ai * HALF + m * 16];
#pragma unroll
        for (int ai = 0; ai < 2; ++ai)
#pragma unroll
            for (int m = 0; m < 4; ++m) { const int row = row0 + ai * HALF + m * 16; const float sc = scv[ai][m];
                float ps = 0.f, pq = 0.f;
#pragma unroll
                for (int bj = 0; bj < 2; ++bj) { f32x4 o[2];
#pragma unroll
                    for (int n = 0; n < 2; ++n)
#pragma unroll
                        for (int j = 0; j < 4; ++j) { o[n][j] = gelu_tanh(sc * acc[ai][bj][m][n][j] + bv[bj][n][j]); ps += o[n][j]; pq += o[n][j] * o[n][j]; }
                    *(u32x4*)(UV + (size_t)row * 2048 + col0 + 8 * bj) = pack_rows(o[0], o[1]); }
                if (u.pn >= 4) { ps += __shfl_xor(ps, 16); ps += __shfl_xor(ps, 32); pq += __shfl_xor(pq, 16); pq += __shfl_xor(pq, 32);
                    if (fq == 0) lnp[(size_t)row * 16 + (u.pn - 4) * 4 + wc] = (f32x2){ps, pq}; } }
    }
};

__device__ __forceinline__ void ph_prep_x(const float* __restrict__ x, const float* __restrict__ g, bf16_t* __restrict__ xn, float* __restrict__ rinv) {
    const int tid = phase_tid(), lane = tid & 63, gw = ((int)blockIdx.x * NT + tid) >> 6, ngw = ((int)gridDim.x * NT) >> 6;
    f32x4 gv[4];
#pragma unroll
    for (int j = 0; j < 4; ++j) gv[j] = ((const f32x4*)g)[lane + 64 * j];
    for (int row = gw; row < T; row += 2 * ngw) {
        const int row2 = row + ngw;
        const bool has2 = row2 < T;
        const f32x4* xr = (const f32x4*)(x + (size_t)row * D) + lane; const f32x4* xr2 = (const f32x4*)(x + (size_t)(has2 ? row2 : row) * D) + lane;
        f32x4 v[4], w[4]; float s = 0.f, s2 = 0.f;
#pragma unroll
        for (int j = 0; j < 4; ++j) { v[j] = __builtin_nontemporal_load(xr + 64 * j); w[j] = __builtin_nontemporal_load(xr2 + 64 * j); }
#pragma unroll
        for (int j = 0; j < 4; ++j) { s += (v[j].x * v[j].x + v[j].y * v[j].y) + (v[j].z * v[j].z + v[j].w * v[j].w); s2 += (w[j].x * w[j].x + w[j].y * w[j].y) + (w[j].z * w[j].z + w[j].w * w[j].w); }
        const float r = rsqrtf(wave_sum(s) * (1.0f / D) + EPS), r2 = rsqrtf(wave_sum(s2) * (1.0f / D) + EPS);
        if (lane == 0) { rinv[row] = 1.0f / r; if (has2) rinv[row2] = 1.0f / r2; }
        u32x2* o = (u32x2*)(xn + (size_t)row * D) + lane; u32x2* o2 = (u32x2*)(xn + (size_t)row2 * D) + lane;
#pragma unroll
        for (int j = 0; j < 4; ++j) { u32x2 q; q.x = pk2(v[j].x * r * gv[j].x, v[j].y * r * gv[j].y); q.y = pk2(v[j].z * r * gv[j].z, v[j].w * r * gv[j].w); o[64 * j] = q; }
        if (has2) {
#pragma unroll
            for (int j = 0; j < 4; ++j) { u32x2 q; q.x = pk2(w[j].x * r2 * gv[j].x, w[j].y * r2 * gv[j].y); q.y = pk2(w[j].z * r2 * gv[j].z, w[j].w * r2 * gv[j].w); o2[64 * j] = q; } }
    }
}
__device__ __forceinline__ int map_row(int mapkind, int n) {
    if (mapkind == 0) return n;
    if (mapkind == 1) { if (n < D) return 2 * D + n; const int ch = (n - D) & (D - 1), second = (n >= 2 * D); return 256 * (ch >> 7) + 128 * second + (ch & 127); }
    return 256 * (n >> 7) + (mapkind == 3 ? 128 : 0) + (n & 127);
}
struct TrItem { const float* src; int k0, n0; };
__device__ __forceinline__ void tr_load(const float* __restrict__ W, int N, int item, int lane, f32x4 (&v)[16]) {
    const int nblk = N / 64, kb = item / nblk, nb = item % nblk, k0 = 64 * kb, n0 = 64 * nb, kq = lane >> 4, nn = 4 * (lane & 15);
#pragma unroll
    for (int i = 0; i < 16; ++i) v[i] = __builtin_nontemporal_load((const f32x4*)(W + (size_t)(k0 + 4 * i + kq) * N + n0 + nn));
}
template <bool FP8OUT> __device__ __forceinline__ void tr_process(const f32x4 (&v)[16], int K, int N, void* __restrict__ WTv, int mapkind, const float* __restrict__ kscale, LAS float* scr, int item, int lane) {
    const int nblk = N / 64, kb = item / nblk, nb = item % nblk, k0 = 64 * kb, n0 = 64 * nb, kq = lane >> 4, nn = 4 * (lane & 15);
#pragma unroll
    for (int i = 0; i < 16; ++i) { const int kk = 4 * i + kq; const float sc = (kscale ? kscale[k0 + kk] : 1.0f) * (FP8OUT ? 32.0f : 1.0f); LAS float* d = scr + kk * 65 + nn;
        d[0] = v[i].x * sc; d[1] = v[i].y * sc; d[2] = v[i].z * sc; d[3] = v[i].w * sc; }
    LDS_WAIT();
    if constexpr (!FP8OUT) {
        bf16_t* WT = (bf16_t*)WTv; const int c = lane & 7;
#pragma unroll
        for (int j = 0; j < 8; ++j) { const int n = (lane >> 3) + 8 * j; const LAS float* sp = scr + (8 * c) * 65 + n;
            u32x4 o; o.x = pk2(sp[0 * 65], sp[1 * 65]); o.y = pk2(sp[2 * 65], sp[3 * 65]); o.z = pk2(sp[4 * 65], sp[5 * 65]); o.w = pk2(sp[6 * 65], sp[7 * 65]);
            *(u32x4*)(WT + (size_t)map_row(mapkind, n0 + n) * K + k0 + 8 * c) = o; }
    } else {
        unsigned char* WT = (unsigned char*)WTv; const int c = lane & 3;
#pragma unroll
        for (int j = 0; j < 4; ++j) { const int n = (lane >> 2) + 16 * j; const LAS float* sp = scr + (16 * c) * 65 + n;
            u32x4 o; o.x = pk4_fp8(sp[0 * 65], sp[1 * 65], sp[2 * 65], sp[3 * 65]); o.y = pk4_fp8(sp[4 * 65], sp[5 * 65], sp[6 * 65], sp[7 * 65]);
            o.z = pk4_fp8(sp[8 * 65], sp[9 * 65], sp[10 * 65], sp[11 * 65]); o.w = pk4_fp8(sp[12 * 65], sp[13 * 65], sp[14 * 65], sp[15 * 65]);
            *(u32x4*)(WT + (size_t)map_row(mapkind, n0 + n) * K + k0 + 16 * c) = o; }
    }
    LDS_WAIT();
}
template <bool FP8OUT> __device__ __forceinline__ void ph_transpose(LAS unsigned char* lds, const float* W, int K, int N, void* WT, int mapkind, const float* kscale, int nbatch, size_t sstride, size_t dstride, int shift = 0) {
    const int tid = phase_tid(), lane = tid & 63, wave = tid >> 6, ngw = (int)gridDim.x * NWAVES, gw = ((int)blockIdx.x * NWAVES + wave + ngw - (shift % ngw)) % ngw;
    LAS float* scr = (LAS float*)(lds + wave * 16640);
    const int per = (K / 64) * (N / 64), nitems = per * nbatch;
    f32x4 v[16], vn[16];
    int it = gw;
    if (it < nitems) tr_load(W + (size_t)(it / per) * sstride, N, it % per, lane, v);
    while (it < nitems) {
        const int nx = it + ngw;
        if (nx < nitems) tr_load(W + (size_t)(nx / per) * sstride, N, nx % per, lane, vn);
        tr_process<FP8OUT>(v, K, N, (unsigned char*)WT + (size_t)(it / per) * dstride * (FP8OUT ? 1 : 2), mapkind, kscale, scr, it % per, lane);
#pragma unroll
        for (int i = 0; i < 16; ++i) v[i] = vn[i];
        it = nx;
    }
}
__device__ __forceinline__ void ph_prep_experts(LAS unsigned char* lds, int layer, const float* w_gate, const float* w_up, const float* w_down, const float* ln2, unsigned char* WGU, unsigned char* WD) {
    ph_transpose<true>(lds, w_gate + (size_t)layer * NE * D * F, D, F, WGU, 2, ln2 + layer * D, NE, (size_t)D * F, (size_t)1024 * D);
    ph_transpose<true>(lds, w_up + (size_t)layer * NE * D * F, D, F, WGU, 3, ln2 + layer * D, NE, (size_t)D * F, (size_t)1024 * D);
    ph_transpose<true>(lds, w_down + (size_t)layer * NE * F * D, F, D, WD, 0, nullptr, NE, (size_t)F * D, (size_t)D * F);
}
__device__ __forceinline__ void ph_prep_router(const float* __restrict__ ln2, const float* __restrict__ wg, const float* __restrict__ we, bf16_t* __restrict__ wr) {
    for (int i = (int)blockIdx.x * NT + phase_tid(); i < 2 * 48 * D; i += (int)gridDim.x * NT) {
        const int l = i / (48 * D), j = (i / D) % 48, k = i % D;
        float w = 0.f;
        if (j < 4) w = wg[((size_t)l * D + k) * NG + j]; else if (j < 36) w = we[((size_t)l * D + k) * NE + (j - 4)];
        w *= ln2[l * D + k];
        const unsigned hi = f2bf(w); const unsigned lo = f2bf(w - bf2f(hi));
        wr[((size_t)l * 2 + 0) * 48 * D + (size_t)j * D + k] = (bf16_t)hi; wr[((size_t)l * 2 + 1) * 48 * D + (size_t)j * D + k] = (bf16_t)lo;
    }
}
__device__ __forceinline__ void ph_prep_wm(const float* __restrict__ ws, bf16_t* __restrict__ wm) {
    for (int i = (int)blockIdx.x * NT + phase_tid(); i < NH * CHUNK * CHUNK; i += (int)gridDim.x * NT) { const int t = (i / CHUNK) % CHUNK, s = i % CHUNK; wm[i] = (bf16_t)f2bf(t >= s ? ws[i] : 0.f); }
}
__device__ __forceinline__ void ph_conv(const bf16_t* __restrict__ ZB, const float* __restrict__ cw, bf16_t* __restrict__ Y) {
    constexpr int RB = 8;
    const int nitems = (T / RB) * (D / 8);
    for (int it = (int)blockIdx.x * NT + phase_tid(); it < nitems; it += (int)gridDim.x * NT) {
        const int cg8 = it & 127, rb = it >> 7, r0 = rb * RB, ch = cg8 * 8, t0 = r0 & (SEQ - 1);
        float w[3][8];
#pragma unroll
        for (int k = 0; k < 3; ++k)
#pragma unroll
            for (int i = 0; i < 8; ++i) w[k][i] = cw[k * D + ch + i];
        float zm2[8], zm1[8];
        if (t0 >= 2) { unpack8(__builtin_nontemporal_load((const u32x4*)(ZB + (size_t)(r0 - 2) * 2048 + ch)), zm2); unpack8(__builtin_nontemporal_load((const u32x4*)(ZB + (size_t)(r0 - 1) * 2048 + ch)), zm1); }
        else {
#pragma unroll
            for (int i = 0; i < 8; ++i) { zm2[i] = 0.f; zm1[i] = 0.f; } }
#pragma unroll
        for (int r = 0; r < RB; ++r) {
            float z[8], b[8], o[8];
            unpack8(__builtin_nontemporal_load((const u32x4*)(ZB + (size_t)(r0 + r) * 2048 + ch)), z); unpack8(__builtin_nontemporal_load((const u32x4*)(ZB + (size_t)(r0 + r) * 2048 + D + ch)), b);
#pragma unroll
            for (int i = 0; i < 8; ++i) { o[i] = b[i] * (w[0][i] * zm2[i] + w[1][i] * zm1[i] + w[2][i] * z[i]); zm2[i] = zm1[i]; zm1[i] = z[i]; }
            *(u32x4*)(Y + (size_t)(r0 + r) * D + ch) = pack8(o);
        }
    }
}
__device__ __forceinline__ void ph_route(LAS unsigned char* lds, const bf16_t* __restrict__ X, const bf16_t* __restrict__ wrh, const float* __restrict__ bg, const float* __restrict__ be,
                                         unsigned* __restrict__ cnt, unsigned* __restrict__ asg, int* __restrict__ ltok, float* __restrict__ lgate, float* __restrict__ lrs) {
    const int tid = phase_tid(), wave = tid >> 6, lane = tid & 63, fr = lane & 15, fq = lane >> 4;
    LAS float* lgs = (LAS float*)(lds + wave * 4096);
    LAS int* s_e = (LAS int*)(lds + 32768); LAS float* s_g = (LAS float*)(lds + 32768 + 1024); LAS float* s_r = (LAS float*)(lds + 32768 + 2048);
    LAS unsigned* s_cnt = (LAS unsigned*)(lds + 32768 + 3072); LAS unsigned* s_base = (LAS unsigned*)(lds + 32768 + 3200); LAS unsigned* s_rank = (LAS unsigned*)(lds + 32768 + 3328);
    const bf16_t* wrl = wrh + 48 * D;
    for (int tb = (int)blockIdx.x * 128; tb < T; tb += (int)gridDim.x * 128) {
        if (tid < NE) s_cnt[tid] = 0u;
        const int tok0 = tb + wave * 16;
        f32x4 acc[3]; float ss = 0.f;
#pragma unroll
        for (int n = 0; n < 3; ++n) acc[n] = (f32x4){0.f, 0.f, 0.f, 0.f};
        constexpr int WCH_PITCH = 272, WCH_BYTES = 2 * 48 * WCH_PITCH;
        LAS unsigned char* wbuf = lds + 49152;
        u32x4 wreg[3], araw[4];
#pragma unroll
        for (int p = 0; p < 3; ++p) { const int pc = tid + 512 * p, hl = pc / 768, row = (pc % 768) >> 4, kc = pc & 15; wreg[p] = *(const u32x4*)(wrh + (size_t)hl * 48 * D + (size_t)row * D + kc * 8); }
#pragma unroll
        for (int q = 0; q < 4; ++q) araw[q] = *(const u32x4*)(X + (size_t)(tok0 + fr) * D + q * 32 + fq * 8);
#pragma unroll 1
        for (int kb = 0; kb < D / 128; ++kb) {
            LAS unsigned char* wb = wbuf + (kb & 1) * WCH_BYTES;
#pragma unroll
            for (int p = 0; p < 3; ++p) { const int pc = tid + 512 * p, hl = pc / 768, row = (pc % 768) >> 4, kc = pc & 15; *(LAS u32x4*)(wb + (hl * 48 + row) * WCH_PITCH + kc * 16) = wreg[p]; }
            u32x4 acur[4];
#pragma unroll
            for (int q = 0; q < 4; ++q) acur[q] = araw[q];
            __syncthreads();
            if (kb + 1 < D / 128) {
#pragma unroll
                for (int p = 0; p < 3; ++p) { const int pc = tid + 512 * p, hl = pc / 768, row = (pc % 768) >> 4, kc = pc & 15; wreg[p] = *(const u32x4*)(wrh + (size_t)hl * 48 * D + (size_t)row * D + (kb + 1) * 128 + kc * 8); }
#pragma unroll
                for (int q = 0; q < 4; ++q) araw[q] = *(const u32x4*)(X + (size_t)(tok0 + fr) * D + ((kb + 1) * 4 + q) * 32 + fq * 8);
            }
#pragma unroll
            for (int q = 0; q < 4; ++q) {
                float af[8]; unpack8(acur[q], af);
#pragma unroll
                for (int e = 0; e < 8; ++e) ss += af[e] * af[e];
                const bf16x8 a = __builtin_bit_cast(bf16x8, acur[q]);
#pragma unroll
                for (int n = 0; n < 3; ++n) {
                    const bf16x8 bh = *(const LAS bf16x8*)(wb + (n * 16 + fr) * WCH_PITCH + (q * 32 + fq * 8) * 2);
                    const bf16x8 bl = *(const LAS bf16x8*)(wb + (48 + n * 16 + fr) * WCH_PITCH + (q * 32 + fq * 8) * 2);
                    acc[n] = __builtin_amdgcn_mfma_f32_16x16x32_bf16(a, bh, acc[n], 0, 0, 0); acc[n] = __builtin_amdgcn_mfma_f32_16x16x32_bf16(a, bl, acc[n], 0, 0, 0); }
            }
        }
        __syncthreads();
        ss += __shfl_xor(ss, 16); ss += __shfl_xor(ss, 32);
#pragma unroll
        for (int n = 0; n < 3; ++n)
#pragma unroll
            for (int j = 0; j < 4; ++j) lgs[(fq * 4 + j) * 49 + n * 16 + fr] = acc[n][j];
        if (fq == 0) lgs[16 * 49 + fr] = rsqrtf(ss * (1.0f / D) + EPS);
        LDS_WAIT();
        if (lane < 16) {
            const float r = lgs[16 * 49 + lane]; const LAS float* L = lgs + lane * 49;
            float lg[36];
#pragma unroll
            for (int j = 0; j < 36; ++j) lg[j] = L[j] * r + (j < 4 ? bg[j] : be[j - 4]);
            int gi = 0; float gm = lg[0];
#pragma unroll
            for (int j = 1; j < 4; ++j) if (lg[j] > gm) { gm = lg[j]; gi = j; }
            float gs = 0.f;
#pragma unroll
            for (int j = 0; j < 4; ++j) gs += __expf(lg[j] - gm);
            const float gp = 1.0f / gs;
            float el[8];
#pragma unroll
            for (int j = 0; j < 8; ++j) { el[j] = lg[4 + j];
#pragma unroll
                for (int g = 1; g < 4; ++g) el[j] = (gi == g) ? lg[4 + g * 8 + j] : el[j]; }
            int i0 = 0; float m0 = el[0];
#pragma unroll
            for (int j = 1; j < 8; ++j) if (el[j] > m0) { m0 = el[j]; i0 = j; }
            int i1 = 0; float m1 = -3.0e38f;
#pragma unroll
            for (int j = 0; j < 8; ++j) if (j != i0 && el[j] > m1) { m1 = el[j]; i1 = j; }
            const float eb = __expf(m1 - m0), den = 1.0f / (1.0f + eb);
            const int tl = wave * 16 + lane;
            s_e[2 * tl] = gi * 8 + i0; s_e[2 * tl + 1] = gi * 8 + i1; s_g[2 * tl] = gp * den; s_g[2 * tl + 1] = gp * eb * den; s_r[tl] = r;
        }
        __syncthreads();
        if (tid < 256) s_rank[tid] = atomicAdd((unsigned*)&s_cnt[s_e[tid]], 1u);
        __syncthreads();
        if (tid < NE) s_base[tid] = s_cnt[tid] ? atomicAdd(&cnt[tid], s_cnt[tid]) : 0u;
        __syncthreads();
        if (tid < 256) { const int e = s_e[tid], tok = tb + (tid >> 1); const unsigned pos = s_base[e] + s_rank[tid];
            ltok[(size_t)e * T + pos] = tok; lgate[(size_t)e * T + pos] = s_g[tid]; lrs[(size_t)e * T + pos] = s_r[tid >> 1];
            asg[(size_t)tok * 4 + (tid & 1) * 2] = ((unsigned)e << 24) | pos; asg[(size_t)tok * 4 + (tid & 1) * 2 + 1] = __float_as_uint(s_g[tid]); }
        __syncthreads();
    }
}
__device__ __forceinline__ int build_tile_table(LAS unsigned char* lds, const unsigned* __restrict__ cnt) {
    LAS int* tab = (LAS int*)(lds + TAB_OFF); LAS int* tabn = (LAS int*)(lds + TABN_OFF);
    const int tid = phase_tid();
    if (tid < NE) {
        int bacc = 0, sacc_small = 0, sacc = 0, mine = 0, nbig_all = 0, nsmall_all = 0;
        for (int e = 0; e < NE; ++e) { const int n = (int)cnt[e], full = n / BM, rem = n % BM, nb = full + (rem > HALF ? 1 : 0), ns = (rem > 0 && rem <= HALF) ? 1 : 0;
            if (e == tid) mine = n; if (e < tid) { bacc += nb; sacc_small += ns; sacc += n; } nbig_all += nb; nsmall_all += ns; }
        const int full = mine / BM, rem = mine % BM, nb = full + (rem > HALF ? 1 : 0);
        for (int j = 0; j < nb; ++j) { const int ti = bacc + j; if (ti < TAB_MAX) { tab[ti * 4 + 0] = tid; tab[ti * 4 + 1] = j * BM; tab[ti * 4 + 2] = min(BM, mine - j * BM); tab[ti * 4 + 3] = sacc + j * BM; } }
        if (rem > 0 && rem <= HALF) { const int ti = nbig_all + sacc_small; if (ti < TAB_MAX) { tab[ti * 4 + 0] = tid; tab[ti * 4 + 1] = full * BM; tab[ti * 4 + 2] = rem; tab[ti * 4 + 3] = sacc + full * BM; } }
        if (tid == NE - 1) tabn[0] = min(nbig_all + nsmall_all, TAB_MAX);
    }
    __syncthreads();
    return __builtin_amdgcn_readfirstlane(tabn[0]);
}
template <bool FINAL> __device__ __forceinline__ void ph_combine(const bf16_t* __restrict__ X, const unsigned char* __restrict__ YS, const unsigned* __restrict__ cnt, const unsigned* __restrict__ asg,
                                                                 bf16_t* __restrict__ Xo, float* __restrict__ rs, const float* __restrict__ g, float* __restrict__ out) {
    const int tid = phase_tid(), lane = tid & 63, gw = ((int)blockIdx.x * NT + tid) >> 6, ngw = ((int)gridDim.x * NT) >> 6;
    unsigned c = lane < NE ? cnt[lane] : 0u, inc = c;
#pragma unroll
    for (int o = 1; o < 32; o <<= 1) { const unsigned t = __shfl_up(inc, o); if (lane >= o) inc += t; }
    const unsigned excl = inc - c;
    for (int rowb = gw; rowb < T; rowb += 2 * ngw) {
        int rows[2]; rows[0] = rowb; rows[1] = (rowb + ngw < T) ? rowb + ngw : rowb;
        unsigned sa[2], sb[2];
#pragma unroll
        for (int q = 0; q < 2; ++q) { const u32x4 cw = *(const u32x4*)(asg + (size_t)rows[q] * 4); sa[q] = __shfl(excl, (int)(cw.x >> 24)) + (cw.x & 0xffffffu); sb[q] = __shfl(excl, (int)(cw.z >> 24)) + (cw.z & 0xffffffu); }
        u32x4 xr[2][2]; u32x2 ar[2][2], br[2][2];
#pragma unroll
        for (int q = 0; q < 2; ++q)
#pragma unroll
            for (int h = 0; h < 2; ++h) { xr[q][h] = __builtin_nontemporal_load((const u32x4*)(X + (size_t)rows[q] * D + h * 512 + lane * 8)); ar[q][h] = __builtin_nontemporal_load((const u32x2*)(YS + (size_t)sa[q] * D + h * 512 + lane * 8)); br[q][h] = __builtin_nontemporal_load((const u32x2*)(YS + (size_t)sb[q] * D + h * 512 + lane * 8)); }
#pragma unroll
        for (int q = 0; q < 2; ++q) {
            if (q == 1 && rows[1] == rows[0]) break;
            const int row = rows[q];
            float v[16];
#pragma unroll
            for (int h = 0; h < 2; ++h) { float x8[8], a[8], b[8]; unpack8(xr[q][h], x8); unpack8_fp8(ar[q][h], a); unpack8_fp8(br[q][h], b);
#pragma unroll
                for (int i = 0; i < 8; ++i) v[h * 8 + i] = x8[i] + (a[i] + b[i]) * (1.0f / 16.0f); }
            if (!FINAL) {
                float ss = 0.f;
#pragma unroll
                for (int h = 0; h < 2; ++h) { float o8[8];
#pragma unroll
                    for (int i = 0; i < 8; ++i) { o8[i] = bf2f(f2bf(v[h * 8 + i])); ss += o8[i] * o8[i]; }
                    *(u32x4*)(Xo + (size_t)row * D + h * 512 + lane * 8) = pack8(o8); }
                const float r = rsqrtf(wave_sum(ss) * (1.0f / D) + EPS);
                if (lane == 0) rs[row] = r;
            } else {
                float ss = 0.f;
#pragma unroll
                for (int i = 0; i < 16; ++i) ss += v[i] * v[i];
                const float r = rsqrtf(wave_sum(ss) * (1.0f / D) + EPS);
#pragma unroll
                for (int h = 0; h < 2; ++h) { const f32x4 g0 = *(const f32x4*)(g + h * 512 + lane * 8), g1 = *(const f32x4*)(g + h * 512 + lane * 8 + 4);
                    f32x4 o0, o1; o0.x = v[h * 8 + 0] * r * g0.x; o0.y = v[h * 8 + 1] * r * g0.y; o0.z = v[h * 8 + 2] * r * g0.z; o0.w = v[h * 8 + 3] * r * g0.w;
                    o1.x = v[h * 8 + 4] * r * g1.x; o1.y = v[h * 8 + 5] * r * g1.y; o1.z = v[h * 8 + 6] * r * g1.z; o1.w = v[h * 8 + 7] * r * g1.w;
                    __builtin_nontemporal_store(o0, (f32x4*)(out + (size_t)row * D + h * 512 + lane * 8)); __builtin_nontemporal_store(o1, (f32x4*)(out + (size_t)row * D + h * 512 + lane * 8 + 4)); }
            }
        }
    }
}
constexpr int MIX_PITCH = 272, MIX_BUF = CHUNK * MIX_PITCH, MIX_STAT_OFF = 2 * MIX_BUF;
typedef short s16x4 __attribute__((ext_vector_type(4)));
__device__ __forceinline__ void ph_mix(LAS unsigned char* lds, const bf16_t* __restrict__ UV, const f32x2* __restrict__ lnp, const float* __restrict__ vg, const float* __restrict__ vbeta,
                                       const bf16_t* __restrict__ wm, const float* __restrict__ bs, bf16_t* __restrict__ YM) {
    const int tid = phase_tid(), wave = tid >> 6, lane = tid & 63, fr = lane & 15, fq = lane >> 4, wt = wave >> 1, wd = wave & 1;
    LAS float* stat = (LAS float*)(lds + MIX_STAT_OFF);
    const int ch = tid & 15, srow = tid >> 4;
    const int cgrp = ch >> 2, ca = ch & 3;
    for (int bc = (int)blockIdx.x; bc < T / CHUNK; bc += (int)gridDim.x) {
        const int row0 = bc * CHUNK;
        if (tid < CHUNK) { const f32x4* pp = (const f32x4*)(lnp + (size_t)(row0 + tid) * 16); float sm = 0.f, sq = 0.f;
#pragma unroll
            for (int i = 0; i < 8; ++i) { const f32x4 pv = pp[i]; sm += pv.x + pv.z; sq += pv.y + pv.w; }
            const float mu = sm * (1.0f / D), var = fmaxf(sq * (1.0f / D) - mu * mu, 0.f);
            stat[2 * tid] = mu; stat[2 * tid + 1] = rsqrtf(var + EPS); }
        __syncthreads();
        u32x4 vraw[4];
#pragma unroll
        for (int p = 0; p < 4; ++p) vraw[p] = __builtin_nontemporal_load((const u32x4*)(UV + (size_t)(row0 + srow + 32 * p) * 2048 + D + 0 * 128 + 8 * ch));
#pragma unroll 1
        for (int h = 0; h < NH; ++h) {
            LAS unsigned char* buf = lds + (h & 1) * MIX_BUF;
            float g8[8], b8[8];
            { const f32x4 ga = *(const f32x4*)(vg + h * 128 + 8 * ch), gb = *(const f32x4*)(vg + h * 128 + 8 * ch + 4), ba = *(const f32x4*)(vbeta + h * 128 + 8 * ch), bb = *(const f32x4*)(vbeta + h * 128 + 8 * ch + 4);
              g8[0] = ga.x; g8[1] = ga.y; g8[2] = ga.z; g8[3] = ga.w; g8[4] = gb.x; g8[5] = gb.y; g8[6] = gb.z; g8[7] = gb.w;
              b8[0] = ba.x; b8[1] = ba.y; b8[2] = ba.z; b8[3] = ba.w; b8[4] = bb.x; b8[5] = bb.y; b8[6] = bb.z; b8[7] = bb.w; }
#pragma unroll
            for (int p = 0; p < 4; ++p) { const int sr = srow + 32 * p; float v[8]; unpack8(vraw[p], v);
                const float mu = stat[2 * sr], rstd = stat[2 * sr + 1];
#pragma unroll
                for (int q = 0; q < 8; ++q) v[q] = (v[q] - mu) * rstd * g8[q] + b8[q];
                u32x2 lo, hi; lo.x = pk2(v[0], v[1]); lo.y = pk2(v[2], v[3]); hi.x = pk2(v[4], v[5]); hi.y = pk2(v[6], v[7]);
                *(LAS u32x2*)(buf + sr * MIX_PITCH + (32 * cgrp + 4 * ca) * 2) = lo; *(LAS u32x2*)(buf + sr * MIX_PITCH + (32 * cgrp + 16 + 4 * ca) * 2) = hi; }
            __syncthreads();
            if (h + 1 < NH) {
#pragma unroll
                for (int p = 0; p < 4; ++p) vraw[p] = __builtin_nontemporal_load((const u32x4*)(UV + (size_t)(row0 + srow + 32 * p) * 2048 + D + (h + 1) * 128 + 8 * ch)); }
            u32x4 uraw[2][2]; float bsv[2];
#pragma unroll
            for (int m = 0; m < 2; ++m) { const int t = 32 * wt + 16 * m + fr; bsv[m] = bs[h * CHUNK + t];
#pragma unroll
                for (int cc = 0; cc < 2; ++cc) uraw[m][cc] = __builtin_nontemporal_load((const u32x4*)(UV + (size_t)(row0 + t) * 2048 + h * 128 + 32 * (2 * wd + cc) + 8 * fq)); }
            bf16x8 af[4][2];
#pragma unroll
            for (int kk = 0; kk < 4; ++kk)
#pragma unroll
                for (int m = 0; m < 2; ++m) af[kk][m] = *(const bf16x8*)(wm + ((size_t)(h * CHUNK + 32 * wt + 16 * m + fr)) * CHUNK + 32 * (kk <= wt ? kk : wt) + 8 * fq);
            f32x4 acc[2][4];
#pragma unroll
            for (int m = 0; m < 2; ++m)
#pragma unroll
                for (int n = 0; n < 4; ++n) acc[m][n] = (f32x4){0.f, 0.f, 0.f, 0.f};
            const int q4 = (lane & 15) >> 2, p4 = lane & 3;
#pragma unroll
            for (int kk = 0; kk < 4; ++kk) {
                if (kk <= wt) {
#pragma unroll
                    for (int n = 0; n < 4; ++n) {
                        const int colpos = 32 * (2 * wd + (n >> 1)) + 16 * (n & 1);
                        LAS unsigned char* base = buf + (32 * kk + 8 * fq + q4) * MIX_PITCH + colpos * 2 + 8 * p4;
                        const s16x4 t0 = __builtin_amdgcn_ds_read_tr16_b64_v4i16((LAS s16x4*)base);
                        const s16x4 t1 = __builtin_amdgcn_ds_read_tr16_b64_v4i16((LAS s16x4*)(base + 4 * MIX_PITCH));
                        bf16x8 bfrag; bfrag[0] = t0[0]; bfrag[1] = t0[1]; bfrag[2] = t0[2]; bfrag[3] = t0[3]; bfrag[4] = t1[0]; bfrag[5] = t1[1]; bfrag[6] = t1[2]; bfrag[7] = t1[3];
#pragma unroll
                        for (int m = 0; m < 2; ++m) acc[m][n] = __builtin_amdgcn_mfma_f32_16x16x32_bf16(bfrag, af[kk][m], acc[m][n], 0, 0, 0);
                    }
                }
            }
#pragma unroll
            for (int m = 0; m < 2; ++m) { const int t = 32 * wt + 16 * m + fr;
#pragma unroll
                for (int cc = 0; cc < 2; ++cc) { const int col = h * 128 + 32 * (2 * wd + cc) + 8 * fq; float u8[8], o8[8];
                    unpack8(uraw[m][cc], u8);
#pragma unroll
                    for (int n = 0; n < 2; ++n)
#pragma unroll
                        for (int r = 0; r < 4; ++r) o8[4 * n + r] = u8[4 * n + r] * (acc[m][2 * cc + n][r] + bsv[m]);
                    *(u32x4*)(YM + (size_t)(row0 + t) * D + col) = pack8(o8); } }
        }
        __syncthreads();
    }
}

#define XB_TMO      128
#define XB_XCNT(j)  (256  + 64 * (j))
#define XB_XSUB(j)  (1280 + 64 * (j))
#define XB_XGEN(j)  (2304 + 64 * (j))
#define XB_TOP      3328
#define XB_TOPGEN   3392
#define XCD_BAR_WORDS 3456
#define XB_SPIN_CAP (1u << 22)
__device__ __forceinline__ unsigned xb_ld(unsigned* p)              { return __hip_atomic_load(p, __ATOMIC_RELAXED, __HIP_MEMORY_SCOPE_AGENT); }
__device__ __forceinline__ unsigned xb_add(unsigned* p, unsigned v) { return __hip_atomic_fetch_add(p, v, __ATOMIC_RELAXED, __HIP_MEMORY_SCOPE_AGENT); }
__device__ __forceinline__ unsigned xb_xcc_id() { return (unsigned)__builtin_amdgcn_s_getreg((3 << 11) | 20) & 0xFu; }
#define XB_SPIN(cond, bar) do { unsigned _sp = 0; while (cond) { __builtin_amdgcn_s_sleep(1); \
    if ((++_sp & 255u) == 0u) { if (xb_ld(&(bar)[XB_TMO])) break; if (_sp > XB_SPIN_CAP) { atomicAdd(&(bar)[XB_TMO], 1u); break; } } } } while (0)
struct XcdBarrier { unsigned* bar; unsigned x; volatile LAS unsigned* st; };
__device__ __forceinline__ XcdBarrier xcd_barrier_post(unsigned* bar, volatile LAS unsigned* st) {
    XcdBarrier b; b.bar = bar; b.x = xb_xcc_id(); b.st = st;
    if (threadIdx.x == 0) (void)xb_add(&bar[XB_XCNT(b.x)], 1u);
    return b;
}
__device__ __forceinline__ void xcd_barrier_complete(unsigned* bar, unsigned x, unsigned& nloc, unsigned& nx) {
    const unsigned G = gridDim.x * gridDim.y * gridDim.z;
    unsigned sum, cnt, mine, sp = 0u;
    for (;;) {
        sum = 0u; cnt = 0u; mine = 0u;
#pragma unroll
        for (unsigned j = 0; j < 16; ++j) { const unsigned c = xb_ld(&bar[XB_XCNT(j)]); sum += c; cnt += (c > 0u) ? 1u : 0u; mine = (j == x) ? c : mine; }
        if (sum == G) break;
        __builtin_amdgcn_s_sleep(1);
        if ((++sp & 255u) == 0u) { if (xb_ld(&bar[XB_TMO])) break; if (sp > XB_SPIN_CAP) { atomicAdd(&bar[XB_TMO], 1u); break; } }
    }
    nloc = mine > 0u ? mine : 1u; nx = cnt > 0u ? cnt : 1u;
}
__device__ __forceinline__ void xcd_barrier(const XcdBarrier& b) {
    asm volatile("s_waitcnt vmcnt(0)" ::: "memory");
    __syncthreads();
    if (threadIdx.x == 0) {
        unsigned* bar = b.bar;
        __builtin_amdgcn_s_waitcnt(0);
        unsigned nloc = b.st[0], nx = b.st[1];
        if (nloc == 0u) { xcd_barrier_complete(bar, b.x, nloc, nx); b.st[0] = nloc; b.st[1] = nx; }
        const unsigned old = xb_add(&bar[XB_XSUB(b.x)], 1u);
        const unsigned gen = old / nloc;
        if (old + 1u == (gen + 1u) * nloc) {
            __builtin_amdgcn_fence(__ATOMIC_RELEASE, "agent");
            asm volatile("s_waitcnt vmcnt(0)" ::: "memory");
            const unsigned og = xb_add(&bar[XB_TOP], 1u);
            const unsigned tg = og / nx;
            if (og + 1u == (tg + 1u) * nx) xb_add(&bar[XB_TOPGEN], 1u);
            else XB_SPIN(xb_ld(&bar[XB_TOPGEN]) == tg, bar);
            __builtin_amdgcn_fence(__ATOMIC_ACQUIRE, "agent");
            xb_add(&bar[XB_XGEN(b.x)], 1u);
            asm volatile("s_waitcnt vmcnt(0)" ::: "memory");
        } else {
            XB_SPIN(xb_ld(&bar[XB_XGEN(b.x)]) == gen, bar);
            __builtin_amdgcn_fence(__ATOMIC_ACQUIRE, "agent");
            asm volatile("s_waitcnt vmcnt(0)" ::: "memory");
        }
    }
    __syncthreads();
}

#ifndef REP_PREP
#define REP_PREP 1
#endif
#ifndef REP_THIN
#define REP_THIN 1
#endif
#ifndef REP_GEMM
#define REP_GEMM 1
#endif
#ifndef REP_SYNC
#define REP_SYNC 1
#endif
#define REPEAT(n, ...) for (int rep_ = 0; rep_ < (n); ++rep_) { __VA_ARGS__; if (rep_ + 1 < (n)) xcd_barrier(xbar); }
#define GSYNC() do { for (int rs_ = 0; rs_ < REP_SYNC; ++rs_) xcd_barrier(xbar); } while (0)
struct Params { const float* in[22]; float* out; unsigned char* ws; };
__global__ void __launch_bounds__(NT, 2) mega_fwd(Params P) {
    extern __shared__ __attribute__((aligned(16))) unsigned char lds_raw[];
    LAS unsigned char* lds = (LAS unsigned char*)lds_raw;
    cg::grid_group grid = cg::this_grid();
    const int G = (int)gridDim.x, bid = (int)blockIdx.x;
    if (P.ws == nullptr) grid.sync();
    if (threadIdx.x < 4) ((LAS unsigned*)(lds + BARST_OFF))[threadIdx.x] = 0u;
    __syncthreads();
    const XcdBarrier xbar = xcd_barrier_post((unsigned*)(P.ws + WS_CTL) + CW_BAR, (volatile LAS unsigned*)(lds + BARST_OFF));
    const float* x = P.in[0]; const float* ln_a = P.in[1]; const float* w_in_a = P.in[2]; const float* conv_w = P.in[3];
    const float* w_out_a = P.in[4]; const float* ln_b = P.in[5]; const float* w_in_b = P.in[6]; const float* b_in_b = P.in[7];
    const float* v_ln_g = P.in[8]; const float* v_ln_b = P.in[9]; const float* w_s = P.in[10]; const float* b_s = P.in[11];
    const float* w_out_b = P.in[12]; const float* ln2 = P.in[13]; const float* w_group = P.in[14]; const float* b_group = P.in[15];
    const float* w_expert = P.in[16]; const float* b_expert = P.in[17]; const float* w_gate = P.in[18]; const float* w_up = P.in[19];
    const float* w_down = P.in[20]; const float* ln_f = P.in[21];
    unsigned char* ws = P.ws; float* out = P.out;
    unsigned* ctl = (unsigned*)(ws + WS_CTL); float* RS = (float*)(ws + WS_RS); unsigned* ASG = (unsigned*)(ws + WS_ASG); float* LNS = (float*)(ws + WS_LNS);
    int* LTOK = (int*)(ws + WS_LTOK); float* LGATE = (float*)(ws + WS_LGATE); float* LRS = (float*)(ws + WS_LRS); bf16_t* WR = (bf16_t*)(ws + WS_WR); bf16_t* WM = (bf16_t*)(ws + WS_WM);
    bf16_t* WA_IN = (bf16_t*)(ws + WS_WA_IN); bf16_t* WA_OUT = (bf16_t*)(ws + WS_WA_OUT); bf16_t* WB_IN = (bf16_t*)(ws + WS_WB_IN); bf16_t* WB_OUT = (bf16_t*)(ws + WS_WB_OUT);
    unsigned char* WGU = ws + WS_WGU; unsigned char* WD = ws + WS_WD; unsigned char* XQ = ws + WS_XQ;
    bf16_t* bufA = (bf16_t*)(ws + WS_A); bf16_t* bufB = (bf16_t*)(ws + WS_B); bf16_t* bufC = (bf16_t*)(ws + WS_C); bf16_t* bufD = (bf16_t*)(ws + WS_D);

#define DENSE_GEMM(EPI_T, epi_init, Aptr, Bptr, NCOLS) do { DenseSched S{T / BM, (NCOLS) / BM, G, bid, D, (Bptr)}; EPI_T E epi_init; gemm_phase<EPI_T, DenseSched>(lds, (Aptr), D, S, E); } while (0)
#define MOE_PHASES(layer, Xin, Hb) do { \
        unsigned* cnt_ = ctl + CW_CNT + (layer) * NE; \
        ph_route(lds, (Xin), WR + (size_t)(layer) * 2 * 48 * D, b_group + (layer) * NG, b_expert + (layer) * NE, cnt_, ASG, LTOK, LGATE, LRS); \
        GSYNC(); \
        { const int ntm = build_tile_table(lds, cnt_); \
          REPEAT(REP_GEMM, { MoeSched<true> S{ntm, G, bid, D / 2, WGU, LTOK, (const LAS int*)(lds + TAB_OFF), LRS}; EpiG3 E{LRS, (unsigned char*)(Hb)}; gemm_phase<EpiG3, MoeSched<true>, true>(lds, (const bf16_t*)XQ, D / 2, S, E); }) \
          GSYNC(); \
          REPEAT(REP_GEMM, { MoeSched<false> S{ntm, G, bid, F / 2, WD, LTOK, (const LAS int*)(lds + TAB_OFF), LGATE}; EpiG4 E{LGATE, (unsigned char*)bufA}; gemm_phase<EpiG4, MoeSched<false>, true>(lds, (const bf16_t*)(Hb), F / 2, S, E); }) } \
        GSYNC(); } while (0)

    REPEAT(REP_PREP,
    ph_prep_x(x, ln_a, bufB, RS);
    ph_transpose<false>(lds, w_in_a, D, 3 * D, WA_IN, 1, nullptr, 1, 0, 0, 0);
    ph_transpose<false>(lds, w_out_a, D, D, WA_OUT, 0, nullptr, 1, 0, 0, 768);
    ph_transpose<false>(lds, w_in_b, D, 2 * D, WB_IN, 0, ln_b, 1, 0, 0, 1024);
    ph_transpose<false>(lds, w_out_b, D, D, WB_OUT, 0, nullptr, 1, 0, 0, 1536);
    ph_prep_router(ln2, w_group, w_expert, WR);
    ph_prep_wm(w_s, WM);
    ph_prep_experts(lds, 0, w_gate, w_up, w_down, ln2, WGU, WD));
    GSYNC();
    REPEAT(REP_GEMM, DENSE_GEMM(EpiG1, {bufA}, bufB, WA_IN, 3 * D));
    GSYNC();
    REPEAT(REP_THIN, ph_conv(bufA, conv_w, bufC));
    GSYNC();
    REPEAT(REP_GEMM, DENSE_GEMM(EpiRes<true>, ({bufB, bufD, XQ, RS, ln_a}), bufC, WA_OUT, D));
    GSYNC();
    MOE_PHASES(0, bufD, bufB);
    REPEAT(REP_THIN, ph_combine<false>(bufD, (const unsigned char*)bufA, ctl + CW_CNT, ASG, bufC, RS, nullptr, nullptr));
    REPEAT(REP_PREP, ph_prep_experts(lds, 1, w_gate, w_up, w_down, ln2, WGU, WD));
    GSYNC();
    REPEAT(REP_GEMM, DENSE_GEMM(EpiG5, ({RS, b_in_b, bufA, (f32x2*)(ws + WS_LNP)}), bufC, WB_IN, 2 * D));
    GSYNC();
    REPEAT(REP_THIN, ph_mix(lds, bufA, (const f32x2*)(ws + WS_LNP), v_ln_g, v_ln_b, WM, b_s, bufD));
    GSYNC();
    REPEAT(REP_GEMM, DENSE_GEMM(EpiRes<false>, ({bufC, bufB, XQ, nullptr, nullptr}), bufD, WB_OUT, D));
    GSYNC();
    MOE_PHASES(1, bufB, bufC);
    REPEAT(REP_THIN, ph_combine<true>(bufB, (const unsigned char*)bufA, ctl + CW_CNT + NE, ASG, nullptr, nullptr, ln_f, out));
}
}

extern "C" void kernel_launch(void* const* d_in, const int* in_sizes, int n_in, void* d_out, int out_size, void* d_ws, size_t ws_size, hipStream_t stream) {
    if (n_in != 22 || ws_size < WS_END) { fprintf(stderr, "kernel_launch: unexpected n_in %d / ws_size %zu\n", n_in, ws_size); return; }
    static int grid_blocks = 0;
    if (!grid_blocks) {
        int dev = 0, cus = 0, per_cu = 0;
        (void)hipGetDevice(&dev);
        (void)hipDeviceGetAttribute(&cus, hipDeviceAttributeMultiprocessorCount, dev);
        (void)hipFuncSetAttribute((const void*)mega_fwd, hipFuncAttributeMaxDynamicSharedMemorySize, LDS_BYTES);
        (void)hipOccupancyMaxActiveBlocksPerMultiprocessor(&per_cu, (const void*)mega_fwd, NT, LDS_BYTES);
        if (per_cu < 1) fprintf(stderr, "kernel_launch: occupancy query says %d blocks per CU\n", per_cu);
        grid_blocks = cus;
    }
    (void)hipMemsetAsync((unsigned char*)d_ws + WS_CTL, 0, CTL_BYTES, stream);
    Params p{};
    for (int i = 0; i < 22; ++i) p.in[i] = (const float*)d_in[i];
    p.out = (float*)d_out; p.ws = (unsigned char*)d_ws;
    void* args[] = {&p};
    hipError_t e = hipLaunchCooperativeKernel((const void*)mega_fwd, dim3(grid_blocks), dim3(NT), args, LDS_BYTES, stream);
    if (e != hipSuccess) fprintf(stderr, "cooperative launch failed: %s (grid %d)\n", hipGetErrorString(e), grid_blocks);
}
```

```cpp
#include <hip/hip_runtime.h>
#include <hip/hip_cooperative_groups.h>
#include <cstdint>
#include <cstdio>

namespace cg = cooperative_groups;
namespace {
#define LAS __attribute__((address_space(3)))
typedef unsigned short bf16_t;
typedef short bf16x8 __attribute__((ext_vector_type(8)));
typedef float f32x4 __attribute__((ext_vector_type(4)));
typedef float f32x2 __attribute__((ext_vector_type(2)));
typedef unsigned u32x4 __attribute__((ext_vector_type(4)));
typedef unsigned u32x2 __attribute__((ext_vector_type(2)));

constexpr int BATCH = 8, SEQ = 4096, D = 1024, T = BATCH * SEQ;
constexpr int NE = 32, NG = 4, F = 512, CHUNK = 128, NH = 8;
constexpr float EPS = 1e-6f;
constexpr int NT = 512, NWAVES = 8;

constexpr size_t MiB = 1u << 20;
constexpr size_t WS_CTL = 0;
constexpr size_t CTL_BYTES = 65536;
constexpr size_t WS_RS = 1 * MiB;
constexpr size_t WS_ASG = 1 * MiB + 512 * 1024;
constexpr size_t WS_LNS = 2 * MiB;
constexpr size_t WS_WR = 2 * MiB + 512 * 1024;
constexpr size_t WS_WM = 3 * MiB;
constexpr size_t WS_LTOK = 4 * MiB;
constexpr size_t WS_LNP = 112 * MiB;
constexpr size_t WS_LGATE = 8 * MiB;
constexpr size_t WS_LRS = 12 * MiB;
constexpr size_t WS_WA_IN = 16 * MiB;
constexpr size_t WS_WA_OUT = 22 * MiB;
constexpr size_t WS_WB_IN = 24 * MiB;
constexpr size_t WS_WB_OUT = 28 * MiB;
constexpr size_t WS_WGU = 32 * MiB;
constexpr size_t WS_WD = 64 * MiB;
constexpr size_t WS_XQ = 80 * MiB;
constexpr size_t WS_A = 128 * MiB;
constexpr size_t WS_B = 256 * MiB;
constexpr size_t WS_C = 320 * MiB;
constexpr size_t WS_D = 384 * MiB;
constexpr size_t WS_END = 449 * MiB;
constexpr int CW_CNT = 0;
constexpr int CW_BAR = 4096;

constexpr int RING_BYTES = 131072;
constexpr int TAB_OFF = RING_BYTES;
constexpr int TAB_MAX = 320;
constexpr int TABN_OFF = TAB_OFF + TAB_MAX * 16;
constexpr int BARST_OFF = TABN_OFF + 16;
constexpr int TOKTAB_OFF = RING_BYTES + 8192;
constexpr int SCTAB_OFF = TOKTAB_OFF + 1024;
constexpr int LDS_BYTES = 147456;

__device__ __forceinline__ float bf2f(unsigned b) { return __uint_as_float(b << 16); }
__device__ __forceinline__ unsigned f2bf(float f) { unsigned u = __float_as_uint(f); return (u + 0x7fffu + ((u >> 16) & 1u)) >> 16; }
__device__ __forceinline__ unsigned pk2(float lo, float hi) { return f2bf(lo) | (f2bf(hi) << 16); }
__device__ __forceinline__ unsigned cvt_pk_bf16(float lo, float hi) { unsigned r; asm volatile("v_cvt_pk_bf16_f32 %0, %1, %2" : "=v"(r) : "v"(lo), "v"(hi)); return r; }
__device__ __forceinline__ float wave_sum(float v) {
#pragma unroll
    for (int o = 1; o < 64; o <<= 1) v += __shfl_xor(v, o);
    return v;
}
__device__ __forceinline__ void unpack8(const u32x4 v, float (&f)[8]) {
    f[0] = bf2f(v.x & 0xffffu); f[1] = bf2f(v.x >> 16); f[2] = bf2f(v.y & 0xffffu); f[3] = bf2f(v.y >> 16);
    f[4] = bf2f(v.z & 0xffffu); f[5] = bf2f(v.z >> 16); f[6] = bf2f(v.w & 0xffffu); f[7] = bf2f(v.w >> 16);
}
__device__ __forceinline__ u32x4 pack8(const float (&f)[8]) {
    u32x4 o; o.x = pk2(f[0], f[1]); o.y = pk2(f[2], f[3]); o.z = pk2(f[4], f[5]); o.w = pk2(f[6], f[7]); return o;
}
__device__ __forceinline__ float gelu_tanh(float x) {
    const float x2 = x * x;
    const float t = x * (x2 * (-0.044715f * 2.0f * 0.7978845608028654f * 1.4426950408889634f) + (-2.0f * 0.7978845608028654f * 1.4426950408889634f));
    return x * __builtin_amdgcn_rcpf(1.0f + __builtin_amdgcn_exp2f(t));
}
__device__ __forceinline__ float silu(float x) { return x * __builtin_amdgcn_rcpf(1.0f + __builtin_amdgcn_exp2f(x * -1.4426950408889634f)); }
#define LDS_WAIT() asm volatile("s_waitcnt lgkmcnt(0)" ::: "memory")
__device__ __forceinline__ float clamp_fp8(float v) { return __builtin_amdgcn_fmed3f(v, -448.0f, 448.0f); }
__device__ __forceinline__ unsigned pk4_fp8(float a, float b, float c, float d) { unsigned w = 0u; a = clamp_fp8(a); b = clamp_fp8(b); c = clamp_fp8(c); d = clamp_fp8(d); w = __builtin_amdgcn_cvt_pk_fp8_f32(a, b, w, false); w = __builtin_amdgcn_cvt_pk_fp8_f32(c, d, w, true); return w; }
__device__ __forceinline__ void unpack8_fp8(const u32x2 v, float (&f)[8]) {
    const f32x2 a = __builtin_amdgcn_cvt_pk_f32_fp8(v.x, false), b = __builtin_amdgcn_cvt_pk_f32_fp8(v.x, true), c = __builtin_amdgcn_cvt_pk_f32_fp8(v.y, false), d = __builtin_amdgcn_cvt_pk_f32_fp8(v.y, true);
    f[0] = a.x; f[1] = a.y; f[2] = b.x; f[3] = b.y; f[4] = c.x; f[5] = c.y; f[6] = d.x; f[7] = d.y;
}
typedef int i32x8 __attribute__((ext_vector_type(8)));
typedef int i32x4 __attribute__((ext_vector_type(4)));
__device__ __forceinline__ int phase_tid() { int t = (int)threadIdx.x; asm volatile("" : "+v"(t)); return t; }

constexpr int BM = 256, BK = 64, HALF = 128, HTB = HALF * BK * 2, NXCD = 8, WGM = 8;
__device__ __forceinline__ int lds_byte(int r, int c) { const int st = (r >> 4) * 2 + (c >> 5), rr = r & 15, cc = c & 31, ob = rr * 64 + cc * 2; return st * 1024 + (ob ^ (((ob >> 9) & 1) << 5)); }
__device__ __forceinline__ void stage_rc(int b, int& R, int& C) { const int st = b / 1024, sb = b % 1024, swz = sb ^ (((sb >> 9) & 1) << 5); R = (st >> 1) * 16 + swz / 64; C = (st & 1) * 32 + (swz % 64) / 2; }
__device__ __forceinline__ int perm32(int rho) { const int n = rho >> 4, i = rho & 15; return 8 * (i >> 2) + 4 * n + (i & 3); }

struct Unit { int pm, pn, e, row0, nrows, slot0; };
__device__ __forceinline__ bool order_next(int i, int G, int c, int nM, int nN, int& pm, int& pn) {
    const int nwg = nM * nN; const long L = (long)i * G + c; if (L >= nwg) return false;
    int wgid = (int)L; { const int q = nwg / NXCD, r = nwg % NXCD, xcd = wgid % NXCD, off = wgid / NXCD; wgid = (xcd < r ? xcd * (q + 1) : r * (q + 1) + (xcd - r) * q) + off; }
    const int nig = WGM * nN, gid = wgid / nig, fm = gid * WGM, gsz = (nM - fm) < WGM ? (nM - fm) : WGM;
    pm = fm + ((wgid % nig) % gsz); pn = (wgid % nig) / gsz; return true;
}
struct DenseSched {
    static constexpr bool ROWTAB = false, GATHER_IDS = false;
    int nM, nN, G, c, K; const bf16_t* Bt;
    __device__ __forceinline__ bool next(int i, Unit& u) const { u.e = 0; u.row0 = 0; u.nrows = BM; u.slot0 = 0; return order_next(i, G, c, nM, nN, u.pm, u.pn); }
    __device__ __forceinline__ void aoff(const Unit& u, int tid, unsigned (&v)[2][2]) const {
        int R[2], C[2]; stage_rc(tid * 16, R[0], C[0]); stage_rc(tid * 16 + 8192, R[1], C[1]);
#pragma unroll
        for (int h = 0; h < 2; ++h)
#pragma unroll
            for (int i = 0; i < 2; ++i) v[h][i] = (unsigned)((u.pm * BM + h * HALF + R[i]) * K + C[i]) * 2u;
    }
    __device__ __forceinline__ const char* bptr(const Unit& u) const { return (const char*)Bt + (size_t)u.pn * BM * K * 2; }
};
template <bool GATHER> struct MoeSched {
    static constexpr bool ROWTAB = true, GATHER_IDS = GATHER;
    int nM, G, c, K; const unsigned char* W; const int* ltok; const LAS int* tab; const float* rowscal;
    __device__ __forceinline__ bool next(int i, Unit& u) const {
        if (G == 256) { const int rt = i * 64 + 8 * (c & 7) + ((c >> 3) & 7); if (rt >= nM) return false; u.pm = rt; u.pn = c >> 6; }
        else if (!order_next(i, G, c, nM, 4, u.pm, u.pn)) return false;
        u.e = __builtin_amdgcn_readfirstlane(tab[u.pm * 4 + 0]); u.row0 = __builtin_amdgcn_readfirstlane(tab[u.pm * 4 + 1]); u.nrows = __builtin_amdgcn_readfirstlane(tab[u.pm * 4 + 2]); u.slot0 = __builtin_amdgcn_readfirstlane(tab[u.pm * 4 + 3]); return true;
    }
    __device__ __forceinline__ void aoff(const Unit& u, int tid, unsigned (&v)[2][2]) const {
        int R[2], C[2]; stage_rc(tid * 16, R[0], C[0]); stage_rc(tid * 16 + 8192, R[1], C[1]);
#pragma unroll
        for (int h = 0; h < 2; ++h)
#pragma unroll
            for (int i = 0; i < 2; ++i) {
                if (GATHER) { const int rr = min(h * HALF + R[i], u.nrows - 1); const int tok = ltok[(size_t)u.e * T + u.row0 + rr]; v[h][i] = (unsigned)(tok * K + C[i]) * 2u; }
                else v[h][i] = (unsigned)((u.slot0 + h * HALF + R[i]) * K + C[i]) * 2u;
            }
    }
    __device__ __forceinline__ void aoff_lds(const LAS int* toktab, int tid, unsigned (&v)[2][2]) const {
        int R[2], C[2]; stage_rc(tid * 16, R[0], C[0]); stage_rc(tid * 16 + 8192, R[1], C[1]);
#pragma unroll
        for (int h = 0; h < 2; ++h)
#pragma unroll
            for (int i = 0; i < 2; ++i) v[h][i] = (unsigned)(toktab[h * HALF + R[i]] * K + C[i]) * 2u;
    }
    __device__ __forceinline__ const char* bptr(const Unit& u) const { return (const char*)W + ((size_t)u.e * 1024 + (size_t)u.pn * BM) * K * 2; }
};

template <class Epi, class Sched, bool FP8 = false>
__device__ __forceinline__ void gemm_phase(LAS unsigned char* lds, const bf16_t* Abase, const int K, const Sched& S, const Epi& E) {
    const int tid = phase_tid(), wid = __builtin_amdgcn_readfirstlane(tid >> 6), lane = tid & 63, wr = wid >> 2, wc = wid & 3, fr = lane & 15, fq = lane >> 4;
    const int nt = K / BK;
    unsigned voffB[2];
#pragma unroll
    for (int i = 0; i < 2; ++i) { int sR, sC; stage_rc(tid * 16 + i * 8192, sR, sC);
        const int Rb = Epi::WIDE ? (64 * (sR >> 5) + 16 * ((sR & 15) >> 2) + 4 * ((sR >> 4) & 1) + (sR & 3)) : ((sR & ~31) + perm32(sR & 31)); voffB[i] = (unsigned)(Rb * K + sC) * 2u; }
    const size_t kstep = (size_t)(BK * 2);
    const size_t hstepB = (size_t)(Epi::WIDE ? 8 : HALF) * K * 2;
    const unsigned ldsw = (unsigned)wid * 1024u;
    const int aoff = lds_byte(wr * 64 + fr, fq * 8), boff = lds_byte(wc * 32 + fr, fq * 8);
#define PG8_SA(b, h) (((b) * 2 + (h)) * HTB)
#define PG8_SB(b, h) ((4 + (b) * 2 + (h)) * HTB)
#define PG8_STAGE(bufoff, gbase, voff) do { _Pragma("unroll") for (int _i = 0; _i < 2; ++_i) \
        __builtin_amdgcn_global_load_lds((const unsigned*)((const char*)(gbase) + (voff)[_i]), (LAS unsigned*)(lds + (bufoff) + ldsw + _i * 8192), 16, 0, 0); } while (0)
#define PG8_LDA(dst, b, h) do { _Pragma("unroll") for (int m = 0; m < 4; ++m) { \
        const i32x4 lo_ = *(const LAS i32x4*)(lds + PG8_SA(b, h) + aoff + m * 2048), hi_ = *(const LAS i32x4*)(lds + PG8_SA(b, h) + aoff + m * 2048 + 1024); \
        if constexpr (FP8) dst##8[m] = __builtin_shufflevector(lo_, hi_, 0, 1, 2, 3, 4, 5, 6, 7); else { dst[m][0] = __builtin_bit_cast(bf16x8, lo_); dst[m][1] = __builtin_bit_cast(bf16x8, hi_); } } } while (0)
#define PG8_LDB(dst, b, h) do { _Pragma("unroll") for (int n = 0; n < 2; ++n) { \
        const i32x4 lo_ = *(const LAS i32x4*)(lds + PG8_SB(b, h) + boff + n * 2048), hi_ = *(const LAS i32x4*)(lds + PG8_SB(b, h) + boff + n * 2048 + 1024); \
        if constexpr (FP8) dst##8[n] = __builtin_shufflevector(lo_, hi_, 0, 1, 2, 3, 4, 5, 6, 7); else { dst[n][0] = __builtin_bit_cast(bf16x8, lo_); dst[n][1] = __builtin_bit_cast(bf16x8, hi_); } } } while (0)
#define PG8_MMA(ai, bj, At, Bt) do { __builtin_amdgcn_s_setprio(1); \
        if constexpr (FP8) { \
            asm volatile("s_nop 1\n\t" \
                "v_mfma_f32_16x16x128_f8f6f4 %0, %8, %10, %0\n\t" "v_mfma_f32_16x16x128_f8f6f4 %1, %9, %10, %1\n\t" \
                "v_mfma_f32_16x16x128_f8f6f4 %2, %8, %11, %2\n\t" "v_mfma_f32_16x16x128_f8f6f4 %3, %9, %11, %3\n\t" \
                "v_mfma_f32_16x16x128_f8f6f4 %4, %8, %12, %4\n\t" "v_mfma_f32_16x16x128_f8f6f4 %5, %9, %12, %5\n\t" \
                "v_mfma_f32_16x16x128_f8f6f4 %6, %8, %13, %6\n\t" "v_mfma_f32_16x16x128_f8f6f4 %7, %9, %13, %7" \
                : "+v"(acc[ai][bj][0][0]), "+v"(acc[ai][bj][0][1]), "+v"(acc[ai][bj][1][0]), "+v"(acc[ai][bj][1][1]), \
                  "+v"(acc[ai][bj][2][0]), "+v"(acc[ai][bj][2][1]), "+v"(acc[ai][bj][3][0]), "+v"(acc[ai][bj][3][1]) \
                : "v"(Bt##8[0]), "v"(Bt##8[1]), "v"(At##8[0]), "v"(At##8[1]), "v"(At##8[2]), "v"(At##8[3])); \
        } else { _Pragma("unroll") for (int m = 0; m < 4; ++m) _Pragma("unroll") for (int n = 0; n < 2; ++n) _Pragma("unroll") for (int k = 0; k < 2; ++k) \
            acc[ai][bj][m][n] = __builtin_amdgcn_mfma_f32_16x16x32_bf16(Bt[n][k], At[m][k], acc[ai][bj][m][n], 0, 0, 0); } \
        __builtin_amdgcn_s_setprio(0); } while (0)
#define PG8_WAIT_V(n) asm volatile("s_waitcnt vmcnt(" #n ")" ::: "memory")
#define PG8_WAIT_L(n) asm volatile("s_waitcnt lgkmcnt(" #n ")" ::: "memory")
#define PG8_BAR __builtin_amdgcn_s_barrier()
#define PG8_SCHED __builtin_amdgcn_sched_barrier(0)
    Unit cur, nxt; int ui = 0;
    if (!S.next(0, cur)) return;
    f32x4 acc[2][2][4][2];
#pragma unroll
    for (int a = 0; a < 2; ++a)
#pragma unroll
        for (int b = 0; b < 2; ++b)
#pragma unroll
            for (int m = 0; m < 4; ++m)
#pragma unroll
                for (int n = 0; n < 2; ++n) acc[a][b][m][n] = (f32x4){0.f, 0.f, 0.f, 0.f};
    bf16x8 At[4][2], B0[2][2], B1[2][2]; i32x8 At8[4], B08[2], B18[2];
    unsigned vA[2][2], vS[2][2];
    S.aoff(cur, tid, vA);
#pragma unroll
    for (int h = 0; h < 2; ++h)
#pragma unroll
        for (int i = 0; i < 2; ++i) vS[h][i] = vA[h][i];
    const char* const A0 = (const char*)Abase;
    const char* cB = S.bptr(cur);
    PG8_STAGE(PG8_SB(0, 0), cB, voffB); PG8_STAGE(PG8_SB(0, 1), cB + hstepB, voffB); PG8_STAGE(PG8_SA(0, 0), A0, vA[0]); PG8_STAGE(PG8_SA(0, 1), A0, vA[1]);
    if (wr == 1) PG8_BAR;
    PG8_WAIT_V(2); PG8_BAR;
    PG8_STAGE(PG8_SB(1, 0), cB + kstep, voffB); PG8_STAGE(PG8_SA(1, 0), A0 + kstep, vA[0]); PG8_STAGE(PG8_SB(1, 1), cB + hstepB + kstep, voffB);
    PG8_WAIT_V(6); PG8_BAR;
    for (;;) {
        const bool has_next = S.next(ui + 1, nxt);
        const bool full = cur.nrows > HALF;
        if constexpr (Sched::ROWTAB) {
            if (wid < 4) { const int row = wid * 64 + lane;
                __builtin_amdgcn_global_load_lds((const unsigned*)(S.rowscal + (size_t)cur.e * T + cur.row0 + min(row, cur.nrows - 1)), (LAS unsigned*)(lds + SCTAB_OFF + (ui & 1) * 1024 + wid * 256), 4, 0, 0);
                if (Sched::GATHER_IDS && has_next) __builtin_amdgcn_global_load_lds((const unsigned*)(S.ltok + (size_t)nxt.e * T + nxt.row0 + min(row, nxt.nrows - 1)), (LAS unsigned*)(lds + TOKTAB_OFF + (ui & 1) * 1024 + wid * 256), 4, 0, 0); }
        }
        const char* nB = has_next ? S.bptr(nxt) : cB;
#pragma unroll 1
        for (int t = 0; t < nt; t += 2) {
            const bool last = (t == nt - 2);
            if (last && has_next) { if constexpr (Sched::GATHER_IDS) S.aoff_lds((const LAS int*)(lds + TOKTAB_OFF + (ui & 1) * 1024), tid, vS); else S.aoff(nxt, tid, vS); }
            const char* a1 = A0 + (size_t)(t + 1) * kstep;
            const char* a2 = last ? A0 : A0 + (size_t)(t + 2) * kstep; const char* b2 = last ? nB : cB + (size_t)(t + 2) * kstep;
            const char* a3 = a2 + kstep; const char* b3 = b2 + kstep;
            PG8_LDB(B0, 0, 0); PG8_LDB(B1, 0, 1); PG8_SCHED; PG8_LDA(At, 0, 0); PG8_STAGE(PG8_SA(1, 1), a1, vA[1]);
            PG8_WAIT_V(8); PG8_WAIT_L(0); PG8_BAR; PG8_MMA(0, 0, At, B0); PG8_MMA(0, 1, At, B1); PG8_BAR; PG8_SCHED;
            PG8_LDA(At, 0, 1); PG8_STAGE(PG8_SB(0, 0), b2, voffB); PG8_STAGE(PG8_SB(0, 1), b2 + hstepB, voffB); PG8_STAGE(PG8_SA(0, 0), a2, vS[0]);
            PG8_WAIT_V(8); PG8_WAIT_L(0); PG8_BAR; if (full) { PG8_MMA(1, 0, At, B0); PG8_MMA(1, 1, At, B1); } PG8_BAR; PG8_SCHED;
            PG8_LDB(B0, 1, 0); PG8_LDB(B1, 1, 1); PG8_SCHED; PG8_LDA(At, 1, 0); PG8_STAGE(PG8_SA(0, 1), a2, vS[1]);
            PG8_WAIT_V(8); PG8_WAIT_L(0); PG8_BAR; PG8_MMA(0, 0, At, B0); PG8_MMA(0, 1, At, B1); PG8_BAR; PG8_SCHED;
            PG8_LDA(At, 1, 1); PG8_STAGE(PG8_SB(1, 0), b3, voffB); PG8_STAGE(PG8_SB(1, 1), b3 + hstepB, voffB); PG8_STAGE(PG8_SA(1, 0), a3, vS[0]);
            PG8_WAIT_V(8); PG8_WAIT_L(0); PG8_BAR; if (full) { PG8_MMA(1, 0, At, B0); PG8_MMA(1, 1, At, B1); } PG8_BAR; PG8_SCHED;
        }
        if (wr == 0) PG8_BAR;
        if constexpr (FP8) asm volatile("s_nop 7\n\ts_nop 7\n\ts_nop 7" ::: "memory");
        { const int t2 = phase_tid(), l2 = t2 & 63; E(acc, cur, wr, wc, l2 & 15, l2 >> 4, (const LAS float*)(lds + SCTAB_OFF + (ui & 1) * 1024)); }
        if (!has_next) break;
#pragma unroll
        for (int a = 0; a < 2; ++a)
#pragma unroll
            for (int b = 0; b < 2; ++b)
#pragma unroll
                for (int m = 0; m < 4; ++m)
#pragma unroll
                    for (int n = 0; n < 2; ++n) acc[a][b][m][n] = (f32x4){0.f, 0.f, 0.f, 0.f};
        cur = nxt; cB = nB; ++ui;
#pragma unroll
        for (int h = 0; h < 2; ++h)
#pragma unroll
            for (int i = 0; i < 2; ++i) vA[h][i] = vS[h][i];
        if (wr == 1) PG8_BAR;
    }
    PG8_WAIT_V(0);
    PG8_BAR;
#undef PG8_SA
#undef PG8_SB
#undef PG8_STAGE
#undef PG8_LDA
#undef PG8_LDB
#undef PG8_MMA
#undef PG8_WAIT_V
#undef PG8_WAIT_L
#undef PG8_BAR
#undef PG8_SCHED
}

__device__ __forceinline__ u32x4 pack_rows(const f32x4 v0, const f32x4 v1) { u32x4 w; w.x = cvt_pk_bf16(v0[0], v0[1]); w.y = cvt_pk_bf16(v0[2], v0[3]); w.z = cvt_pk_bf16(v1[0], v1[1]); w.w = cvt_pk_bf16(v1[2], v1[3]); return w; }
struct EpiG1 {
    static constexpr bool WIDE = false;
    bf16_t* ZB;
    __device__ __forceinline__ void operator()(const f32x4 (&acc)[2][2][4][2], const Unit& u, int wr, int wc, int fr, int fq, const LAS float* sct) const {
        const int row0 = u.pm * BM + wr * 64 + fr;
#pragma unroll
        for (int ai = 0; ai < 2; ++ai)
#pragma unroll
            for (int m = 0; m < 4; ++m) { bf16_t* rowp = ZB + (size_t)(row0 + ai * HALF + m * 16) * D;
                if (u.pn < 8) { *(u32x4*)(rowp + u.pn * 128 + wc * 32 + 8 * fq) = pack_rows(acc[ai][0][m][0] * acc[ai][1][m][0], acc[ai][0][m][1] * acc[ai][1][m][1]); }
                else {
#pragma unroll
                    for (int bj = 0; bj < 2; ++bj) *(u32x4*)(rowp + (size_t)T * D + (u.pn - 8) * BM + bj * HALF + wc * 32 + 8 * fq) = pack_rows(acc[ai][bj][m][0], acc[ai][bj][m][1]); } }
    }
};
template <bool SCALED> struct EpiRes {
    static constexpr bool WIDE = true;
    const bf16_t* res; bf16_t* X; unsigned char* XQ; const float* rinv; const float* gcol;
    __device__ __forceinline__ void operator()(const f32x4 (&acc)[2][2][4][2], const Unit& u, int wr, int wc, int fr, int fq, const LAS float* sct) const {
        const int row0 = u.pm * BM + wr * 64 + fr, col0 = u.pn * BM + wc * 64 + 16 * fq;
        float gi[2][8];
        if (SCALED) {
#pragma unroll
            for (int bj = 0; bj < 2; ++bj) { const f32x4 g0 = *(const f32x4*)(gcol + col0 + 8 * bj), g1 = *(const f32x4*)(gcol + col0 + 8 * bj + 4);
                gi[bj][0] = __builtin_amdgcn_rcpf(g0.x); gi[bj][1] = __builtin_amdgcn_rcpf(g0.y); gi[bj][2] = __builtin_amdgcn_rcpf(g0.z); gi[bj][3] = __builtin_amdgcn_rcpf(g0.w);
                gi[bj][4] = __builtin_amdgcn_rcpf(g1.x); gi[bj][5] = __builtin_amdgcn_rcpf(g1.y); gi[bj][6] = __builtin_amdgcn_rcpf(g1.z); gi[bj][7] = __builtin_amdgcn_rcpf(g1.w); } }
#pragma unroll
        for (int ai = 0; ai < 2; ++ai) {
            u32x4 rb[4][2]; float ri[4];
#pragma unroll
            for (int m = 0; m < 4; ++m) { const size_t off = (size_t)(row0 + ai * HALF + m * 16) * D + col0; ri[m] = SCALED ? rinv[row0 + ai * HALF + m * 16] : 1.0f;
#pragma unroll
                for (int bj = 0; bj < 2; ++bj) rb[m][bj] = __builtin_nontemporal_load((const u32x4*)(res + off + 8 * bj)); }
#pragma unroll
            for (int m = 0; m < 4; ++m) { const size_t off = (size_t)(row0 + ai * HALF + m * 16) * D + col0; u32x4 q;
#pragma unroll
                for (int bj = 0; bj < 2; ++bj) { float f[8]; unpack8(rb[m][bj], f);
                    if (SCALED) {
#pragma unroll
                        for (int e = 0; e < 8; ++e) f[e] = f[e] * ri[m] * gi[bj][e]; }
                    const f32x4 o0 = (f32x4){f[0], f[1], f[2], f[3]} + acc[ai][bj][m][0], o1 = (f32x4){f[4], f[5], f[6], f[7]} + acc[ai][bj][m][1];
                    *(u32x4*)(X + off + 8 * bj) = pack_rows(o0, o1);
                    q[2 * bj] = pk4_fp8(2.f * o0[0], 2.f * o0[1], 2.f * o0[2], 2.f * o0[3]); q[2 * bj + 1] = pk4_fp8(2.f * o1[0], 2.f * o1[1], 2.f * o1[2], 2.f * o1[3]); }
                *(u32x4*)(XQ + off) = q; }
        }
    }
};
struct EpiG3 {
    static constexpr bool WIDE = false;
    const float* lrs; unsigned char* H;
    __device__ __forceinline__ void operator()(const f32x4 (&acc)[2][2][4][2], const Unit& u, int wr, int wc, int fr, int fq, const LAS float* sct) const {
        float scv[2][4];
#pragma unroll
        for (int ai = 0; ai < 2; ++ai)
#pragma unroll
            for (int m = 0; m < 4; ++m) { const int r = ai * HALF + wr * 64 + m * 16 + fr; scv[ai][m] = sct[r]; }
#pragma unroll
        for (int ai = 0; ai < 2; ++ai)
#pragma unroll
            for (int m = 0; m < 4; ++m) { const int r = ai * HALF + wr * 64 + m * 16 + fr;
                if (r < u.nrows) { const float sc = scv[ai][m] * (1.0f / 64.0f); f32x4 o[2];
#pragma unroll
                    for (int n = 0; n < 2; ++n)
#pragma unroll
                        for (int j = 0; j < 4; ++j) o[n][j] = 4.0f * silu(sc * acc[ai][0][m][n][j]) * (sc * acc[ai][1][m][n][j]);
                    u32x2 q; q.x = pk4_fp8(o[0][0], o[0][1], o[0][2], o[0][3]); q.y = pk4_fp8(o[1][0], o[1][1], o[1][2], o[1][3]);
                    *(u32x2*)(H + (size_t)(u.slot0 + r) * F + u.pn * 128 + wc * 32 + 8 * fq) = q; } }
    }
};
struct EpiG4 {
    static constexpr bool WIDE = true;
    const float* lgate; unsigned char* YS;
    __device__ __forceinline__ void operator()(const f32x4 (&acc)[2][2][4][2], const Unit& u, int wr, int wc, int fr, int fq, const LAS float* sct) const {
        float gv[2][4];
#pragma unroll
        for (int ai = 0; ai < 2; ++ai)
#pragma unroll
            for (int m = 0; m < 4; ++m) { const int r = ai * HALF + wr * 64 + m * 16 + fr; gv[ai][m] = sct[r]; }
#pragma unroll
        for (int ai = 0; ai < 2; ++ai)
#pragma unroll
            for (int m = 0; m < 4; ++m) { const int r = ai * HALF + wr * 64 + m * 16 + fr;
                if (r < u.nrows) { const float g = gv[ai][m] * (16.0f / 128.0f);
                    u32x4 q;
#pragma unroll
                    for (int bj = 0; bj < 2; ++bj) { const f32x4 o0 = acc[ai][bj][m][0] * g, o1 = acc[ai][bj][m][1] * g; q[2 * bj] = pk4_fp8(o0[0], o0[1], o0[2], o0[3]); q[2 * bj + 1] = pk4_fp8(o1[0], o1[1], o1[2], o1[3]); }
                    *(u32x4*)(YS + (size_t)(u.slot0 + r) * D + u.pn * BM + wc * 64 + 16 * fq) = q; } }
    }
};
struct EpiG5 {
    static constexpr bool WIDE = true;
    const float* rs; const float* bias; bf16_t* UV; f32x2* lnp;
    __device__ __forceinline__ void operator()(const f32x4 (&acc)[2][2][4][2], const Unit& u, int wr, int wc, int fr, int fq, const LAS float* sct) const {
        const int row0 = u.pm * BM + wr * 64 + fr, col0 = u.pn * BM + wc * 64 + 16 * fq;
        f32x4 bv[2][2];
#pragma unroll
        for (int bj = 0; bj < 2; ++bj)
#pragma unroll
            for (int n = 0; n < 2; ++n) bv[bj][n] = *(const f32x4*)(bias + col0 + 8 * bj + 4 * n);
        float scv[2][4];
#pragma unroll
        for (int ai = 0; ai < 2; ++ai)
#pragma unroll
            for (int m = 0; m < 4; ++m) scv[ai][m] = rs[row0 + ai * HALF + m * 16];
#pragma unroll
        for (int ai = 0; ai < 2; ++ai)
#pragma unroll
            for (int m = 0; m < 4; ++m) { const int row = row0 + ai * HALF + m * 16; const float sc = scv[ai][m];
                float ps = 0.f, pq = 0.f;
#pragma unroll
                for (int bj = 0; bj < 2; ++bj) { f32x4 o[2];
#pragma unroll
                    for (int n = 0; n < 2; ++n)
#pragma unroll
                        for (int j = 0; j < 4; ++j) { o[n][j] = gelu_tanh(sc * acc[ai][bj][m][n][j] + bv[bj][n][j]); ps += o[n][j]; pq += o[n][j] * o[n][j]; }
                    *(u32x4*)(UV + (u.pn >= 4 ? (size_t)T * D : (size_t)0) + (size_t)row * D + (col0 & (D - 1)) + 8 * bj) = pack_rows(o[0], o[1]); }
                if (u.pn >= 4) { ps += __shfl_xor(ps, 16); ps += __shfl_xor(ps, 32); pq += __shfl_xor(pq, 16); pq += __shfl_xor(pq, 32);
                    if (fq == 0) lnp[(size_t)row * 16 + (u.pn - 4) * 4 + wc] = (f32x2){ps, pq}; } }
    }
};

__device__ __forceinline__ void ph_prep_x(const float* __restrict__ x, const float* __restrict__ g, bf16_t* __restrict__ xn, float* __restrict__ rinv) {
    const int tid = phase_tid(), lane = tid & 63, gw = ((int)blockIdx.x * NT + tid) >> 6, ngw = ((int)gridDim.x * NT) >> 6;
    f32x4 gv[4];
#pragma unroll
    for (int j = 0; j < 4; ++j) gv[j] = ((const f32x4*)g)[lane + 64 * j];
    for (int row = gw; row < T; row += 2 * ngw) {
        const int row2 = row + ngw;
        const bool has2 = row2 < T;
        const f32x4* xr = (const f32x4*)(x + (size_t)row * D) + lane; const f32x4* xr2 = (const f32x4*)(x + (size_t)(has2 ? row2 : row) * D) + lane;
        f32x4 v[4], w[4]; float s = 0.f, s2 = 0.f;
#pragma unroll
        for (int j = 0; j < 4; ++j) { v[j] = __builtin_nontemporal_load(xr + 64 * j); w[j] = __builtin_nontemporal_load(xr2 + 64 * j); }
#pragma unroll
        for (int j = 0; j < 4; ++j) { s += (v[j].x * v[j].x + v[j].y * v[j].y) + (v[j].z * v[j].z + v[j].w * v[j].w); s2 += (w[j].x * w[j].x + w[j].y * w[j].y) + (w[j].z * w[j].z + w[j].w * w[j].w); }
        const float r = rsqrtf(wave_sum(s) * (1.0f / D) + EPS), r2 = rsqrtf(wave_sum(s2) * (1.0f / D) + EPS);
        if (lane == 0) { rinv[row] = 1.0f / r; if (has2) rinv[row2] = 1.0f / r2; }
        u32x2* o = (u32x2*)(xn + (size_t)row * D) + lane; u32x2* o2 = (u32x2*)(xn + (size_t)row2 * D) + lane;
#pragma unroll
        for (int j = 0; j < 4; ++j) { u32x2 q; q.x = pk2(v[j].x * r * gv[j].x, v[j].y * r * gv[j].y); q.y = pk2(v[j].z * r * gv[j].z, v[j].w * r * gv[j].w); o[64 * j] = q; }
        if (has2) {
#pragma unroll
            for (int j = 0; j < 4; ++j) { u32x2 q; q.x = pk2(w[j].x * r2 * gv[j].x, w[j].y * r2 * gv[j].y); q.y = pk2(w[j].z * r2 * gv[j].z, w[j].w * r2 * gv[j].w); o2[64 * j] = q; } }
    }
}
__device__ __forceinline__ int map_row(int mapkind, int n) {
    if (mapkind == 0) return n;
    if (mapkind == 1) { if (n < D) return 2 * D + n; const int ch = (n - D) & (D - 1), second = (n >= 2 * D); return 256 * (ch >> 7) + 128 * second + (ch & 127); }
    return 256 * (n >> 7) + (mapkind == 3 ? 128 : 0) + (n & 127);
}
struct TrItem { const float* src; int k0, n0; };
__device__ __forceinline__ void tr_load(const float* __restrict__ W, int N, int item, int lane, f32x4 (&v)[16]) {
    const int nblk = N / 64, kb = item / nblk, nb = item % nblk, k0 = 64 * kb, n0 = 64 * nb, kq = lane >> 4, nn = 4 * (lane & 15);
#pragma unroll
    for (int i = 0; i < 16; ++i) v[i] = __builtin_nontemporal_load((const f32x4*)(W + (size_t)(k0 + 4 * i + kq) * N + n0 + nn));
}
template <bool FP8OUT> __device__ __forceinline__ void tr_process(const f32x4 (&v)[16], int K, int N, void* __restrict__ WTv, int mapkind, const float* __restrict__ kscale, LAS float* scr, int item, int lane) {
    const int nblk = N / 64, kb = item / nblk, nb = item % nblk, k0 = 64 * kb, n0 = 64 * nb, kq = lane >> 4, nn = 4 * (lane & 15);
#pragma unroll
    for (int i = 0; i < 16; ++i) { const int kk = 4 * i + kq; const float sc = (kscale ? kscale[k0 + kk] : 1.0f) * (FP8OUT ? 32.0f : 1.0f); LAS float* d = scr + kk * 65 + nn;
        d[0] = v[i].x * sc; d[1] = v[i].y * sc; d[2] = v[i].z * sc; d[3] = v[i].w * sc; }
    LDS_WAIT();
    if constexpr (!FP8OUT) {
        bf16_t* WT = (bf16_t*)WTv; const int c = lane & 7;
#pragma unroll
        for (int j = 0; j < 8; ++j) { const int n = (lane >> 3) + 8 * j; const LAS float* sp = scr + (8 * c) * 65 + n;
            u32x4 o; o.x = pk2(sp[0 * 65], sp[1 * 65]); o.y = pk2(sp[2 * 65], sp[3 * 65]); o.z = pk2(sp[4 * 65], sp[5 * 65]); o.w = pk2(sp[6 * 65], sp[7 * 65]);
            *(u32x4*)(WT + (size_t)map_row(mapkind, n0 + n) * K + k0 + 8 * c) = o; }
    } else {
        unsigned char* WT = (unsigned char*)WTv; const int c = lane & 3;
#pragma unroll
        for (int j = 0; j < 4; ++j) { const int n = (lane >> 2) + 16 * j; const LAS float* sp = scr + (16 * c) * 65 + n;
            u32x4 o; o.x = pk4_fp8(sp[0 * 65], sp[1 * 65], sp[2 * 65], sp[3 * 65]); o.y = pk4_fp8(sp[4 * 65], sp[5 * 65], sp[6 * 65], sp[7 * 65]);
            o.z = pk4_fp8(sp[8 * 65], sp[9 * 65], sp[10 * 65], sp[11 * 65]); o.w = pk4_fp8(sp[12 * 65], sp[13 * 65], sp[14 * 65], sp[15 * 65]);
            *(u32x4*)(WT + (size_t)map_row(mapkind, n0 + n) * K + k0 + 16 * c) = o; }
    }
    LDS_WAIT();
}
template <bool FP8OUT> __device__ __forceinline__ void ph_transpose(LAS unsigned char* lds, const float* W, int K, int N, void* WT, int mapkind, const float* kscale, int nbatch, size_t sstride, size_t dstride, int shift = 0) {
    const int tid = phase_tid(), lane = tid & 63, wave = tid >> 6, ngw = (int)gridDim.x * NWAVES, gw = ((int)blockIdx.x * NWAVES + wave + ngw - (shift % ngw)) % ngw;
    LAS float* scr = (LAS float*)(lds + wave * 16640);
    const int per = (K / 64) * (N / 64), nitems = per * nbatch;
    f32x4 v[16], vn[16];
    int it = gw;
    if (it < nitems) tr_load(W + (size_t)(it / per) * sstride, N, it % per, lane, v);
    while (it < nitems) {
        const int nx = it + ngw;
        if (nx < nitems) tr_load(W + (size_t)(nx / per) * sstride, N, nx % per, lane, vn);
        tr_process<FP8OUT>(v, K, N, (unsigned char*)WT + (size_t)(it / per) * dstride * (FP8OUT ? 1 : 2), mapkind, kscale, scr, it % per, lane);
#pragma unroll
        for (int i = 0; i < 16; ++i) v[i] = vn[i];
        it = nx;
    }
}
__device__ __forceinline__ void ph_prep_experts(LAS unsigned char* lds, int layer, const float* w_gate, const float* w_up, const float* w_down, const float* ln2, unsigned char* WGU, unsigned char* WD) {
    ph_transpose<true>(lds, w_gate + (size_t)layer * NE * D * F, D, F, WGU, 2, ln2 + layer * D, NE, (size_t)D * F, (size_t)1024 * D);
    ph_transpose<true>(lds, w_up + (size_t)layer * NE * D * F, D, F, WGU, 3, ln2 + layer * D, NE, (size_t)D * F, (size_t)1024 * D);
    ph_transpose<true>(lds, w_down + (size_t)layer * NE * F * D, F, D, WD, 0, nullptr, NE, (size_t)F * D, (size_t)D * F);
}
__device__ __forceinline__ void ph_prep_router(const float* __restrict__ ln2, const float* __restrict__ wg, const float* __restrict__ we, bf16_t* __restrict__ wr) {
    for (int i = (int)blockIdx.x * NT + phase_tid(); i < 2 * 48 * D; i += (int)gridDim.x * NT) {
        const int l = i / (48 * D), j = (i / D) % 48, k = i % D;
        float w = 0.f;
        if (j < 4) w = wg[((size_t)l * D + k) * NG + j]; else if (j < 36) w = we[((size_t)l * D + k) * NE + (j - 4)];
        w *= ln2[l * D + k];
        const unsigned hi = f2bf(w); const unsigned lo = f2bf(w - bf2f(hi));
        wr[((size_t)l * 2 + 0) * 48 * D + (size_t)j * D + k] = (bf16_t)hi; wr[((size_t)l * 2 + 1) * 48 * D + (size_t)j * D + k] = (bf16_t)lo;
    }
}
__device__ __forceinline__ void ph_prep_wm(const float* __restrict__ ws, bf16_t* __restrict__ wm) {
    for (int i = (int)blockIdx.x * NT + phase_tid(); i < NH * CHUNK * CHUNK; i += (int)gridDim.x * NT) { const int t = (i / CHUNK) % CHUNK, s = i % CHUNK; wm[i] = (bf16_t)f2bf(t >= s ? ws[i] : 0.f); }
}
__device__ __forceinline__ void ph_conv(const bf16_t* __restrict__ ZB, const float* __restrict__ cw, bf16_t* __restrict__ Y) {
    constexpr int RB = 8;
    const int nitems = (T / RB) * (D / 8);
    for (int it = (int)blockIdx.x * NT + phase_tid(); it < nitems; it += (int)gridDim.x * NT) {
        const int cg8 = it & 127, rb = it >> 7, r0 = rb * RB, ch = cg8 * 8, t0 = r0 & (SEQ - 1);
        float w[3][8];
#pragma unroll
        for (int k = 0; k < 3; ++k)
#pragma unroll
            for (int i = 0; i < 8; ++i) w[k][i] = cw[k * D + ch + i];
        float zm2[8], zm1[8];
        if (t0 >= 2) { unpack8(__builtin_nontemporal_load((const u32x4*)(ZB + (size_t)(r0 - 2) * D + ch)), zm2); unpack8(__builtin_nontemporal_load((const u32x4*)(ZB + (size_t)(r0 - 1) * D + ch)), zm1); }
        else {
#pragma unroll
            for (int i = 0; i < 8; ++i) { zm2[i] = 0.f; zm1[i] = 0.f; } }
#pragma unroll
        for (int r = 0; r < RB; ++r) {
            float z[8], b[8], o[8];
            unpack8(__builtin_nontemporal_load((const u32x4*)(ZB + (size_t)(r0 + r) * D + ch)), z); unpack8(__builtin_nontemporal_load((const u32x4*)(ZB + (size_t)T * D + (size_t)(r0 + r) * D + ch)), b);
#pragma unroll
            for (int i = 0; i < 8; ++i) { o[i] = b[i] * (w[0][i] * zm2[i] + w[1][i] * zm1[i] + w[2][i] * z[i]); zm2[i] = zm1[i]; zm1[i] = z[i]; }
            *(u32x4*)(Y + (size_t)(r0 + r) * D + ch) = pack8(o);
        }
    }
}
__device__ __forceinline__ void ph_route(LAS unsigned char* lds, const bf16_t* __restrict__ X, const bf16_t* __restrict__ wrh, const float* __restrict__ bg, const float* __restrict__ be,
                                         unsigned* __restrict__ cnt, unsigned* __restrict__ asg, int* __restrict__ ltok, float* __restrict__ lgate, float* __restrict__ lrs) {
    const int tid = phase_tid(), wave = tid >> 6, lane = tid & 63, fr = lane & 15, fq = lane >> 4;
    LAS float* lgs = (LAS float*)(lds + wave * 4096);
    LAS int* s_e = (LAS int*)(lds + 32768); LAS float* s_g = (LAS float*)(lds + 32768 + 1024); LAS float* s_r = (LAS float*)(lds + 32768 + 2048);
    LAS unsigned* s_cnt = (LAS unsigned*)(lds + 32768 + 3072); LAS unsigned* s_base = (LAS unsigned*)(lds + 32768 + 3200); LAS unsigned* s_rank = (LAS unsigned*)(lds + 32768 + 3328);
    const bf16_t* wrl = wrh + 48 * D;
    for (int tb = (int)blockIdx.x * 128; tb < T; tb += (int)gridDim.x * 128) {
        if (tid < NE) s_cnt[tid] = 0u;
        const int tok0 = tb + wave * 16;
        f32x4 acc[3]; float ss = 0.f;
#pragma unroll
        for (int n = 0; n < 3; ++n) acc[n] = (f32x4){0.f, 0.f, 0.f, 0.f};
        constexpr int WCH_PITCH = 272, WCH_BYTES = 2 * 48 * WCH_PITCH;
        LAS unsigned char* wbuf = lds + 49152;
        u32x4 wreg[3], araw[4];
#pragma unroll
        for (int p = 0; p < 3; ++p) { const int pc = tid + 512 * p, hl = pc / 768, row = (pc % 768) >> 4, kc = pc & 15; wreg[p] = *(const u32x4*)(wrh + (size_t)hl * 48 * D + (size_t)row * D + kc * 8); }
#pragma unroll
        for (int q = 0; q < 4; ++q) araw[q] = *(const u32x4*)(X + (size_t)(tok0 + fr) * D + q * 32 + fq * 8);
#pragma unroll 1
        for (int kb = 0; kb < D / 128; ++kb) {
            LAS unsigned char* wb = wbuf + (kb & 1) * WCH_BYTES;
#pragma unroll
            for (int p = 0; p < 3; ++p) { const int pc = tid + 512 * p, hl = pc / 768, row = (pc % 768) >> 4, kc = pc & 15; *(LAS u32x4*)(wb + (hl * 48 + row) * WCH_PITCH + kc * 16) = wreg[p]; }
            u32x4 acur[4];
#pragma unroll
            for (int q = 0; q < 4; ++q) acur[q] = araw[q];
            __syncthreads();
            if (kb + 1 < D / 128) {
#pragma unroll
                for (int p = 0; p < 3; ++p) { const int pc = tid + 512 * p, hl = pc / 768, row = (pc % 768) >> 4, kc = pc & 15; wreg[p] = *(const u32x4*)(wrh + (size_t)hl * 48 * D + (size_t)row * D + (kb + 1) * 128 + kc * 8); }
#pragma unroll
                for (int q = 0; q < 4; ++q) araw[q] = *(const u32x4*)(X + (size_t)(tok0 + fr) * D + ((kb + 1) * 4 + q) * 32 + fq * 8);
            }
#pragma unroll
            for (int q = 0; q < 4; ++q) {
                float af[8]; unpack8(acur[q], af);
#pragma unroll
                for (int e = 0; e < 8; ++e) ss += af[e] * af[e];
                const bf16x8 a = __builtin_bit_cast(bf16x8, acur[q]);
#pragma unroll
                for (int n = 0; n < 3; ++n) {
                    const bf16x8 bh = *(const LAS bf16x8*)(wb + (n * 16 + fr) * WCH_PITCH + (q * 32 + fq * 8) * 2);
                    const bf16x8 bl = *(const LAS bf16x8*)(wb + (48 + n * 16 + fr) * WCH_PITCH + (q * 32 + fq * 8) * 2);
                    acc[n] = __builtin_amdgcn_mfma_f32_16x16x32_bf16(a, bh, acc[n], 0, 0, 0); acc[n] = __builtin_amdgcn_mfma_f32_16x16x32_bf16(a, bl, acc[n], 0, 0, 0); }
            }
        }
        __syncthreads();
        ss += __shfl_xor(ss, 16); ss += __shfl_xor(ss, 32);
#pragma unroll
        for (int n = 0; n < 3; ++n)
#pragma unroll
            for (int j = 0; j < 4; ++j) lgs[(fq * 4 + j) * 49 + n * 16 + fr] = acc[n][j];
        if (fq == 0) lgs[16 * 49 + fr] = rsqrtf(ss * (1.0f / D) + EPS);
        LDS_WAIT();
        if (lane < 16) {
            const float r = lgs[16 * 49 + lane]; const LAS float* L = lgs + lane * 49;
            float lg[36];
#pragma unroll
            for (int j = 0; j < 36; ++j) lg[j] = L[j] * r + (j < 4 ? bg[j] : be[j - 4]);
            int gi = 0; float gm = lg[0];
#pragma unroll
            for (int j = 1; j < 4; ++j) if (lg[j] > gm) { gm = lg[j]; gi = j; }
            float gs = 0.f;
#pragma unroll
            for (int j = 0; j < 4; ++j) gs += __expf(lg[j] - gm);
            const float gp = 1.0f / gs;
            float el[8];
#pragma unroll
            for (int j = 0; j < 8; ++j) { el[j] = lg[4 + j];
#pragma unroll
                for (int g = 1; g < 4; ++g) el[j] = (gi == g) ? lg[4 + g * 8 + j] : el[j]; }
            int i0 = 0; float m0 = el[0];
#pragma unroll
            for (int j = 1; j < 8; ++j) if (el[j] > m0) { m0 = el[j]; i0 = j; }
            int i1 = 0; float m1 = -3.0e38f;
#pragma unroll
            for (int j = 0; j < 8; ++j) if (j != i0 && el[j] > m1) { m1 = el[j]; i1 = j; }
            const float eb = __expf(m1 - m0), den = 1.0f / (1.0f + eb);
            const int tl = wave * 16 + lane;
            s_e[2 * tl] = gi * 8 + i0; s_e[2 * tl + 1] = gi * 8 + i1; s_g[2 * tl] = gp * den; s_g[2 * tl + 1] = gp * eb * den; s_r[tl] = r;
        }
        __syncthreads();
        if (tid < 256) s_rank[tid] = atomicAdd((unsigned*)&s_cnt[s_e[tid]], 1u);
        __syncthreads();
        if (tid < NE) s_base[tid] = s_cnt[tid] ? atomicAdd(&cnt[tid], s_cnt[tid]) : 0u;
        __syncthreads();
        if (tid < 256) { const int e = s_e[tid], tok = tb + (tid >> 1); const unsigned pos = s_base[e] + s_rank[tid];
            ltok[(size_t)e * T + pos] = tok; lgate[(size_t)e * T + pos] = s_g[tid]; lrs[(size_t)e * T + pos] = s_r[tid >> 1];
            asg[(size_t)tok * 4 + (tid & 1) * 2] = ((unsigned)e << 24) | pos; asg[(size_t)tok * 4 + (tid & 1) * 2 + 1] = __float_as_uint(s_g[tid]); }
        __syncthreads();
    }
}
__device__ __forceinline__ int build_tile_table(LAS unsigned char* lds, const unsigned* __restrict__ cnt) {
    LAS int* tab = (LAS int*)(lds + TAB_OFF); LAS int* tabn = (LAS int*)(lds + TABN_OFF);
    const int tid = phase_tid();
    if (tid < NE) {
        int bacc = 0, sacc_small = 0, sacc = 0, mine = 0, nbig_all = 0, nsmall_all = 0;
        for (int e = 0; e < NE; ++e) { const int n = (int)cnt[e], full = n / BM, rem = n % BM, nb = full + (rem > HALF ? 1 : 0), ns = (rem > 0 && rem <= HALF) ? 1 : 0;
            if (e == tid) mine = n; if (e < tid) { bacc += nb; sacc_small += ns; sacc += n; } nbig_all += nb; nsmall_all += ns; }
        const int full = mine / BM, rem = mine % BM, nb = full + (rem > HALF ? 1 : 0);
        for (int j = 0; j < nb; ++j) { const int ti = bacc + j; if (ti < TAB_MAX) { tab[ti * 4 + 0] = tid; tab[ti * 4 + 1] = j * BM; tab[ti * 4 + 2] = min(BM, mine - j * BM); tab[ti * 4 + 3] = sacc + j * BM; } }
        if (rem > 0 && rem <= HALF) { const int ti = nbig_all + sacc_small; if (ti < TAB_MAX) { tab[ti * 4 + 0] = tid; tab[ti * 4 + 1] = full * BM; tab[ti * 4 + 2] = rem; tab[ti * 4 + 3] = sacc + full * BM; } }
        if (tid == NE - 1) tabn[0] = min(nbig_all + nsmall_all, TAB_MAX);
    }
    __syncthreads();
    return __builtin_amdgcn_readfirstlane(tabn[0]);
}
template <bool FINAL> __device__ __forceinline__ void ph_combine(const bf16_t* __restrict__ X, const unsigned char* __restrict__ YS, const unsigned* __restrict__ cnt, const unsigned* __restrict__ asg,
                                                                 bf16_t* __restrict__ Xo, float* __restrict__ rs, const float* __restrict__ g, float* __restrict__ out) {
    const int tid = phase_tid(), lane = tid & 63, gw = ((int)blockIdx.x * NT + tid) >> 6, ngw = ((int)gridDim.x * NT) >> 6;
    unsigned c = lane < NE ? cnt[lane] : 0u, inc = c;
#pragma unroll
    for (int o = 1; o < 32; o <<= 1) { const unsigned t = __shfl_up(inc, o); if (lane >= o) inc += t; }
    const unsigned excl = inc - c;
    for (int rowb = gw; rowb < T; rowb += 2 * ngw) {
        int rows[2]; rows[0] = rowb; rows[1] = (rowb + ngw < T) ? rowb + ngw : rowb;
        unsigned sa[2], sb[2];
#pragma unroll
        for (int q = 0; q < 2; ++q) { const u32x4 cw = *(const u32x4*)(asg + (size_t)rows[q] * 4); sa[q] = __shfl(excl, (int)(cw.x >> 24)) + (cw.x & 0xffffffu); sb[q] = __shfl(excl, (int)(cw.z >> 24)) + (cw.z & 0xffffffu); }
        u32x4 xr[2][2]; u32x2 ar[2][2], br[2][2];
#pragma unroll
        for (int q = 0; q < 2; ++q)
#pragma unroll
            for (int h = 0; h < 2; ++h) { xr[q][h] = __builtin_nontemporal_load((const u32x4*)(X + (size_t)rows[q] * D + h * 512 + lane * 8)); ar[q][h] = __builtin_nontemporal_load((const u32x2*)(YS + (size_t)sa[q] * D + h * 512 + lane * 8)); br[q][h] = __builtin_nontemporal_load((const u32x2*)(YS + (size_t)sb[q] * D + h * 512 + lane * 8)); }
#pragma unroll
        for (int q = 0; q < 2; ++q) {
            if (q == 1 && rows[1] == rows[0]) break;
            const int row = rows[q];
            float v[16];
#pragma unroll
            for (int h = 0; h < 2; ++h) { float x8[8], a[8], b[8]; unpack8(xr[q][h], x8); unpack8_fp8(ar[q][h], a); unpack8_fp8(br[q][h], b);
#pragma unroll
                for (int i = 0; i < 8; ++i) v[h * 8 + i] = x8[i] + (a[i] + b[i]) * (1.0f / 16.0f); }
            if (!FINAL) {
                float ss = 0.f;
#pragma unroll
                for (int h = 0; h < 2; ++h) { float o8[8];
#pragma unroll
                    for (int i = 0; i < 8; ++i) { o8[i] = bf2f(f2bf(v[h * 8 + i])); ss += o8[i] * o8[i]; }
                    *(u32x4*)(Xo + (size_t)row * D + h * 512 + lane * 8) = pack8(o8); }
                const float r = rsqrtf(wave_sum(ss) * (1.0f / D) + EPS);
                if (lane == 0) rs[row] = r;
            } else {
                float ss = 0.f;
#pragma unroll
                for (int i = 0; i < 16; ++i) ss += v[i] * v[i];
                const float r = rsqrtf(wave_sum(ss) * (1.0f / D) + EPS);
#pragma unroll
                for (int h = 0; h < 2; ++h) { const f32x4 g0 = *(const f32x4*)(g + h * 512 + lane * 8), g1 = *(const f32x4*)(g + h * 512 + lane * 8 + 4);
                    f32x4 o0, o1; o0.x = v[h * 8 + 0] * r * g0.x; o0.y = v[h * 8 + 1] * r * g0.y; o0.z = v[h * 8 + 2] * r * g0.z; o0.w = v[h * 8 + 3] * r * g0.w;
                    o1.x = v[h * 8 + 4] * r * g1.x; o1.y = v[h * 8 + 5] * r * g1.y; o1.z = v[h * 8 + 6] * r * g1.z; o1.w = v[h * 8 + 7] * r * g1.w;
                    __builtin_nontemporal_store(o0, (f32x4*)(out + (size_t)row * D + h * 512 + lane * 8)); __builtin_nontemporal_store(o1, (f32x4*)(out + (size_t)row * D + h * 512 + lane * 8 + 4)); }
            }
        }
    }
}
constexpr int MIX_PITCH = 272, MIX_BUF = CHUNK * MIX_PITCH, MIX_STAT_OFF = 2 * MIX_BUF;
typedef short s16x4 __attribute__((ext_vector_type(4)));
__device__ __forceinline__ void ph_mix(LAS unsigned char* lds, const bf16_t* __restrict__ UV, const f32x2* __restrict__ lnp, const float* __restrict__ vg, const float* __restrict__ vbeta,
                                       const bf16_t* __restrict__ wm, const float* __restrict__ bs, bf16_t* __restrict__ YM) {
    const int tid = phase_tid(), wave = tid >> 6, lane = tid & 63, fr = lane & 15, fq = lane >> 4, wt = wave >> 1, wd = wave & 1;
    LAS float* stat = (LAS float*)(lds + MIX_STAT_OFF);
    const int ch = tid & 15, srow = tid >> 4;
    const int cgrp = ch >> 2, ca = ch & 3;
    for (int bc = (int)blockIdx.x; bc < T / CHUNK; bc += (int)gridDim.x) {
        const int row0 = bc * CHUNK;
        if (tid < CHUNK) { const f32x4* pp = (const f32x4*)(lnp + (size_t)(row0 + tid) * 16); float sm = 0.f, sq = 0.f;
#pragma unroll
            for (int i = 0; i < 8; ++i) { const f32x4 pv = pp[i]; sm += pv.x + pv.z; sq += pv.y + pv.w; }
            const float mu = sm * (1.0f / D), var = fmaxf(sq * (1.0f / D) - mu * mu, 0.f);
            stat[2 * tid] = mu; stat[2 * tid + 1] = rsqrtf(var + EPS); }
        __syncthreads();
        u32x4 vraw[4];
#pragma unroll
        for (int p = 0; p < 4; ++p) vraw[p] = __builtin_nontemporal_load((const u32x4*)(UV + (size_t)T * D + (size_t)(row0 + srow + 32 * p) * D + 0 * 128 + 8 * ch));
#pragma unroll 1
        for (int h = 0; h < NH; ++h) {
            LAS unsigned char* buf = lds + (h & 1) * MIX_BUF;
            float g8[8], b8[8];
            { const f32x4 ga = *(const f32x4*)(vg + h * 128 + 8 * ch), gb = *(const f32x4*)(vg + h * 128 + 8 * ch + 4), ba = *(const f32x4*)(vbeta + h * 128 + 8 * ch), bb = *(const f32x4*)(vbeta + h * 128 + 8 * ch + 4);
              g8[0] = ga.x; g8[1] = ga.y; g8[2] = ga.z; g8[3] = ga.w; g8[4] = gb.x; g8[5] = gb.y; g8[6] = gb.z; g8[7] = gb.w;
              b8[0] = ba.x; b8[1] = ba.y; b8[2] = ba.z; b8[3] = ba.w; b8[4] = bb.x; b8[5] = bb.y; b8[6] = bb.z; b8[7] = bb.w; }
#pragma unroll
            for (int p = 0; p < 4; ++p) { const int sr = srow + 32 * p; float v[8]; unpack8(vraw[p], v);
                const float mu = stat[2 * sr], rstd = stat[2 * sr + 1];
#pragma unroll
                for (int q = 0; q < 8; ++q) v[q] = (v[q] - mu) * rstd * g8[q] + b8[q];
                u32x2 lo, hi; lo.x = pk2(v[0], v[1]); lo.y = pk2(v[2], v[3]); hi.x = pk2(v[4], v[5]); hi.y = pk2(v[6], v[7]);
                *(LAS u32x2*)(buf + sr * MIX_PITCH + (32 * cgrp + 4 * ca) * 2) = lo; *(LAS u32x2*)(buf + sr * MIX_PITCH + (32 * cgrp + 16 + 4 * ca) * 2) = hi; }
            __syncthreads();
            if (h + 1 < NH) {
#pragma unroll
                for (int p = 0; p < 4; ++p) vraw[p] = __builtin_nontemporal_load((const u32x4*)(UV + (size_t)T * D + (size_t)(row0 + srow + 32 * p) * D + (h + 1) * 128 + 8 * ch)); }
            u32x4 uraw[2][2]; float bsv[2];
#pragma unroll
            for (int m = 0; m < 2; ++m) { const int t = 32 * wt + 16 * m + fr; bsv[m] = bs[h * CHUNK + t];
#pragma unroll
                for (int cc = 0; cc < 2; ++cc) uraw[m][cc] = __builtin_nontemporal_load((const u32x4*)(UV + (size_t)(row0 + t) * D + h * 128 + 32 * (2 * wd + cc) + 8 * fq)); }
            bf16x8 af[4][2];
#pragma unroll
            for (int kk = 0; kk < 4; ++kk)
#pragma unroll
                for (int m = 0; m < 2; ++m) af[kk][m] = *(const bf16x8*)(wm + ((size_t)(h * CHUNK + 32 * wt + 16 * m + fr)) * CHUNK + 32 * (kk <= wt ? kk : wt) + 8 * fq);
            f32x4 acc[2][4];
#pragma unroll
            for (int m = 0; m < 2; ++m)
#pragma unroll
                for (int n = 0; n < 4; ++n) acc[m][n] = (f32x4){0.f, 0.f, 0.f, 0.f};
            const int q4 = (lane & 15) >> 2, p4 = lane & 3;
#pragma unroll
            for (int kk = 0; kk < 4; ++kk) {
                if (kk <= wt) {
#pragma unroll
                    for (int n = 0; n < 4; ++n) {
                        const int colpos = 32 * (2 * wd + (n >> 1)) + 16 * (n & 1);
                        LAS unsigned char* base = buf + (32 * kk + 8 * fq + q4) * MIX_PITCH + colpos * 2 + 8 * p4;
                        const s16x4 t0 = __builtin_amdgcn_ds_read_tr16_b64_v4i16((LAS s16x4*)base);
                        const s16x4 t1 = __builtin_amdgcn_ds_read_tr16_b64_v4i16((LAS s16x4*)(base + 4 * MIX_PITCH));
                        bf16x8 bfrag; bfrag[0] = t0[0]; bfrag[1] = t0[1]; bfrag[2] = t0[2]; bfrag[3] = t0[3]; bfrag[4] = t1[0]; bfrag[5] = t1[1]; bfrag[6] = t1[2]; bfrag[7] = t1[3];
#pragma unroll
                        for (int m = 0; m < 2; ++m) acc[m][n] = __builtin_amdgcn_mfma_f32_16x16x32_bf16(bfrag, af[kk][m], acc[m][n], 0, 0, 0);
                    }
                }
            }
#pragma unroll
            for (int m = 0; m < 2; ++m) { const int t = 32 * wt + 16 * m + fr;
#pragma unroll
                for (int cc = 0; cc < 2; ++cc) { const int col = h * 128 + 32 * (2 * wd + cc) + 8 * fq; float u8[8], o8[8];
                    unpack8(uraw[m][cc], u8);
#pragma unroll
                    for (int n = 0; n < 2; ++n)
#pragma unroll
                        for (int r = 0; r < 4; ++r) o8[4 * n + r] = u8[4 * n + r] * (acc[m][2 * cc + n][r] + bsv[m]);
                    *(u32x4*)(YM + (size_t)(row0 + t) * D + col) = pack8(o8); } }
        }
        __syncthreads();
    }
}

#define XB_TMO      128
#define XB_XCNT(j)  (256  + 64 * (j))
#define XB_XSUB(j)  (1280 + 64 * (j))
#define XB_XGEN(j)  (2304 + 64 * (j))
#define XB_TOP      3328
#define XB_TOPGEN   3392
#define XCD_BAR_WORDS 3456
#define XB_SPIN_CAP (1u << 22)
__device__ __forceinline__ unsigned xb_ld(unsigned* p)              { return __hip_atomic_load(p, __ATOMIC_RELAXED, __HIP_MEMORY_SCOPE_AGENT); }
__device__ __forceinline__ unsigned xb_add(unsigned* p, unsigned v) { return __hip_atomic_fetch_add(p, v, __ATOMIC_RELAXED, __HIP_MEMORY_SCOPE_AGENT); }
__device__ __forceinline__ unsigned xb_xcc_id() { return (unsigned)__builtin_amdgcn_s_getreg((3 << 11) | 20) & 0xFu; }
#define XB_SPIN(cond, bar) do { unsigned _sp = 0; while (cond) { __builtin_amdgcn_s_sleep(1); \
    if ((++_sp & 255u) == 0u) { if (xb_ld(&(bar)[XB_TMO])) break; if (_sp > XB_SPIN_CAP) { atomicAdd(&(bar)[XB_TMO], 1u); break; } } } } while (0)
struct XcdBarrier { unsigned* bar; unsigned x; volatile LAS unsigned* st; };
__device__ __forceinline__ XcdBarrier xcd_barrier_post(unsigned* bar, volatile LAS unsigned* st) {
    XcdBarrier b; b.bar = bar; b.x = xb_xcc_id(); b.st = st;
    if (threadIdx.x == 0) (void)xb_add(&bar[XB_XCNT(b.x)], 1u);
    return b;
}
__device__ __forceinline__ void xcd_barrier_complete(unsigned* bar, unsigned x, unsigned& nloc, unsigned& nx) {
    const unsigned G = gridDim.x * gridDim.y * gridDim.z;
    unsigned sum, cnt, mine, sp = 0u;
    for (;;) {
        sum = 0u; cnt = 0u; mine = 0u;
#pragma unroll
        for (unsigned j = 0; j < 16; ++j) { const unsigned c = xb_ld(&bar[XB_XCNT(j)]); sum += c; cnt += (c > 0u) ? 1u : 0u; mine = (j == x) ? c : mine; }
        if (sum == G) break;
        __builtin_amdgcn_s_sleep(1);
        if ((++sp & 255u) == 0u) { if (xb_ld(&bar[XB_TMO])) break; if (sp > XB_SPIN_CAP) { atomicAdd(&bar[XB_TMO], 1u); break; } }
    }
    nloc = mine > 0u ? mine : 1u; nx = cnt > 0u ? cnt : 1u;
}
__device__ __forceinline__ void xcd_barrier(const XcdBarrier& b) {
    asm volatile("s_waitcnt vmcnt(0)" ::: "memory");
    __syncthreads();
    if (threadIdx.x == 0) {
        unsigned* bar = b.bar;
        __builtin_amdgcn_s_waitcnt(0);
        unsigned nloc = b.st[0], nx = b.st[1];
        if (nloc == 0u) { xcd_barrier_complete(bar, b.x, nloc, nx); b.st[0] = nloc; b.st[1] = nx; }
        const unsigned old = xb_add(&bar[XB_XSUB(b.x)], 1u);
        const unsigned gen = old / nloc;
        if (old + 1u == (gen + 1u) * nloc) {
            __builtin_amdgcn_fence(__ATOMIC_RELEASE, "agent");
            asm volatile("s_waitcnt vmcnt(0)" ::: "memory");
            const unsigned og = xb_add(&bar[XB_TOP], 1u);
            const unsigned tg = og / nx;
            if (og + 1u == (tg + 1u) * nx) xb_add(&bar[XB_TOPGEN], 1u);
            else XB_SPIN(xb_ld(&bar[XB_TOPGEN]) == tg, bar);
            __builtin_amdgcn_fence(__ATOMIC_ACQUIRE, "agent");
            xb_add(&bar[XB_XGEN(b.x)], 1u);
            asm volatile("s_waitcnt vmcnt(0)" ::: "memory");
        } else {
            XB_SPIN(xb_ld(&bar[XB_XGEN(b.x)]) == gen, bar);
            __builtin_amdgcn_fence(__ATOMIC_ACQUIRE, "agent");
            asm volatile("s_waitcnt vmcnt(0)" ::: "memory");
        }
    }
    __syncthreads();
}

#ifndef REP_PREP
#define REP_PREP 1
#endif
#ifndef REP_THIN
#define REP_THIN 1
#endif
#ifndef REP_GEMM
#define REP_GEMM 1
#endif
#ifndef REP_SYNC
#define REP_SYNC 1
#endif
#define REPEAT(n, ...) for (int rep_ = 0; rep_ < (n); ++rep_) { __VA_ARGS__; if (rep_ + 1 < (n)) xcd_barrier(xbar); }
#define GSYNC() do { for (int rs_ = 0; rs_ < REP_SYNC; ++rs_) xcd_barrier(xbar); } while (0)
struct Params { const float* in[22]; float* out; unsigned char* ws; };
__global__ void __launch_bounds__(NT, 2) mega_fwd(Params P) {
    extern __shared__ __attribute__((aligned(16))) unsigned char lds_raw[];
    LAS unsigned char* lds = (LAS unsigned char*)lds_raw;
    cg::grid_group grid = cg::this_grid();
    const int G = (int)gridDim.x, bid = (int)blockIdx.x;
    if (P.ws == nullptr) grid.sync();
    if (threadIdx.x < 4) ((LAS unsigned*)(lds + BARST_OFF))[threadIdx.x] = 0u;
    __syncthreads();
    const XcdBarrier xbar = xcd_barrier_post((unsigned*)(P.ws + WS_CTL) + CW_BAR, (volatile LAS unsigned*)(lds + BARST_OFF));
    const float* x = P.in[0]; const float* ln_a = P.in[1]; const float* w_in_a = P.in[2]; const float* conv_w = P.in[3];
    const float* w_out_a = P.in[4]; const float* ln_b = P.in[5]; const float* w_in_b = P.in[6]; const float* b_in_b = P.in[7];
    const float* v_ln_g = P.in[8]; const float* v_ln_b = P.in[9]; const float* w_s = P.in[10]; const float* b_s = P.in[11];
    const float* w_out_b = P.in[12]; const float* ln2 = P.in[13]; const float* w_group = P.in[14]; const float* b_group = P.in[15];
    const float* w_expert = P.in[16]; const float* b_expert = P.in[17]; const float* w_gate = P.in[18]; const float* w_up = P.in[19];
    const float* w_down = P.in[20]; const float* ln_f = P.in[21];
    unsigned char* ws = P.ws; float* out = P.out;
    unsigned* ctl = (unsigned*)(ws + WS_CTL); float* RS = (float*)(ws + WS_RS); unsigned* ASG = (unsigned*)(ws + WS_ASG); float* LNS = (float*)(ws + WS_LNS);
    int* LTOK = (int*)(ws + WS_LTOK); float* LGATE = (float*)(ws + WS_LGATE); float* LRS = (float*)(ws + WS_LRS); bf16_t* WR = (bf16_t*)(ws + WS_WR); bf16_t* WM = (bf16_t*)(ws + WS_WM);
    bf16_t* WA_IN = (bf16_t*)(ws + WS_WA_IN); bf16_t* WA_OUT = (bf16_t*)(ws + WS_WA_OUT); bf16_t* WB_IN = (bf16_t*)(ws + WS_WB_IN); bf16_t* WB_OUT = (bf16_t*)(ws + WS_WB_OUT);
    unsigned char* WGU = ws + WS_WGU; unsigned char* WD = ws + WS_WD; unsigned char* XQ = ws + WS_XQ;
    bf16_t* bufA = (bf16_t*)(ws + WS_A); bf16_t* bufB = (bf16_t*)(ws + WS_B); bf16_t* bufC = (bf16_t*)(ws + WS_C); bf16_t* bufD = (bf16_t*)(ws + WS_D);

#define DENSE_GEMM(EPI_T, epi_init, Aptr, Bptr, NCOLS) do { DenseSched S{T / BM, (NCOLS) / BM, G, bid, D, (Bptr)}; EPI_T E epi_init; gemm_phase<EPI_T, DenseSched>(lds, (Aptr), D, S, E); } while (0)
#define MOE_PHASES(layer, Xin, Hb) do { \
        unsigned* cnt_ = ctl + CW_CNT + (layer) * NE; \
        ph_route(lds, (Xin), WR + (size_t)(layer) * 2 * 48 * D, b_group + (layer) * NG, b_expert + (layer) * NE, cnt_, ASG, LTOK, LGATE, LRS); \
        GSYNC(); \
        { const int ntm = build_tile_table(lds, cnt_); \
          REPEAT(REP_GEMM, { MoeSched<true> S{ntm, G, bid, D / 2, WGU, LTOK, (const LAS int*)(lds + TAB_OFF), LRS}; EpiG3 E{LRS, (unsigned char*)(Hb)}; gemm_phase<EpiG3, MoeSched<true>, true>(lds, (const bf16_t*)XQ, D / 2, S, E); }) \
          GSYNC(); \
          REPEAT(REP_GEMM, { MoeSched<false> S{ntm, G, bid, F / 2, WD, LTOK, (const LAS int*)(lds + TAB_OFF), LGATE}; EpiG4 E{LGATE, (unsigned char*)bufA}; gemm_phase<EpiG4, MoeSched<false>, true>(lds, (const bf16_t*)(Hb), F / 2, S, E); }) } \
        GSYNC(); } while (0)

    REPEAT(REP_PREP,
    ph_prep_x(x, ln_a, bufB, RS);
    ph_transpose<false>(lds, w_in_a, D, 3 * D, WA_IN, 1, nullptr, 1, 0, 0, 0);
    ph_transpose<false>(lds, w_out_a, D, D, WA_OUT, 0, nullptr, 1, 0, 0, 768);
    ph_transpose<false>(lds, w_in_b, D, 2 * D, WB_IN, 0, ln_b, 1, 0, 0, 1024);
    ph_transpose<false>(lds, w_out_b, D, D, WB_OUT, 0, nullptr, 1, 0, 0, 1536);
    ph_prep_router(ln2, w_group, w_expert, WR);
    ph_prep_wm(w_s, WM);
    ph_prep_experts(lds, 0, w_gate, w_up, w_down, ln2, WGU, WD));
    GSYNC();
    REPEAT(REP_GEMM, DENSE_GEMM(EpiG1, {bufA}, bufB, WA_IN, 3 * D));
    GSYNC();
    REPEAT(REP_THIN, ph_conv(bufA, conv_w, bufC));
    GSYNC();
    REPEAT(REP_GEMM, DENSE_GEMM(EpiRes<true>, ({bufB, bufD, XQ, RS, ln_a}), bufC, WA_OUT, D));
    GSYNC();
    MOE_PHASES(0, bufD, bufB);
    REPEAT(REP_THIN, ph_combine<false>(bufD, (const unsigned char*)bufA, ctl + CW_CNT, ASG, bufC, RS, nullptr, nullptr));
    REPEAT(REP_PREP, ph_prep_experts(lds, 1, w_gate, w_up, w_down, ln2, WGU, WD));
    GSYNC();
    REPEAT(REP_GEMM, DENSE_GEMM(EpiG5, ({RS, b_in_b, bufA, (f32x2*)(ws + WS_LNP)}), bufC, WB_IN, 2 * D));
    GSYNC();
    REPEAT(REP_THIN, ph_mix(lds, bufA, (const f32x2*)(ws + WS_LNP), v_ln_g, v_ln_b, WM, b_s, bufD));
    GSYNC();
    REPEAT(REP_GEMM, DENSE_GEMM(EpiRes<false>, ({bufC, bufB, XQ, nullptr, nullptr}), bufD, WB_OUT, D));
    GSYNC();
    MOE_PHASES(1, bufB, bufC);
    REPEAT(REP_THIN, ph_combine<true>(bufB, (const unsigned char*)bufA, ctl + CW_CNT + NE, ASG, nullptr, nullptr, ln_f, out));
}
}

extern "C" void kernel_launch(void* const* d_in, const int* in_sizes, int n_in, void* d_out, int out_size, void* d_ws, size_t ws_size, hipStream_t stream) {
    if (n_in != 22 || ws_size < WS_END) { fprintf(stderr, "kernel_launch: unexpected n_in %d / ws_size %zu\n", n_in, ws_size); return; }
    static int grid_blocks = 0;
    if (!grid_blocks) {
        int dev = 0, cus = 0, per_cu = 0;
        (void)hipGetDevice(&dev);
        (void)hipDeviceGetAttribute(&cus, hipDeviceAttributeMultiprocessorCount, dev);
        (void)hipFuncSetAttribute((const void*)mega_fwd, hipFuncAttributeMaxDynamicSharedMemorySize, LDS_BYTES);
        (void)hipOccupancyMaxActiveBlocksPerMultiprocessor(&per_cu, (const void*)mega_fwd, NT, LDS_BYTES);
        if (per_cu < 1) fprintf(stderr, "kernel_launch: occupancy query says %d blocks per CU\n", per_cu);
        grid_blocks = cus;
    }
    (void)hipMemsetAsync((unsigned char*)d_ws + WS_CTL, 0, CTL_BYTES, stream);
    Params p{};
    for (int i = 0; i < 22; ++i) p.in[i] = (const float*)d_in[i];
    p.out = (float*)d_out; p.ws = (unsigned char*)d_ws;
    void* args[] = {&p};
    hipError_t e = hipLaunchCooperativeKernel((const void*)mega_fwd, dim3(grid_blocks), dim3(NT), args, LDS_BYTES, stream);
    if (e != hipSuccess) fprintf(stderr, "cooperative launch failed: %s (grid %d)\n", hipGetErrorString(e), grid_blocks);
}
```

```cpp
#include <hip/hip_runtime.h>
#include <hip/hip_cooperative_groups.h>
#include <cstdint>
#include <cstdio>

namespace cg = cooperative_groups;
namespace {
#define LAS __attribute__((address_space(3)))
typedef unsigned short bf16_t;
typedef short bf16x8 __attribute__((ext_vector_type(8)));
typedef float f32x4 __attribute__((ext_vector_type(4)));
typedef float f32x2 __attribute__((ext_vector_type(2)));
typedef unsigned u32x4 __attribute__((ext_vector_type(4)));
typedef unsigned u32x2 __attribute__((ext_vector_type(2)));

constexpr int BATCH = 8, SEQ = 4096, D = 1024, T = BATCH * SEQ;
constexpr int NE = 32, NG = 4, F = 512, CHUNK = 128, NH = 8;
constexpr float EPS = 1e-6f;
constexpr int NT = 512, NWAVES = 8;

constexpr size_t MiB = 1u << 20;
constexpr size_t WS_CTL = 0;
constexpr size_t CTL_BYTES = 65536;
constexpr size_t WS_RS = 1 * MiB;
constexpr size_t WS_ASG = 1 * MiB + 512 * 1024;
constexpr size_t WS_LNS = 2 * MiB;
constexpr size_t WS_WR = 2 * MiB + 512 * 1024;
constexpr size_t WS_WM = 3 * MiB;
constexpr size_t WS_LTOK = 4 * MiB;
constexpr size_t WS_LNP = 112 * MiB;
constexpr size_t WS_LGATE = 8 * MiB;
constexpr size_t WS_LRS = 12 * MiB;
constexpr size_t WS_WA_IN = 16 * MiB;
constexpr size_t WS_WA_OUT = 22 * MiB;
constexpr size_t WS_WB_IN = 24 * MiB;
constexpr size_t WS_WB_OUT = 28 * MiB;
constexpr size_t WS_WGU = 32 * MiB;
constexpr size_t WS_WD = 64 * MiB;
constexpr size_t WS_XQ = 80 * MiB;
constexpr size_t WS_A = 128 * MiB;
constexpr size_t WS_B = 256 * MiB;
constexpr size_t WS_C = 320 * MiB;
constexpr size_t WS_D = 384 * MiB;
constexpr size_t WS_END = 449 * MiB;
constexpr int CW_CNT = 0;
constexpr int CW_BAR = 4096;

constexpr int RING_BYTES = 131072;
constexpr int TAB_OFF = RING_BYTES;
constexpr int TAB_MAX = 320;
constexpr int TABN_OFF = TAB_OFF + TAB_MAX * 16;
constexpr int BARST_OFF = TABN_OFF + 16;
constexpr int TOKTAB_OFF = RING_BYTES + 8192;
constexpr int SCTAB_OFF = TOKTAB_OFF + 2048;
constexpr int LDS_BYTES = 147456;

__device__ __forceinline__ float bf2f(unsigned b) { return __uint_as_float(b << 16); }
__device__ __forceinline__ unsigned f2bf(float f) { unsigned u = __float_as_uint(f); return (u + 0x7fffu + ((u >> 16) & 1u)) >> 16; }
__device__ __forceinline__ unsigned pk2(float lo, float hi) { return f2bf(lo) | (f2bf(hi) << 16); }
__device__ __forceinline__ unsigned cvt_pk_bf16(float lo, float hi) { unsigned r; asm volatile("v_cvt_pk_bf16_f32 %0, %1, %2" : "=v"(r) : "v"(lo), "v"(hi)); return r; }
__device__ __forceinline__ float wave_sum(float v) {
#pragma unroll
    for (int o = 1; o < 64; o <<= 1) v += __shfl_xor(v, o);
    return v;
}
__device__ __forceinline__ void unpack8(const u32x4 v, float (&f)[8]) {
    f[0] = bf2f(v.x & 0xffffu); f[1] = bf2f(v.x >> 16); f[2] = bf2f(v.y & 0xffffu); f[3] = bf2f(v.y >> 16);
    f[4] = bf2f(v.z & 0xffffu); f[5] = bf2f(v.z >> 16); f[6] = bf2f(v.w & 0xffffu); f[7] = bf2f(v.w >> 16);
}
__device__ __forceinline__ u32x4 pack8(const float (&f)[8]) {
    u32x4 o; o.x = pk2(f[0], f[1]); o.y = pk2(f[2], f[3]); o.z = pk2(f[4], f[5]); o.w = pk2(f[6], f[7]); return o;
}
__device__ __forceinline__ float gelu_tanh(float x) {
    const float x2 = x * x;
    const float t = x * (x2 * (-0.044715f * 2.0f * 0.7978845608028654f * 1.4426950408889634f) + (-2.0f * 0.7978845608028654f * 1.4426950408889634f));
    return x * __builtin_amdgcn_rcpf(1.0f + __builtin_amdgcn_exp2f(t));
}
__device__ __forceinline__ float silu(float x) { return x * __builtin_amdgcn_rcpf(1.0f + __builtin_amdgcn_exp2f(x * -1.4426950408889634f)); }
#define LDS_WAIT() asm volatile("s_waitcnt lgkmcnt(0)" ::: "memory")
__device__ __forceinline__ float clamp_fp8(float v) { return __builtin_amdgcn_fmed3f(v, -448.0f, 448.0f); }
__device__ __forceinline__ unsigned pk4_fp8(float a, float b, float c, float d) { unsigned w = 0u; a = clamp_fp8(a); b = clamp_fp8(b); c = clamp_fp8(c); d = clamp_fp8(d); w = __builtin_amdgcn_cvt_pk_fp8_f32(a, b, w, false); w = __builtin_amdgcn_cvt_pk_fp8_f32(c, d, w, true); return w; }
__device__ __forceinline__ void unpack8_fp8(const u32x2 v, float (&f)[8]) {
    const f32x2 a = __builtin_amdgcn_cvt_pk_f32_fp8(v.x, false), b = __builtin_amdgcn_cvt_pk_f32_fp8(v.x, true), c = __builtin_amdgcn_cvt_pk_f32_fp8(v.y, false), d = __builtin_amdgcn_cvt_pk_f32_fp8(v.y, true);
    f[0] = a.x; f[1] = a.y; f[2] = b.x; f[3] = b.y; f[4] = c.x; f[5] = c.y; f[6] = d.x; f[7] = d.y;
}
typedef int i32x8 __attribute__((ext_vector_type(8)));
typedef int i32x4 __attribute__((ext_vector_type(4)));
__device__ __forceinline__ int phase_tid() { int t = (int)threadIdx.x; asm volatile("" : "+v"(t)); return t; }

constexpr int BM = 256, BK = 64, HALF = 128, HTB = HALF * BK * 2, NXCD = 8, WGM = 8;
__device__ __forceinline__ int lds_byte(int r, int c) { const int st = (r >> 4) * 2 + (c >> 5), rr = r & 15, cc = c & 31, ob = rr * 64 + cc * 2; return st * 1024 + (ob ^ (((ob >> 9) & 1) << 5)); }
__device__ __forceinline__ void stage_rc(int b, int& R, int& C) { const int st = b / 1024, sb = b % 1024, swz = sb ^ (((sb >> 9) & 1) << 5); R = (st >> 1) * 16 + swz / 64; C = (st & 1) * 32 + (swz % 64) / 2; }
__device__ __forceinline__ int perm32(int rho) { const int n = rho >> 4, i = rho & 15; return 8 * (i >> 2) + 4 * n + (i & 3); }

struct Unit { int pm, pn, e, row0, nrows, slot0; };
__device__ __forceinline__ bool order_next(int i, int G, int c, int nM, int nN, int& pm, int& pn) {
    const int nwg = nM * nN; const long L = (long)i * G + c; if (L >= nwg) return false;
    int wgid = (int)L; { const int q = nwg / NXCD, r = nwg % NXCD, xcd = wgid % NXCD, off = wgid / NXCD; wgid = (xcd < r ? xcd * (q + 1) : r * (q + 1) + (xcd - r) * q) + off; }
    const int nig = WGM * nN, gid = wgid / nig, fm = gid * WGM, gsz = (nM - fm) < WGM ? (nM - fm) : WGM;
    pm = fm + ((wgid % nig) % gsz); pn = (wgid % nig) / gsz; return true;
}
struct DenseSched {
    static constexpr bool ROWTAB = false, GATHER_IDS = false;
    int nM, nN, G, c, K; const bf16_t* Bt;
    __device__ __forceinline__ bool next(int i, Unit& u) const { u.e = 0; u.row0 = 0; u.nrows = BM; u.slot0 = 0; return order_next(i, G, c, nM, nN, u.pm, u.pn); }
    __device__ __forceinline__ void aoff(const Unit& u, int tid, unsigned (&v)[2][2]) const {
        int R[2], C[2]; stage_rc(tid * 16, R[0], C[0]); stage_rc(tid * 16 + 8192, R[1], C[1]);
#pragma unroll
        for (int h = 0; h < 2; ++h)
#pragma unroll
            for (int i = 0; i < 2; ++i) v[h][i] = (unsigned)((u.pm * BM + h * HALF + R[i]) * K + C[i]) * 2u;
    }
    __device__ __forceinline__ const char* bptr(const Unit& u) const { return (const char*)Bt + (size_t)u.pn * BM * K * 2; }
};
template <bool GATHER> struct MoeSched {
    static constexpr bool ROWTAB = true, GATHER_IDS = GATHER;
    int nM, G, c, K; const unsigned char* W; const int* ltok; const LAS int* tab; const float* rowscal;
    __device__ __forceinline__ bool next(int i, Unit& u) const {
        if (G == 256) { const int rt = i * 64 + 8 * (c & 7) + ((c >> 3) & 7); if (rt >= nM) return false; u.pm = rt; u.pn = c >> 6; }
        else if (!order_next(i, G, c, nM, 4, u.pm, u.pn)) return false;
        u.e = __builtin_amdgcn_readfirstlane(tab[u.pm * 4 + 0]); u.row0 = __builtin_amdgcn_readfirstlane(tab[u.pm * 4 + 1]); u.nrows = __builtin_amdgcn_readfirstlane(tab[u.pm * 4 + 2]); u.slot0 = __builtin_amdgcn_readfirstlane(tab[u.pm * 4 + 3]); return true;
    }
    __device__ __forceinline__ void aoff(const Unit& u, int tid, unsigned (&v)[2][2]) const {
        int R[2], C[2]; stage_rc(tid * 16, R[0], C[0]); stage_rc(tid * 16 + 8192, R[1], C[1]);
#pragma unroll
        for (int h = 0; h < 2; ++h)
#pragma unroll
            for (int i = 0; i < 2; ++i) {
                if (GATHER) { const int rr = min(h * HALF + R[i], u.nrows - 1); const int tok = ltok[(size_t)u.e * T + u.row0 + rr]; v[h][i] = (unsigned)(tok * K + C[i]) * 2u; }
                else v[h][i] = (unsigned)((u.slot0 + h * HALF + R[i]) * K + C[i]) * 2u;
            }
    }
    __device__ __forceinline__ void aoff_lds(const LAS int* toktab, int tid, unsigned (&v)[2][2]) const {
        int R[2], C[2]; stage_rc(tid * 16, R[0], C[0]); stage_rc(tid * 16 + 8192, R[1], C[1]);
#pragma unroll
        for (int h = 0; h < 2; ++h)
#pragma unroll
            for (int i = 0; i < 2; ++i) v[h][i] = (unsigned)(toktab[h * HALF + R[i]] * K + C[i]) * 2u;
    }
    __device__ __forceinline__ const char* bptr(const Unit& u) const { return (const char*)W + ((size_t)u.e * 1024 + (size_t)u.pn * BM) * K * 2; }
};

template <class Epi, class Sched, bool FP8 = false>
__device__ __forceinline__ void gemm_phase(LAS unsigned char* lds, const bf16_t* Abase, const int K, const Sched& S, const Epi& E) {
    const int tid = phase_tid(), wid = __builtin_amdgcn_readfirstlane(tid >> 6), lane = tid & 63, wr = wid >> 2, wc = wid & 3, fr = lane & 15, fq = lane >> 4;
    const int nt = K / BK;
    unsigned voffB[2];
#pragma unroll
    for (int i = 0; i < 2; ++i) { int sR, sC; stage_rc(tid * 16 + i * 8192, sR, sC);
        const int Rb = Epi::WIDE ? (64 * (sR >> 5) + 16 * ((sR & 15) >> 2) + 4 * ((sR >> 4) & 1) + (sR & 3)) : ((sR & ~31) + perm32(sR & 31)); voffB[i] = (unsigned)(Rb * K + sC) * 2u; }
    const size_t kstep = (size_t)(BK * 2);
    const size_t hstepB = (size_t)(Epi::WIDE ? 8 : HALF) * K * 2;
    const unsigned ldsw = (unsigned)wid * 1024u;
    const int aoff = lds_byte(wr * 64 + fr, fq * 8), boff = lds_byte(wc * 32 + fr, fq * 8);
#define PG8_SA(b, h) (((b) * 2 + (h)) * HTB)
#define PG8_SB(b, h) ((4 + (b) * 2 + (h)) * HTB)
#define PG8_STAGE(bufoff, gbase, voff) do { _Pragma("unroll") for (int _i = 0; _i < 2; ++_i) \
        __builtin_amdgcn_global_load_lds((const unsigned*)((const char*)(gbase) + (voff)[_i]), (LAS unsigned*)(lds + (bufoff) + ldsw + _i * 8192), 16, 0, 0); } while (0)
#define PG8_LDA(dst, b, h) do { _Pragma("unroll") for (int m = 0; m < 4; ++m) { \
        const i32x4 lo_ = *(const LAS i32x4*)(lds + PG8_SA(b, h) + aoff + m * 2048), hi_ = *(const LAS i32x4*)(lds + PG8_SA(b, h) + aoff + m * 2048 + 1024); \
        if constexpr (FP8) dst##8[m] = __builtin_shufflevector(lo_, hi_, 0, 1, 2, 3, 4, 5, 6, 7); else { dst[m][0] = __builtin_bit_cast(bf16x8, lo_); dst[m][1] = __builtin_bit_cast(bf16x8, hi_); } } } while (0)
#define PG8_LDB(dst, b, h) do { _Pragma("unroll") for (int n = 0; n < 2; ++n) { \
        const i32x4 lo_ = *(const LAS i32x4*)(lds + PG8_SB(b, h) + boff + n * 2048), hi_ = *(const LAS i32x4*)(lds + PG8_SB(b, h) + boff + n * 2048 + 1024); \
        if constexpr (FP8) dst##8[n] = __builtin_shufflevector(lo_, hi_, 0, 1, 2, 3, 4, 5, 6, 7); else { dst[n][0] = __builtin_bit_cast(bf16x8, lo_); dst[n][1] = __builtin_bit_cast(bf16x8, hi_); } } } while (0)
#define PG8_MMA(ai, bj, At, Bt) do { __builtin_amdgcn_s_setprio(1); \
        if constexpr (FP8) { \
            asm volatile("s_nop 1\n\t" \
                "v_mfma_f32_16x16x128_f8f6f4 %0, %8, %10, %0\n\t" "v_mfma_f32_16x16x128_f8f6f4 %1, %9, %10, %1\n\t" \
                "v_mfma_f32_16x16x128_f8f6f4 %2, %8, %11, %2\n\t" "v_mfma_f32_16x16x128_f8f6f4 %3, %9, %11, %3\n\t" \
                "v_mfma_f32_16x16x128_f8f6f4 %4, %8, %12, %4\n\t" "v_mfma_f32_16x16x128_f8f6f4 %5, %9, %12, %5\n\t" \
                "v_mfma_f32_16x16x128_f8f6f4 %6, %8, %13, %6\n\t" "v_mfma_f32_16x16x128_f8f6f4 %7, %9, %13, %7" \
                : "+v"(acc[ai][bj][0][0]), "+v"(acc[ai][bj][0][1]), "+v"(acc[ai][bj][1][0]), "+v"(acc[ai][bj][1][1]), \
                  "+v"(acc[ai][bj][2][0]), "+v"(acc[ai][bj][2][1]), "+v"(acc[ai][bj][3][0]), "+v"(acc[ai][bj][3][1]) \
                : "v"(Bt##8[0]), "v"(Bt##8[1]), "v"(At##8[0]), "v"(At##8[1]), "v"(At##8[2]), "v"(At##8[3])); \
        } else { _Pragma("unroll") for (int m = 0; m < 4; ++m) _Pragma("unroll") for (int n = 0; n < 2; ++n) _Pragma("unroll") for (int k = 0; k < 2; ++k) \
            acc[ai][bj][m][n] = __builtin_amdgcn_mfma_f32_16x16x32_bf16(Bt[n][k], At[m][k], acc[ai][bj][m][n], 0, 0, 0); } \
        __builtin_amdgcn_s_setprio(0); } while (0)
#define PG8_WAIT_V(n) asm volatile("s_waitcnt vmcnt(" #n ")" ::: "memory")
#define PG8_WAIT_L(n) asm volatile("s_waitcnt lgkmcnt(" #n ")" ::: "memory")
#define PG8_BAR __builtin_amdgcn_s_barrier()
#define PG8_SCHED __builtin_amdgcn_sched_barrier(0)
    Unit cur, nxt; int ui = 0;
    if (!S.next(0, cur)) return;
    f32x4 acc[2][2][4][2];
#pragma unroll
    for (int a = 0; a < 2; ++a)
#pragma unroll
        for (int b = 0; b < 2; ++b)
#pragma unroll
            for (int m = 0; m < 4; ++m)
#pragma unroll
                for (int n = 0; n < 2; ++n) acc[a][b][m][n] = (f32x4){0.f, 0.f, 0.f, 0.f};
    bf16x8 At[4][2], B0[2][2], B1[2][2]; i32x8 At8[4], B08[2], B18[2];
    unsigned vA[2][2], vS[2][2];
    S.aoff(cur, tid, vA);
#pragma unroll
    for (int h = 0; h < 2; ++h)
#pragma unroll
        for (int i = 0; i < 2; ++i) vS[h][i] = vA[h][i];
    const char* const A0 = (const char*)Abase;
    const char* cB = S.bptr(cur);
    PG8_STAGE(PG8_SB(0, 0), cB, voffB); PG8_STAGE(PG8_SB(0, 1), cB + hstepB, voffB); PG8_STAGE(PG8_SA(0, 0), A0, vA[0]); PG8_STAGE(PG8_SA(0, 1), A0, vA[1]);
    if (wr == 1) PG8_BAR;
    PG8_WAIT_V(2); PG8_BAR;
    PG8_STAGE(PG8_SB(1, 0), cB + kstep, voffB); PG8_STAGE(PG8_SA(1, 0), A0 + kstep, vA[0]); PG8_STAGE(PG8_SB(1, 1), cB + hstepB + kstep, voffB);
    PG8_WAIT_V(6); PG8_BAR;
    for (;;) {
        const bool has_next = S.next(ui + 1, nxt);
        const bool full = cur.nrows > HALF;
        if constexpr (Sched::ROWTAB) {
            if (wid < 4) { const int row = wid * 64 + lane;
                __builtin_amdgcn_global_load_lds((const unsigned*)(S.rowscal + (size_t)cur.e * T + cur.row0 + min(row, cur.nrows - 1)), (LAS unsigned*)(lds + SCTAB_OFF + (ui & 1) * 1024 + wid * 256), 4, 0, 0);
                if (Sched::GATHER_IDS && has_next) __builtin_amdgcn_global_load_lds((const unsigned*)(S.ltok + (size_t)nxt.e * T + nxt.row0 + min(row, nxt.nrows - 1)), (LAS unsigned*)(lds + TOKTAB_OFF + (ui & 1) * 1024 + wid * 256), 4, 0, 0); }
        }
        const char* nB = has_next ? S.bptr(nxt) : cB;
#pragma unroll 1
        for (int t = 0; t < nt; t += 2) {
            const bool last = (t == nt - 2);
            if (last && has_next) { if constexpr (Sched::GATHER_IDS) S.aoff_lds((const LAS int*)(lds + TOKTAB_OFF + (ui & 1) * 1024), tid, vS); else S.aoff(nxt, tid, vS); }
            const char* a1 = A0 + (size_t)(t + 1) * kstep;
            const char* a2 = last ? A0 : A0 + (size_t)(t + 2) * kstep; const char* b2 = last ? nB : cB + (size_t)(t + 2) * kstep;
            const char* a3 = a2 + kstep; const char* b3 = b2 + kstep;
            PG8_LDB(B0, 0, 0); PG8_LDB(B1, 0, 1); PG8_SCHED; PG8_LDA(At, 0, 0); PG8_STAGE(PG8_SA(1, 1), a1, vA[1]);
            PG8_WAIT_V(8); PG8_WAIT_L(0); PG8_BAR; PG8_MMA(0, 0, At, B0); PG8_MMA(0, 1, At, B1); PG8_BAR; PG8_SCHED;
            PG8_LDA(At, 0, 1); PG8_STAGE(PG8_SB(0, 0), b2, voffB); PG8_STAGE(PG8_SB(0, 1), b2 + hstepB, voffB); PG8_STAGE(PG8_SA(0, 0), a2, vS[0]);
            PG8_WAIT_V(8); PG8_WAIT_L(0); PG8_BAR; if (full) { PG8_MMA(1, 0, At, B0); PG8_MMA(1, 1, At, B1); } PG8_BAR; PG8_SCHED;
            PG8_LDB(B0, 1, 0); PG8_LDB(B1, 1, 1); PG8_SCHED; PG8_LDA(At, 1, 0); PG8_STAGE(PG8_SA(0, 1), a2, vS[1]);
            PG8_WAIT_V(8); PG8_WAIT_L(0); PG8_BAR; PG8_MMA(0, 0, At, B0); PG8_MMA(0, 1, At, B1); PG8_BAR; PG8_SCHED;
            PG8_LDA(At, 1, 1); PG8_STAGE(PG8_SB(1, 0), b3, voffB); PG8_STAGE(PG8_SB(1, 1), b3 + hstepB, voffB); PG8_STAGE(PG8_SA(1, 0), a3, vS[0]);
            PG8_WAIT_V(8); PG8_WAIT_L(0); PG8_BAR; if (full) { PG8_MMA(1, 0, At, B0); PG8_MMA(1, 1, At, B1); } PG8_BAR; PG8_SCHED;
        }
        if (wr == 0) PG8_BAR;
        if constexpr (FP8) asm volatile("s_nop 7\n\ts_nop 7\n\ts_nop 7" ::: "memory");
        { const int t2 = phase_tid(), l2 = t2 & 63; E(acc, cur, wr, wc, l2 & 15, l2 >> 4, (const LAS float*)(lds + SCTAB_OFF + (ui & 1) * 1024)); }
        if (!has_next) break;
#pragma unroll
        for (int a = 0; a < 2; ++a)
#pragma unroll
            for (int b = 0; b < 2; ++b)
#pragma unroll
                for (int m = 0; m < 4; ++m)
#pragma unroll
                    for (int n = 0; n < 2; ++n) acc[a][b][m][n] = (f32x4){0.f, 0.f, 0.f, 0.f};
        cur = nxt; cB = nB; ++ui;
#pragma unroll
        for (int h = 0; h < 2; ++h)
#pragma unroll
            for (int i = 0; i < 2; ++i) vA[h][i] = vS[h][i];
        if (wr == 1) PG8_BAR;
    }
    PG8_WAIT_V(0);
    PG8_BAR;
#undef PG8_SA
#undef PG8_SB
#undef PG8_STAGE
#undef PG8_LDA
#undef PG8_LDB
#undef PG8_MMA
#undef PG8_WAIT_V
#undef PG8_WAIT_L
#undef PG8_BAR
#undef PG8_SCHED
}

__device__ __forceinline__ u32x4 pack_rows(const f32x4 v0, const f32x4 v1) { u32x4 w; w.x = cvt_pk_bf16(v0[0], v0[1]); w.y = cvt_pk_bf16(v0[2], v0[3]); w.z = cvt_pk_bf16(v1[0], v1[1]); w.w = cvt_pk_bf16(v1[2], v1[3]); return w; }
struct EpiG1 {
    static constexpr bool WIDE = false;
    bf16_t* ZB;
    __device__ __forceinline__ void operator()(const f32x4 (&acc)[2][2][4][2], const Unit& u, int wr, int wc, int fr, int fq, const LAS float* sct) const {
        const int row0 = u.pm * BM + wr * 64 + fr;
#pragma unroll
        for (int ai = 0; ai < 2; ++ai)
#pragma unroll
            for (int m = 0; m < 4; ++m) { bf16_t* rowp = ZB + (size_t)(row0 + ai * HALF + m * 16) * D;
                if (u.pn < 8) { *(u32x4*)(rowp + u.pn * 128 + wc * 32 + 8 * fq) = pack_rows(acc[ai][0][m][0] * acc[ai][1][m][0], acc[ai][0][m][1] * acc[ai][1][m][1]); }
                else {
#pragma unroll
                    for (int bj = 0; bj < 2; ++bj) *(u32x4*)(rowp + (size_t)T * D + (u.pn - 8) * BM + bj * HALF + wc * 32 + 8 * fq) = pack_rows(acc[ai][bj][m][0], acc[ai][bj][m][1]); } }
    }
};
template <bool SCALED> struct EpiRes {
    static constexpr bool WIDE = true;
    const bf16_t* res; bf16_t* X; unsigned char* XQ; const float* rinv; const float* gcol;
    __device__ __forceinline__ void operator()(const f32x4 (&acc)[2][2][4][2], const Unit& u, int wr, int wc, int fr, int fq, const LAS float* sct) const {
        const int row0 = u.pm * BM + wr * 64 + fr, col0 = u.pn * BM + wc * 64 + 16 * fq;
        float gi[2][8];
        if (SCALED) {
#pragma unroll
            for (int bj = 0; bj < 2; ++bj) { const f32x4 g0 = *(const f32x4*)(gcol + col0 + 8 * bj), g1 = *(const f32x4*)(gcol + col0 + 8 * bj + 4);
                gi[bj][0] = __builtin_amdgcn_rcpf(g0.x); gi[bj][1] = __builtin_amdgcn_rcpf(g0.y); gi[bj][2] = __builtin_amdgcn_rcpf(g0.z); gi[bj][3] = __builtin_amdgcn_rcpf(g0.w);
                gi[bj][4] = __builtin_amdgcn_rcpf(g1.x); gi[bj][5] = __builtin_amdgcn_rcpf(g1.y); gi[bj][6] = __builtin_amdgcn_rcpf(g1.z); gi[bj][7] = __builtin_amdgcn_rcpf(g1.w); } }
#pragma unroll
        for (int ai = 0; ai < 2; ++ai) {
            u32x4 rb[4][2]; float ri[4];
#pragma unroll
            for (int m = 0; m < 4; ++m) { const size_t off = (size_t)(row0 + ai * HALF + m * 16) * D + col0; ri[m] = SCALED ? rinv[row0 + ai * HALF + m * 16] : 1.0f;
#pragma unroll
                for (int bj = 0; bj < 2; ++bj) rb[m][bj] = __builtin_nontemporal_load((const u32x4*)(res + off + 8 * bj)); }
#pragma unroll
            for (int m = 0; m < 4; ++m) { const size_t off = (size_t)(row0 + ai * HALF + m * 16) * D + col0; u32x4 q;
#pragma unroll
                for (int bj = 0; bj < 2; ++bj) { float f[8]; unpack8(rb[m][bj], f);
                    if (SCALED) {
#pragma unroll
                        for (int e = 0; e < 8; ++e) f[e] = f[e] * ri[m] * gi[bj][e]; }
                    const f32x4 o0 = (f32x4){f[0], f[1], f[2], f[3]} + acc[ai][bj][m][0], o1 = (f32x4){f[4], f[5], f[6], f[7]} + acc[ai][bj][m][1];
                    *(u32x4*)(X + off + 8 * bj) = pack_rows(o0, o1);
                    q[2 * bj] = pk4_fp8(2.f * o0[0], 2.f * o0[1], 2.f * o0[2], 2.f * o0[3]); q[2 * bj + 1] = pk4_fp8(2.f * o1[0], 2.f * o1[1], 2.f * o1[2], 2.f * o1[3]); }
                *(u32x4*)(XQ + off) = q; }
        }
    }
};
struct EpiG3 {
    static constexpr bool WIDE = false;
    const float* lrs; unsigned char* H;
    __device__ __forceinline__ void operator()(const f32x4 (&acc)[2][2][4][2], const Unit& u, int wr, int wc, int fr, int fq, const LAS float* sct) const {
        float scv[2][4];
#pragma unroll
        for (int ai = 0; ai < 2; ++ai)
#pragma unroll
            for (int m = 0; m < 4; ++m) { const int r = ai * HALF + wr * 64 + m * 16 + fr; scv[ai][m] = sct[r]; }
#pragma unroll
        for (int ai = 0; ai < 2; ++ai)
#pragma unroll
            for (int m = 0; m < 4; ++m) { const int r = ai * HALF + wr * 64 + m * 16 + fr;
                if (r < u.nrows) { const float sc = scv[ai][m] * (1.0f / 64.0f); f32x4 o[2];
#pragma unroll
                    for (int n = 0; n < 2; ++n)
#pragma unroll
                        for (int j = 0; j < 4; ++j) o[n][j] = 4.0f * silu(sc * acc[ai][0][m][n][j]) * (sc * acc[ai][1][m][n][j]);
                    u32x2 q; q.x = pk4_fp8(o[0][0], o[0][1], o[0][2], o[0][3]); q.y = pk4_fp8(o[1][0], o[1][1], o[1][2], o[1][3]);
                    *(u32x2*)(H + (size_t)(u.slot0 + r) * F + u.pn * 128 + wc * 32 + 8 * fq) = q; } }
    }
};
struct EpiG4 {
    static constexpr bool WIDE = true;
    const float* lgate; unsigned char* YS;
    __device__ __forceinline__ void operator()(const f32x4 (&acc)[2][2][4][2], const Unit& u, int wr, int wc, int fr, int fq, const LAS float* sct) const {
        float gv[2][4];
#pragma unroll
        for (int ai = 0; ai < 2; ++ai)
#pragma unroll
            for (int m = 0; m < 4; ++m) { const int r = ai * HALF + wr * 64 + m * 16 + fr; gv[ai][m] = sct[r]; }
#pragma unroll
        for (int ai = 0; ai < 2; ++ai)
#pragma unroll
            for (int m = 0; m < 4; ++m) { const int r = ai * HALF + wr * 64 + m * 16 + fr;
                if (r < u.nrows) { const float g = gv[ai][m] * (16.0f / 128.0f);
                    u32x4 q;
#pragma unroll
                    for (int bj = 0; bj < 2; ++bj) { const f32x4 o0 = acc[ai][bj][m][0] * g, o1 = acc[ai][bj][m][1] * g; q[2 * bj] = pk4_fp8(o0[0], o0[1], o0[2], o0[3]); q[2 * bj + 1] = pk4_fp8(o1[0], o1[1], o1[2], o1[3]); }
                    *(u32x4*)(YS + (size_t)(u.slot0 + r) * D + u.pn * BM + wc * 64 + 16 * fq) = q; } }
    }
};
struct EpiG5 {
    static constexpr bool WIDE = true;
    const float* rs; const float* bias; bf16_t* UV; f32x2* lnp;
    __device__ __forceinline__ void operator()(const f32x4 (&acc)[2][2][4][2], const Unit& u, int wr, int wc, int fr, int fq, const LAS float* sct) const {
        const int row0 = u.pm * BM + wr * 64 + fr, col0 = u.pn * BM + wc * 64 + 16 * fq;
        f32x4 bv[2][2];
#pragma unroll
        for (int bj = 0; bj < 2; ++bj)
#pragma unroll
            for (int n = 0; n < 2; ++n) bv[bj][n] = *(const f32x4*)(bias + col0 + 8 * bj + 4 * n);
        float scv[2][4];
#pragma unroll
        for (int ai = 0; ai < 2; ++ai)
#pragma unroll
            for (int m = 0; m < 4; ++m) scv[ai][m] = rs[row0 + ai * HALF + m * 16];
#pragma unroll
        for (int ai = 0; ai < 2; ++ai)
#pragma unroll
            for (int m = 0; m < 4; ++m) { const int row = row0 + ai * HALF + m * 16; const float sc = scv[ai][m];
                float ps = 0.f, pq = 0.f;
#pragma unroll
                for (int bj = 0; bj < 2; ++bj) { f32x4 o[2];
#pragma unroll
                    for (int n = 0; n < 2; ++n)
#pragma unroll
                        for (int j = 0; j < 4; ++j) { o[n][j] = gelu_tanh(sc * acc[ai][bj][m][n][j] + bv[bj][n][j]); ps += o[n][j]; pq += o[n][j] * o[n][j]; }
                    *(u32x4*)(UV + (u.pn >= 4 ? (size_t)T * D : (size_t)0) + (size_t)row * D + (col0 & (D - 1)) + 8 * bj) = pack_rows(o[0], o[1]); }
                if (u.pn >= 4) { ps += __shfl_xor(ps, 16); ps += __shfl_xor(ps, 32); pq += __shfl_xor(pq, 16); pq += __shfl_xor(pq, 32);
                    if (fq == 0) lnp[(size_t)row * 16 + (u.pn - 4) * 4 + wc] = (f32x2){ps, pq}; } }
    }
};

__device__ __forceinline__ void ph_prep_x(const float* __restrict__ x, const float* __restrict__ g, bf16_t* __restrict__ xn, float* __restrict__ rinv) {
    const int tid = phase_tid(), lane = tid & 63, gw = ((int)blockIdx.x * NT + tid) >> 6, ngw = ((int)gridDim.x * NT) >> 6;
    f32x4 gv[4];
#pragma unroll
    for (int j = 0; j < 4; ++j) gv[j] = ((const f32x4*)g)[lane + 64 * j];
    for (int row = gw; row < T; row += 2 * ngw) {
        const int row2 = row + ngw;
        const bool has2 = row2 < T;
        const f32x4* xr = (const f32x4*)(x + (size_t)row * D) + lane; const f32x4* xr2 = (const f32x4*)(x + (size_t)(has2 ? row2 : row) * D) + lane;
        f32x4 v[4], w[4]; float s = 0.f, s2 = 0.f;
#pragma unroll
        for (int j = 0; j < 4; ++j) { v[j] = __builtin_nontemporal_load(xr + 64 * j); w[j] = __builtin_nontemporal_load(xr2 + 64 * j); }
#pragma unroll
        for (int j = 0; j < 4; ++j) { s += (v[j].x * v[j].x + v[j].y * v[j].y) + (v[j].z * v[j].z + v[j].w * v[j].w); s2 += (w[j].x * w[j].x + w[j].y * w[j].y) + (w[j].z * w[j].z + w[j].w * w[j].w); }
        const float r = rsqrtf(wave_sum(s) * (1.0f / D) + EPS), r2 = rsqrtf(wave_sum(s2) * (1.0f / D) + EPS);
        if (lane == 0) { rinv[row] = 1.0f / r; if (has2) rinv[row2] = 1.0f / r2; }
        u32x2* o = (u32x2*)(xn + (size_t)row * D) + lane; u32x2* o2 = (u32x2*)(xn + (size_t)row2 * D) + lane;
#pragma unroll
        for (int j = 0; j < 4; ++j) { u32x2 q; q.x = pk2(v[j].x * r * gv[j].x, v[j].y * r * gv[j].y); q.y = pk2(v[j].z * r * gv[j].z, v[j].w * r * gv[j].w); o[64 * j] = q; }
        if (has2) {
#pragma unroll
            for (int j = 0; j < 4; ++j) { u32x2 q; q.x = pk2(w[j].x * r2 * gv[j].x, w[j].y * r2 * gv[j].y); q.y = pk2(w[j].z * r2 * gv[j].z, w[j].w * r2 * gv[j].w); o2[64 * j] = q; } }
    }
}
__device__ __forceinline__ int map_row(int mapkind, int n) {
    if (mapkind == 0) return n;
    if (mapkind == 1) { if (n < D) return 2 * D + n; const int ch = (n - D) & (D - 1), second = (n >= 2 * D); return 256 * (ch >> 7) + 128 * second + (ch & 127); }
    return 256 * (n >> 7) + (mapkind == 3 ? 128 : 0) + (n & 127);
}
struct TrItem { const float* src; int k0, n0; };
__device__ __forceinline__ void tr_load(const float* __restrict__ W, int N, int item, int lane, f32x4 (&v)[16]) {
    const int nblk = N / 64, kb = item / nblk, nb = item % nblk, k0 = 64 * kb, n0 = 64 * nb, kq = lane >> 4, nn = 4 * (lane & 15);
#pragma unroll
    for (int i = 0; i < 16; ++i) v[i] = __builtin_nontemporal_load((const f32x4*)(W + (size_t)(k0 + 4 * i + kq) * N + n0 + nn));
}
template <bool FP8OUT> __device__ __forceinline__ void tr_process(const f32x4 (&v)[16], int K, int N, void* __restrict__ WTv, int mapkind, const float* __restrict__ kscale, LAS float* scr, int item, int lane) {
    const int nblk = N / 64, kb = item / nblk, nb = item % nblk, k0 = 64 * kb, n0 = 64 * nb, kq = lane >> 4, nn = 4 * (lane & 15);
#pragma unroll
    for (int i = 0; i < 16; ++i) { const int kk = 4 * i + kq; const float sc = (kscale ? kscale[k0 + kk] : 1.0f) * (FP8OUT ? 32.0f : 1.0f); LAS float* d = scr + kk * 65 + nn;
        d[0] = v[i].x * sc; d[1] = v[i].y * sc; d[2] = v[i].z * sc; d[3] = v[i].w * sc; }
    LDS_WAIT();
    if constexpr (!FP8OUT) {
        bf16_t* WT = (bf16_t*)WTv; const int c = lane & 7;
#pragma unroll
        for (int j = 0; j < 8; ++j) { const int n = (lane >> 3) + 8 * j; const LAS float* sp = scr + (8 * c) * 65 + n;
            u32x4 o; o.x = pk2(sp[0 * 65], sp[1 * 65]); o.y = pk2(sp[2 * 65], sp[3 * 65]); o.z = pk2(sp[4 * 65], sp[5 * 65]); o.w = pk2(sp[6 * 65], sp[7 * 65]);
            *(u32x4*)(WT + (size_t)map_row(mapkind, n0 + n) * K + k0 + 8 * c) = o; }
    } else {
        unsigned char* WT = (unsigned char*)WTv; const int c = lane & 3;
#pragma unroll
        for (int j = 0; j < 4; ++j) { const int n = (lane >> 2) + 16 * j; const LAS float* sp = scr + (16 * c) * 65 + n;
            u32x4 o; o.x = pk4_fp8(sp[0 * 65], sp[1 * 65], sp[2 * 65], sp[3 * 65]); o.y = pk4_fp8(sp[4 * 65], sp[5 * 65], sp[6 * 65], sp[7 * 65]);
            o.z = pk4_fp8(sp[8 * 65], sp[9 * 65], sp[10 * 65], sp[11 * 65]); o.w = pk4_fp8(sp[12 * 65], sp[13 * 65], sp[14 * 65], sp[15 * 65]);
            *(u32x4*)(WT + (size_t)map_row(mapkind, n0 + n) * K + k0 + 16 * c) = o; }
    }
    LDS_WAIT();
}
template <bool FP8OUT> __device__ __forceinline__ void ph_transpose(LAS unsigned char* lds, const float* W, int K, int N, void* WT, int mapkind, const float* kscale, int nbatch, size_t sstride, size_t dstride, int shift = 0) {
    const int tid = phase_tid(), lane = tid & 63, wave = tid >> 6, ngw = (int)gridDim.x * NWAVES, gw = ((int)blockIdx.x * NWAVES + wave + ngw - (shift % ngw)) % ngw;
    LAS float* scr = (LAS float*)(lds + wave * 16640);
    const int per = (K / 64) * (N / 64), nitems = per * nbatch;
    f32x4 v[16], vn[16];
    int it = gw;
    if (it < nitems) tr_load(W + (size_t)(it / per) * sstride, N, it % per, lane, v);
    while (it < nitems) {
        const int nx = it + ngw;
        if (nx < nitems) tr_load(W + (size_t)(nx / per) * sstride, N, nx % per, lane, vn);
        tr_process<FP8OUT>(v, K, N, (unsigned char*)WT + (size_t)(it / per) * dstride * (FP8OUT ? 1 : 2), mapkind, kscale, scr, it % per, lane);
#pragma unroll
        for (int i = 0; i < 16; ++i) v[i] = vn[i];
        it = nx;
    }
}
__device__ __forceinline__ void ph_prep_experts(LAS unsigned char* lds, int layer, const float* w_gate, const float* w_up, const float* w_down, const float* ln2, unsigned char* WGU, unsigned char* WD) {
    ph_transpose<true>(lds, w_gate + (size_t)layer * NE * D * F, D, F, WGU, 2, ln2 + layer * D, NE, (size_t)D * F, (size_t)1024 * D);
    ph_transpose<true>(lds, w_up + (size_t)layer * NE * D * F, D, F, WGU, 3, ln2 + layer * D, NE, (size_t)D * F, (size_t)1024 * D);
    ph_transpose<true>(lds, w_down + (size_t)layer * NE * F * D, F, D, WD, 0, nullptr, NE, (size_t)F * D, (size_t)D * F);
}
__device__ __forceinline__ void ph_prep_router(const float* __restrict__ ln2, const float* __restrict__ wg, const float* __restrict__ we, bf16_t* __restrict__ wr) {
    for (int i = (int)blockIdx.x * NT + phase_tid(); i < 2 * 48 * D; i += (int)gridDim.x * NT) {
        const int l = i / (48 * D), j = (i / D) % 48, k = i % D;
        float w = 0.f;
        if (j < 4) w = wg[((size_t)l * D + k) * NG + j]; else if (j < 36) w = we[((size_t)l * D + k) * NE + (j - 4)];
        w *= ln2[l * D + k];
        const unsigned hi = f2bf(w); const unsigned lo = f2bf(w - bf2f(hi));
        wr[((size_t)l * 2 + 0) * 48 * D + (size_t)j * D + k] = (bf16_t)hi; wr[((size_t)l * 2 + 1) * 48 * D + (size_t)j * D + k] = (bf16_t)lo;
    }
}
__device__ __forceinline__ void ph_prep_wm(const float* __restrict__ ws, bf16_t* __restrict__ wm) {
    for (int i = (int)blockIdx.x * NT + phase_tid(); i < NH * CHUNK * CHUNK; i += (int)gridDim.x * NT) { const int t = (i / CHUNK) % CHUNK, s = i % CHUNK; wm[i] = (bf16_t)f2bf(t >= s ? ws[i] : 0.f); }
}
__device__ __forceinline__ void ph_conv(const bf16_t* __restrict__ ZB, const float* __restrict__ cw, bf16_t* __restrict__ Y) {
    constexpr int RB = 8;
    const int nitems = (T / RB) * (D / 8);
    for (int it = (int)blockIdx.x * NT + phase_tid(); it < nitems; it += (int)gridDim.x * NT) {
        const int cg8 = it & 127, rb = it >> 7, r0 = rb * RB, ch = cg8 * 8, t0 = r0 & (SEQ - 1);
        float w[3][8];
#pragma unroll
        for (int k = 0; k < 3; ++k)
#pragma unroll
            for (int i = 0; i < 8; ++i) w[k][i] = cw[k * D + ch + i];
        float zm2[8], zm1[8];
        if (t0 >= 2) { unpack8(__builtin_nontemporal_load((const u32x4*)(ZB + (size_t)(r0 - 2) * D + ch)), zm2); unpack8(__builtin_nontemporal_load((const u32x4*)(ZB + (size_t)(r0 - 1) * D + ch)), zm1); }
        else {
#pragma unroll
            for (int i = 0; i < 8; ++i) { zm2[i] = 0.f; zm1[i] = 0.f; } }
#pragma unroll
        for (int r = 0; r < RB; ++r) {
            float z[8], b[8], o[8];
            unpack8(__builtin_nontemporal_load((const u32x4*)(ZB + (size_t)(r0 + r) * D + ch)), z); unpack8(__builtin_nontemporal_load((const u32x4*)(ZB + (size_t)T * D + (size_t)(r0 + r) * D + ch)), b);
#pragma unroll
            for (int i = 0; i < 8; ++i) { o[i] = b[i] * (w[0][i] * zm2[i] + w[1][i] * zm1[i] + w[2][i] * z[i]); zm2[i] = zm1[i]; zm1[i] = z[i]; }
            *(u32x4*)(Y + (size_t)(r0 + r) * D + ch) = pack8(o);
        }
    }
}
__device__ __forceinline__ void ph_route(LAS unsigned char* lds, const bf16_t* __restrict__ X, const bf16_t* __restrict__ wrh, const float* __restrict__ bg, const float* __restrict__ be,
                                         unsigned* __restrict__ cnt, unsigned* __restrict__ asg, int* __restrict__ ltok, float* __restrict__ lgate, float* __restrict__ lrs) {
    const int tid = phase_tid(), wave = tid >> 6, lane = tid & 63, fr = lane & 15, fq = lane >> 4;
    LAS float* lgs = (LAS float*)(lds + wave * 4096);
    LAS int* s_e = (LAS int*)(lds + 32768); LAS float* s_g = (LAS float*)(lds + 32768 + 1024); LAS float* s_r = (LAS float*)(lds + 32768 + 2048);
    LAS unsigned* s_cnt = (LAS unsigned*)(lds + 32768 + 3072); LAS unsigned* s_base = (LAS unsigned*)(lds + 32768 + 3200); LAS unsigned* s_rank = (LAS unsigned*)(lds + 32768 + 3328);
    const bf16_t* wrl = wrh + 48 * D;
    for (int tb = (int)blockIdx.x * 128; tb < T; tb += (int)gridDim.x * 128) {
        if (tid < NE) s_cnt[tid] = 0u;
        const int tok0 = tb + wave * 16;
        f32x4 acc[3]; float ss = 0.f;
#pragma unroll
        for (int n = 0; n < 3; ++n) acc[n] = (f32x4){0.f, 0.f, 0.f, 0.f};
        constexpr int WCH_PITCH = 272, WCH_BYTES = 2 * 48 * WCH_PITCH;
        LAS unsigned char* wbuf = lds + 49152;
        u32x4 wreg[3], araw[4];
#pragma unroll
        for (int p = 0; p < 3; ++p) { const int pc = tid + 512 * p, hl = pc / 768, row = (pc % 768) >> 4, kc = pc & 15; wreg[p] = *(const u32x4*)(wrh + (size_t)hl * 48 * D + (size_t)row * D + kc * 8); }
#pragma unroll
        for (int q = 0; q < 4; ++q) araw[q] = *(const u32x4*)(X + (size_t)(tok0 + fr) * D + q * 32 + fq * 8);
#pragma unroll 1
        for (int kb = 0; kb < D / 128; ++kb) {
            LAS unsigned char* wb = wbuf + (kb & 1) * WCH_BYTES;
#pragma unroll
            for (int p = 0; p < 3; ++p) { const int pc = tid + 512 * p, hl = pc / 768, row = (pc % 768) >> 4, kc = pc & 15; *(LAS u32x4*)(wb + (hl * 48 + row) * WCH_PITCH + kc * 16) = wreg[p]; }
            u32x4 acur[4];
#pragma unroll
            for (int q = 0; q < 4; ++q) acur[q] = araw[q];
            __syncthreads();
            if (kb + 1 < D / 128) {
#pragma unroll
                for (int p = 0; p < 3; ++p) { const int pc = tid + 512 * p, hl = pc / 768, row = (pc % 768) >> 4, kc = pc & 15; wreg[p] = *(const u32x4*)(wrh + (size_t)hl * 48 * D + (size_t)row * D + (kb + 1) * 128 + kc * 8); }
#pragma unroll
                for (int q = 0; q < 4; ++q) araw[q] = *(const u32x4*)(X + (size_t)(tok0 + fr) * D + ((kb + 1) * 4 + q) * 32 + fq * 8);
            }
#pragma unroll
            for (int q = 0; q < 4; ++q) {
                float af[8]; unpack8(acur[q], af);
#pragma unroll
                for (int e = 0; e < 8; ++e) ss += af[e] * af[e];
                const bf16x8 a = __builtin_bit_cast(bf16x8, acur[q]);
#pragma unroll
                for (int n = 0; n < 3; ++n) {
                    const bf16x8 bh = *(const LAS bf16x8*)(wb + (n * 16 + fr) * WCH_PITCH + (q * 32 + fq * 8) * 2);
                    const bf16x8 bl = *(const LAS bf16x8*)(wb + (48 + n * 16 + fr) * WCH_PITCH + (q * 32 + fq * 8) * 2);
                    acc[n] = __builtin_amdgcn_mfma_f32_16x16x32_bf16(a, bh, acc[n], 0, 0, 0); acc[n] = __builtin_amdgcn_mfma_f32_16x16x32_bf16(a, bl, acc[n], 0, 0, 0); }
            }
        }
        __syncthreads();
        ss += __shfl_xor(ss, 16); ss += __shfl_xor(ss, 32);
#pragma unroll
        for (int n = 0; n < 3; ++n)
#pragma unroll
            for (int j = 0; j < 4; ++j) lgs[(fq * 4 + j) * 49 + n * 16 + fr] = acc[n][j];
        if (fq == 0) lgs[16 * 49 + fr] = rsqrtf(ss * (1.0f / D) + EPS);
        LDS_WAIT();
        if (lane < 16) {
            const float r = lgs[16 * 49 + lane]; const LAS float* L = lgs + lane * 49;
            float lg[36];
#pragma unroll
            for (int j = 0; j < 36; ++j) lg[j] = L[j] * r + (j < 4 ? bg[j] : be[j - 4]);
            int gi = 0; float gm = lg[0];
#pragma unroll
            for (int j = 1; j < 4; ++j) if (lg[j] > gm) { gm = lg[j]; gi = j; }
            float gs = 0.f;
#pragma unroll
            for (int j = 0; j < 4; ++j) gs += __expf(lg[j] - gm);
            const float gp = 1.0f / gs;
            float el[8];
#pragma unroll
            for (int j = 0; j < 8; ++j) { el[j] = lg[4 + j];
#pragma unroll
                for (int g = 1; g < 4; ++g) el[j] = (gi == g) ? lg[4 + g * 8 + j] : el[j]; }
            int i0 = 0; float m0 = el[0];
#pragma unroll
            for (int j = 1; j < 8; ++j) if (el[j] > m0) { m0 = el[j]; i0 = j; }
            int i1 = 0; float m1 = -3.0e38f;
#pragma unroll
            for (int j = 0; j < 8; ++j) if (j != i0 && el[j] > m1) { m1 = el[j]; i1 = j; }
            const float eb = __expf(m1 - m0), den = 1.0f / (1.0f + eb);
            const int tl = wave * 16 + lane;
            s_e[2 * tl] = gi * 8 + i0; s_e[2 * tl + 1] = gi * 8 + i1; s_g[2 * tl] = gp * den; s_g[2 * tl + 1] = gp * eb * den; s_r[tl] = r;
        }
        __syncthreads();
        if (tid < 256) s_rank[tid] = atomicAdd((unsigned*)&s_cnt[s_e[tid]], 1u);
        __syncthreads();
        if (tid < NE) s_base[tid] = s_cnt[tid] ? atomicAdd(&cnt[tid], s_cnt[tid]) : 0u;
        __syncthreads();
        if (tid < 256) { const int e = s_e[tid], tok = tb + (tid >> 1); const unsigned pos = s_base[e] + s_rank[tid];
            ltok[(size_t)e * T + pos] = tok; lgate[(size_t)e * T + pos] = s_g[tid]; lrs[(size_t)e * T + pos] = s_r[tid >> 1];
            asg[(size_t)tok * 4 + (tid & 1) * 2] = ((unsigned)e << 24) | pos; asg[(size_t)tok * 4 + (tid & 1) * 2 + 1] = __float_as_uint(s_g[tid]); }
        __syncthreads();
    }
}
__device__ __forceinline__ int build_tile_table(LAS unsigned char* lds, const unsigned* __restrict__ cnt) {
    LAS int* tab = (LAS int*)(lds + TAB_OFF); LAS int* tabn = (LAS int*)(lds + TABN_OFF);
    const int tid = phase_tid();
    if (tid < NE) {
        int bacc = 0, sacc_small = 0, sacc = 0, mine = 0, nbig_all = 0, nsmall_all = 0;
        for (int e = 0; e < NE; ++e) { const int n = (int)cnt[e], full = n / BM, rem = n % BM, nb = full + (rem > HALF ? 1 : 0), ns = (rem > 0 && rem <= HALF) ? 1 : 0;
            if (e == tid) mine = n; if (e < tid) { bacc += nb; sacc_small += ns; sacc += n; } nbig_all += nb; nsmall_all += ns; }
        const int full = mine / BM, rem = mine % BM, nb = full + (rem > HALF ? 1 : 0);
        for (int j = 0; j < nb; ++j) { const int ti = bacc + j; if (ti < TAB_MAX) { tab[ti * 4 + 0] = tid; tab[ti * 4 + 1] = j * BM; tab[ti * 4 + 2] = min(BM, mine - j * BM); tab[ti * 4 + 3] = sacc + j * BM; } }
        if (rem > 0 && rem <= HALF) { const int ti = nbig_all + sacc_small; if (ti < TAB_MAX) { tab[ti * 4 + 0] = tid; tab[ti * 4 + 1] = full * BM; tab[ti * 4 + 2] = rem; tab[ti * 4 + 3] = sacc + full * BM; } }
        if (tid == NE - 1) tabn[0] = min(nbig_all + nsmall_all, TAB_MAX);
    }
    __syncthreads();
    return __builtin_amdgcn_readfirstlane(tabn[0]);
}
template <bool FINAL> __device__ __forceinline__ void ph_combine(const bf16_t* __restrict__ X, const unsigned char* __restrict__ YS, const unsigned* __restrict__ cnt, const unsigned* __restrict__ asg,
                                                                 bf16_t* __restrict__ Xo, float* __restrict__ rs, const float* __restrict__ g, float* __restrict__ out) {
    const int tid = phase_tid(), lane = tid & 63, gw = ((int)blockIdx.x * NT + tid) >> 6, ngw = ((int)gridDim.x * NT) >> 6;
    unsigned c = lane < NE ? cnt[lane] : 0u, inc = c;
#pragma unroll
    for (int o = 1; o < 32; o <<= 1) { const unsigned t = __shfl_up(inc, o); if (lane >= o) inc += t; }
    const unsigned excl = inc - c;
    for (int rowb = gw; rowb < T; rowb += 2 * ngw) {
        int rows[2]; rows[0] = rowb; rows[1] = (rowb + ngw < T) ? rowb + ngw : rowb;
        unsigned sa[2], sb[2];
#pragma unroll
        for (int q = 0; q < 2; ++q) { const u32x4 cw = *(const u32x4*)(asg + (size_t)rows[q] * 4); sa[q] = __shfl(excl, (int)(cw.x >> 24)) + (cw.x & 0xffffffu); sb[q] = __shfl(excl, (int)(cw.z >> 24)) + (cw.z & 0xffffffu); }
        u32x4 xr[2][2]; u32x2 ar[2][2], br[2][2];
#pragma unroll
        for (int q = 0; q < 2; ++q)
#pragma unroll
            for (int h = 0; h < 2; ++h) { xr[q][h] = __builtin_nontemporal_load((const u32x4*)(X + (size_t)rows[q] * D + h * 512 + lane * 8)); ar[q][h] = __builtin_nontemporal_load((const u32x2*)(YS + (size_t)sa[q] * D + h * 512 + lane * 8)); br[q][h] = __builtin_nontemporal_load((const u32x2*)(YS + (size_t)sb[q] * D + h * 512 + lane * 8)); }
#pragma unroll
        for (int q = 0; q < 2; ++q) {
            if (q == 1 && rows[1] == rows[0]) break;
            const int row = rows[q];
            float v[16];
#pragma unroll
            for (int h = 0; h < 2; ++h) { float x8[8], a[8], b[8]; unpack8(xr[q][h], x8); unpack8_fp8(ar[q][h], a); unpack8_fp8(br[q][h], b);
#pragma unroll
                for (int i = 0; i < 8; ++i) v[h * 8 + i] = x8[i] + (a[i] + b[i]) * (1.0f / 16.0f); }
            if (!FINAL) {
                float ss = 0.f;
#pragma unroll
                for (int h = 0; h < 2; ++h) { float o8[8];
#pragma unroll
                    for (int i = 0; i < 8; ++i) { o8[i] = bf2f(f2bf(v[h * 8 + i])); ss += o8[i] * o8[i]; }
                    *(u32x4*)(Xo + (size_t)row * D + h * 512 + lane * 8) = pack8(o8); }
                const float r = rsqrtf(wave_sum(ss) * (1.0f / D) + EPS);
                if (lane == 0) rs[row] = r;
            } else {
                float ss = 0.f;
#pragma unroll
                for (int i = 0; i < 16; ++i) ss += v[i] * v[i];
                const float r = rsqrtf(wave_sum(ss) * (1.0f / D) + EPS);
#pragma unroll
                for (int h = 0; h < 2; ++h) { const f32x4 g0 = *(const f32x4*)(g + h * 512 + lane * 8), g1 = *(const f32x4*)(g + h * 512 + lane * 8 + 4);
                    f32x4 o0, o1; o0.x = v[h * 8 + 0] * r * g0.x; o0.y = v[h * 8 + 1] * r * g0.y; o0.z = v[h * 8 + 2] * r * g0.z; o0.w = v[h * 8 + 3] * r * g0.w;
                    o1.x = v[h * 8 + 4] * r * g1.x; o1.y = v[h * 8 + 5] * r * g1.y; o1.z = v[h * 8 + 6] * r * g1.z; o1.w = v[h * 8 + 7] * r * g1.w;
                    __builtin_nontemporal_store(o0, (f32x4*)(out + (size_t)row * D + h * 512 + lane * 8)); __builtin_nontemporal_store(o1, (f32x4*)(out + (size_t)row * D + h * 512 + lane * 8 + 4)); }
            }
        }
    }
}
constexpr int MIX_PITCH = 272, MIX_BUF = CHUNK * MIX_PITCH, MIX_STAT_OFF = 2 * MIX_BUF;
typedef short s16x4 __attribute__((ext_vector_type(4)));
__device__ __forceinline__ void ph_mix(LAS unsigned char* lds, const bf16_t* __restrict__ UV, const f32x2* __restrict__ lnp, const float* __restrict__ vg, const float* __restrict__ vbeta,
                                       const bf16_t* __restrict__ wm, const float* __restrict__ bs, bf16_t* __restrict__ YM) {
    const int tid = phase_tid(), wave = tid >> 6, lane = tid & 63, fr = lane & 15, fq = lane >> 4, wt = wave >> 1, wd = wave & 1;
    LAS float* stat = (LAS float*)(lds + MIX_STAT_OFF);
    const int ch = tid & 15, srow = tid >> 4;
    const int cgrp = ch >> 2, ca = ch & 3;
    for (int bc = (int)blockIdx.x; bc < T / CHUNK; bc += (int)gridDim.x) {
        const int row0 = bc * CHUNK;
        if (tid < CHUNK) { const f32x4* pp = (const f32x4*)(lnp + (size_t)(row0 + tid) * 16); float sm = 0.f, sq = 0.f;
#pragma unroll
            for (int i = 0; i < 8; ++i) { const f32x4 pv = pp[i]; sm += pv.x + pv.z; sq += pv.y + pv.w; }
            const float mu = sm * (1.0f / D), var = fmaxf(sq * (1.0f / D) - mu * mu, 0.f);
            stat[2 * tid] = mu; stat[2 * tid + 1] = rsqrtf(var + EPS); }
        __syncthreads();
        u32x4 vraw[4];
#pragma unroll
        for (int p = 0; p < 4; ++p) vraw[p] = __builtin_nontemporal_load((const u32x4*)(UV + (size_t)T * D + (size_t)(row0 + srow + 32 * p) * D + 0 * 128 + 8 * ch));
#pragma unroll 1
        for (int h = 0; h < NH; ++h) {
            LAS unsigned char* buf = lds + (h & 1) * MIX_BUF;
            float g8[8], b8[8];
            { const f32x4 ga = *(const f32x4*)(vg + h * 128 + 8 * ch), gb = *(const f32x4*)(vg + h * 128 + 8 * ch + 4), ba = *(const f32x4*)(vbeta + h * 128 + 8 * ch), bb = *(const f32x4*)(vbeta + h * 128 + 8 * ch + 4);
              g8[0] = ga.x; g8[1] = ga.y; g8[2] = ga.z; g8[3] = ga.w; g8[4] = gb.x; g8[5] = gb.y; g8[6] = gb.z; g8[7] = gb.w;
              b8[0] = ba.x; b8[1] = ba.y; b8[2] = ba.z; b8[3] = ba.w; b8[4] = bb.x; b8[5] = bb.y; b8[6] = bb.z; b8[7] = bb.w; }
#pragma unroll
            for (int p = 0; p < 4; ++p) { const int sr = srow + 32 * p; float v[8]; unpack8(vraw[p], v);
                const float mu = stat[2 * sr], rstd = stat[2 * sr + 1];
#pragma unroll
                for (int q = 0; q < 8; ++q) v[q] = (v[q] - mu) * rstd * g8[q] + b8[q];
                u32x2 lo, hi; lo.x = pk2(v[0], v[1]); lo.y = pk2(v[2], v[3]); hi.x = pk2(v[4], v[5]); hi.y = pk2(v[6], v[7]);
                *(LAS u32x2*)(buf + sr * MIX_PITCH + (32 * cgrp + 4 * ca) * 2) = lo; *(LAS u32x2*)(buf + sr * MIX_PITCH + (32 * cgrp + 16 + 4 * ca) * 2) = hi; }
            __syncthreads();
            if (h + 1 < NH) {
#pragma unroll
                for (int p = 0; p < 4; ++p) vraw[p] = __builtin_nontemporal_load((const u32x4*)(UV + (size_t)T * D + (size_t)(row0 + srow + 32 * p) * D + (h + 1) * 128 + 8 * ch)); }
            u32x4 uraw[2][2]; float bsv[2];
#pragma unroll
            for (int m = 0; m < 2; ++m) { const int t = 32 * wt + 16 * m + fr; bsv[m] = bs[h * CHUNK + t];
#pragma unroll
                for (int cc = 0; cc < 2; ++cc) uraw[m][cc] = __builtin_nontemporal_load((const u32x4*)(UV + (size_t)(row0 + t) * D + h * 128 + 32 * (2 * wd + cc) + 8 * fq)); }
            bf16x8 af[4][2];
#pragma unroll
            for (int kk = 0; kk < 4; ++kk)
#pragma unroll
                for (int m = 0; m < 2; ++m) af[kk][m] = *(const bf16x8*)(wm + ((size_t)(h * CHUNK + 32 * wt + 16 * m + fr)) * CHUNK + 32 * (kk <= wt ? kk : wt) + 8 * fq);
            f32x4 acc[2][4];
#pragma unroll
            for (int m = 0; m < 2; ++m)
#pragma unroll
                for (int n = 0; n < 4; ++n) acc[m][n] = (f32x4){0.f, 0.f, 0.f, 0.f};
            const int q4 = (lane & 15) >> 2, p4 = lane & 3;
#pragma unroll
            for (int kk = 0; kk < 4; ++kk) {
                if (kk <= wt) {
#pragma unroll
                    for (int n = 0; n < 4; ++n) {
                        const int colpos = 32 * (2 * wd + (n >> 1)) + 16 * (n & 1);
                        LAS unsigned char* base = buf + (32 * kk + 8 * fq + q4) * MIX_PITCH + colpos * 2 + 8 * p4;
                        const s16x4 t0 = __builtin_amdgcn_ds_read_tr16_b64_v4i16((LAS s16x4*)base);
                        const s16x4 t1 = __builtin_amdgcn_ds_read_tr16_b64_v4i16((LAS s16x4*)(base + 4 * MIX_PITCH));
                        bf16x8 bfrag; bfrag[0] = t0[0]; bfrag[1] = t0[1]; bfrag[2] = t0[2]; bfrag[3] = t0[3]; bfrag[4] = t1[0]; bfrag[5] = t1[1]; bfrag[6] = t1[2]; bfrag[7] = t1[3];
#pragma unroll
                        for (int m = 0; m < 2; ++m) acc[m][n] = __builtin_amdgcn_mfma_f32_16x16x32_bf16(bfrag, af[kk][m], acc[m][n], 0, 0, 0);
                    }
                }
            }
#pragma unroll
            for (int m = 0; m < 2; ++m) { const int t = 32 * wt + 16 * m + fr;
#pragma unroll
                for (int cc = 0; cc < 2; ++cc) { const int col = h * 128 + 32 * (2 * wd + cc) + 8 * fq; float u8[8], o8[8];
                    unpack8(uraw[m][cc], u8);
#pragma unroll
                    for (int n = 0; n < 2; ++n)
#pragma unroll
                        for (int r = 0; r < 4; ++r) o8[4 * n + r] = u8[4 * n + r] * (acc[m][2 * cc + n][r] + bsv[m]);
                    *(u32x4*)(YM + (size_t)(row0 + t) * D + col) = pack8(o8); } }
        }
        __syncthreads();
    }
}

#define XB_TMO      128
#define XB_XCNT(j)  (256  + 64 * (j))
#define XB_XSUB(j)  (1280 + 64 * (j))
#define XB_XGEN(j)  (2304 + 64 * (j))
#define XB_TOP      3328
#define XB_TOPGEN   3392
#define XCD_BAR_WORDS 3456
#define XB_SPIN_CAP (1u << 22)
__device__ __forceinline__ unsigned xb_ld(unsigned* p)              { return __hip_atomic_load(p, __ATOMIC_RELAXED, __HIP_MEMORY_SCOPE_AGENT); }
__device__ __forceinline__ unsigned xb_add(unsigned* p, unsigned v) { return __hip_atomic_fetch_add(p, v, __ATOMIC_RELAXED, __HIP_MEMORY_SCOPE_AGENT); }
__device__ __forceinline__ unsigned xb_xcc_id() { return (unsigned)__builtin_amdgcn_s_getreg((3 << 11) | 20) & 0xFu; }
#define XB_SPIN(cond, bar) do { unsigned _sp = 0; while (cond) { __builtin_amdgcn_s_sleep(1); \
    if ((++_sp & 255u) == 0u) { if (xb_ld(&(bar)[XB_TMO])) break; if (_sp > XB_SPIN_CAP) { atomicAdd(&(bar)[XB_TMO], 1u); break; } } } } while (0)
struct XcdBarrier { unsigned* bar; unsigned x; volatile LAS unsigned* st; };
__device__ __forceinline__ XcdBarrier xcd_barrier_post(unsigned* bar, volatile LAS unsigned* st) {
    XcdBarrier b; b.bar = bar; b.x = xb_xcc_id(); b.st = st;
    if (threadIdx.x == 0) (void)xb_add(&bar[XB_XCNT(b.x)], 1u);
    return b;
}
__device__ __forceinline__ void xcd_barrier_complete(unsigned* bar, unsigned x, unsigned& nloc, unsigned& nx) {
    const unsigned G = gridDim.x * gridDim.y * gridDim.z;
    unsigned sum, cnt, mine, sp = 0u;
    for (;;) {
        sum = 0u; cnt = 0u; mine = 0u;
#pragma unroll
        for (unsigned j = 0; j < 16; ++j) { const unsigned c = xb_ld(&bar[XB_XCNT(j)]); sum += c; cnt += (c > 0u) ? 1u : 0u; mine = (j == x) ? c : mine; }
        if (sum == G) break;
        __builtin_amdgcn_s_sleep(1);
        if ((++sp & 255u) == 0u) { if (xb_ld(&bar[XB_TMO])) break; if (sp > XB_SPIN_CAP) { atomicAdd(&bar[XB_TMO], 1u); break; } }
    }
    nloc = mine > 0u ? mine : 1u; nx = cnt > 0u ? cnt : 1u;
}
__device__ __forceinline__ void xcd_barrier(const XcdBarrier& b) {
    asm volatile("s_waitcnt vmcnt(0)" ::: "memory");
    __syncthreads();
    if (threadIdx.x == 0) {
        unsigned* bar = b.bar;
        __builtin_amdgcn_s_waitcnt(0);
        unsigned nloc = b.st[0], nx = b.st[1];
        if (nloc == 0u) { xcd_barrier_complete(bar, b.x, nloc, nx); b.st[0] = nloc; b.st[1] = nx; }
        const unsigned old = xb_add(&bar[XB_XSUB(b.x)], 1u);
        const unsigned gen = old / nloc;
        if (old + 1u == (gen + 1u) * nloc) {
            __builtin_amdgcn_fence(__ATOMIC_RELEASE, "agent");
            asm volatile("s_waitcnt vmcnt(0)" ::: "memory");
            const unsigned og = xb_add(&bar[XB_TOP], 1u);
            const unsigned tg = og / nx;
            if (og + 1u == (tg + 1u) * nx) xb_add(&bar[XB_TOPGEN], 1u);
            else XB_SPIN(xb_ld(&bar[XB_TOPGEN]) == tg, bar);
            __builtin_amdgcn_fence(__ATOMIC_ACQUIRE, "agent");
            xb_add(&bar[XB_XGEN(b.x)], 1u);
            asm volatile("s_waitcnt vmcnt(0)" ::: "memory");
        } else {
            XB_SPIN(xb_ld(&bar[XB_XGEN(b.x)]) == gen, bar);
            __builtin_amdgcn_fence(__ATOMIC_ACQUIRE, "agent");
            asm volatile("s_waitcnt vmcnt(0)" ::: "memory");
        }
    }
    __syncthreads();
}

#ifndef REP_PREP
#define REP_PREP 1
#endif
#ifndef REP_THIN
#define REP_THIN 1
#endif
#ifndef REP_GEMM
#define REP_GEMM 1
#endif
#ifndef REP_SYNC
#define REP_SYNC 1
#endif
#define REPEAT(n, ...) for (int rep_ = 0; rep_ < (n); ++rep_) { __VA_ARGS__; if (rep_ + 1 < (n)) xcd_barrier(xbar); }
#define GSYNC() do { for (int rs_ = 0; rs_ < REP_SYNC; ++rs_) xcd_barrier(xbar); } while (0)
struct Params { const float* in[22]; float* out; unsigned char* ws; };
__global__ void __launch_bounds__(NT, 2) mega_fwd(Params P) {
    extern __shared__ __attribute__((aligned(16))) unsigned char lds_raw[];
    LAS unsigned char* lds = (LAS unsigned char*)lds_raw;
    cg::grid_group grid = cg::this_grid();
    const int G = (int)gridDim.x, bid = (int)blockIdx.x;
    if (P.ws == nullptr) grid.sync();
    if (threadIdx.x < 4) ((LAS unsigned*)(lds + BARST_OFF))[threadIdx.x] = 0u;
    __syncthreads();
    const XcdBarrier xbar = xcd_barrier_post((unsigned*)(P.ws + WS_CTL) + CW_BAR, (volatile LAS unsigned*)(lds + BARST_OFF));
    const float* x = P.in[0]; const float* ln_a = P.in[1]; const float* w_in_a = P.in[2]; const float* conv_w = P.in[3];
    const float* w_out_a = P.in[4]; const float* ln_b = P.in[5]; const float* w_in_b = P.in[6]; const float* b_in_b = P.in[7];
    const float* v_ln_g = P.in[8]; const float* v_ln_b = P.in[9]; const float* w_s = P.in[10]; const float* b_s = P.in[11];
    const float* w_out_b = P.in[12]; const float* ln2 = P.in[13]; const float* w_group = P.in[14]; const float* b_group = P.in[15];
    const float* w_expert = P.in[16]; const float* b_expert = P.in[17]; const float* w_gate = P.in[18]; const float* w_up = P.in[19];
    const float* w_down = P.in[20]; const float* ln_f = P.in[21];
    unsigned char* ws = P.ws; float* out = P.out;
    unsigned* ctl = (unsigned*)(ws + WS_CTL); float* RS = (float*)(ws + WS_RS); unsigned* ASG = (unsigned*)(ws + WS_ASG); float* LNS = (float*)(ws + WS_LNS);
    int* LTOK = (int*)(ws + WS_LTOK); float* LGATE = (float*)(ws + WS_LGATE); float* LRS = (float*)(ws + WS_LRS); bf16_t* WR = (bf16_t*)(ws + WS_WR); bf16_t* WM = (bf16_t*)(ws + WS_WM);
    bf16_t* WA_IN = (bf16_t*)(ws + WS_WA_IN); bf16_t* WA_OUT = (bf16_t*)(ws + WS_WA_OUT); bf16_t* WB_IN = (bf16_t*)(ws + WS_WB_IN); bf16_t* WB_OUT = (bf16_t*)(ws + WS_WB_OUT);
    unsigned char* WGU = ws + WS_WGU; unsigned char* WD = ws + WS_WD; unsigned char* XQ = ws + WS_XQ;
    bf16_t* bufA = (bf16_t*)(ws + WS_A); bf16_t* bufB = (bf16_t*)(ws + WS_B); bf16_t* bufC = (bf16_t*)(ws + WS_C); bf16_t* bufD = (bf16_t*)(ws + WS_D);

#define DENSE_GEMM(EPI_T, epi_init, Aptr, Bptr, NCOLS) do { DenseSched S{T / BM, (NCOLS) / BM, G, bid, D, (Bptr)}; EPI_T E epi_init; gemm_phase<EPI_T, DenseSched>(lds, (Aptr), D, S, E); } while (0)
#define MOE_PHASES(layer, Xin, Hb) do { \
        unsigned* cnt_ = ctl + CW_CNT + (layer) * NE; \
        ph_route(lds, (Xin), WR + (size_t)(layer) * 2 * 48 * D, b_group + (layer) * NG, b_expert + (layer) * NE, cnt_, ASG, LTOK, LGATE, LRS); \
        GSYNC(); \
        { const int ntm = build_tile_table(lds, cnt_); \
          REPEAT(REP_GEMM, { MoeSched<true> S{ntm, G, bid, D / 2, WGU, LTOK, (const LAS int*)(lds + TAB_OFF), LRS}; EpiG3 E{LRS, (unsigned char*)(Hb)}; gemm_phase<EpiG3, MoeSched<true>, true>(lds, (const bf16_t*)XQ, D / 2, S, E); }) \
          GSYNC(); \
          REPEAT(REP_GEMM, { MoeSched<false> S{ntm, G, bid, F / 2, WD, LTOK, (const LAS int*)(lds + TAB_OFF), LGATE}; EpiG4 E{LGATE, (unsigned char*)bufA}; gemm_phase<EpiG4, MoeSched<false>, true>(lds, (const bf16_t*)(Hb), F / 2, S, E); }) } \
        GSYNC(); } while (0)

    REPEAT(REP_PREP,
    ph_prep_x(x, ln_a, bufB, RS);
    ph_transpose<false>(lds, w_in_a, D, 3 * D, WA_IN, 1, nullptr, 1, 0, 0, 0);
    ph_transpose<false>(lds, w_out_a, D, D, WA_OUT, 0, nullptr, 1, 0, 0, 768);
    ph_transpose<false>(lds, w_in_b, D, 2 * D, WB_IN, 0, ln_b, 1, 0, 0, 1024);
    ph_transpose<false>(lds, w_out_b, D, D, WB_OUT, 0, nullptr, 1, 0, 0, 1536);
    ph_prep_router(ln2, w_group, w_expert, WR);
    ph_prep_wm(w_s, WM);
    ph_prep_experts(lds, 0, w_gate, w_up, w_down, ln2, WGU, WD));
    GSYNC();
    REPEAT(REP_GEMM, DENSE_GEMM(EpiG1, {bufA}, bufB, WA_IN, 3 * D));
    GSYNC();
    REPEAT(REP_THIN, ph_conv(bufA, conv_w, bufC));
    GSYNC();
    REPEAT(REP_GEMM, DENSE_GEMM(EpiRes<true>, ({bufB, bufD, XQ, RS, ln_a}), bufC, WA_OUT, D));
    GSYNC();
    MOE_PHASES(0, bufD, bufB);
    REPEAT(REP_THIN, ph_combine<false>(bufD, (const unsigned char*)bufA, ctl + CW_CNT, ASG, bufC, RS, nullptr, nullptr));
    REPEAT(REP_PREP, ph_prep_experts(lds, 1, w_gate, w_up, w_down, ln2, WGU, WD));
    GSYNC();
    REPEAT(REP_GEMM, DENSE_GEMM(EpiG5, ({RS, b_in_b, bufA, (f32x2*)(ws + WS_LNP)}), bufC, WB_IN, 2 * D));
    GSYNC();
    REPEAT(REP_THIN, ph_mix(lds, bufA, (const f32x2*)(ws + WS_LNP), v_ln_g, v_ln_b, WM, b_s, bufD));
    GSYNC();
    REPEAT(REP_GEMM, DENSE_GEMM(EpiRes<false>, ({bufC, bufB, XQ, nullptr, nullptr}), bufD, WB_OUT, D));
    GSYNC();
    MOE_PHASES(1, bufB, bufC);
    REPEAT(REP_THIN, ph_combine<true>(bufB, (const unsigned char*)bufA, ctl + CW_CNT + NE, ASG, nullptr, nullptr, ln_f, out));
}
}

extern "C" void kernel_launch(void* const* d_in, const int* in_sizes, int n_in, void* d_out, int out_size, void* d_ws, size_t ws_size, hipStream_t stream) {
    if (n_in != 22 || ws_size < WS_END) { fprintf(stderr, "kernel_launch: unexpected n_in %d / ws_size %zu\n", n_in, ws_size); return; }
    static int grid_blocks = 0;
    if (!grid_blocks) {
        int dev = 0, cus = 0, per_cu = 0;
        (void)hipGetDevice(&dev);
        (void)hipDeviceGetAttribute(&cus, hipDeviceAttributeMultiprocessorCount, dev);
        (void)hipFuncSetAttribute((const void*)mega_fwd, hipFuncAttributeMaxDynamicSharedMemorySize, LDS_BYTES);
        (void)hipOccupancyMaxActiveBlocksPerMultiprocessor(&per_cu, (const void*)mega_fwd, NT, LDS_BYTES);
        if (per_cu < 1) fprintf(stderr, "kernel_launch: occupancy query says %d blocks per CU\n", per_cu);
        grid_blocks = cus;
    }
    (void)hipMemsetAsync((unsigned char*)d_ws + WS_CTL, 0, CTL_BYTES, stream);
    Params p{};
    for (int i = 0; i < 22; ++i) p.in[i] = (const float*)d_in[i];
    p.out = (float*)d_out; p.ws = (unsigned char*)d_ws;
    void* args[] = {&p};
    hipError_t e = hipLaunchCooperativeKernel((const void*)mega_fwd, dim3(grid_blocks), dim3(NT), args, LDS_BYTES, stream);
    if (e != hipSuccess) fprintf(stderr, "cooperative launch failed: %s (grid %d)\n", hipGetErrorString(e), grid_blocks);
}
```

```cpp
#include <hip/hip_runtime.h>
#include <hip/hip_cooperative_groups.h>
#include <cstdint>
#include <cstdio>

namespace cg = cooperative_groups;
namespace {
#define LAS __attribute__((address_space(3)))
typedef unsigned short bf16_t;
typedef short bf16x8 __attribute__((ext_vector_type(8)));
typedef float f32x4 __attribute__((ext_vector_type(4)));
typedef float f32x2 __attribute__((ext_vector_type(2)));
typedef unsigned u32x4 __attribute__((ext_vector_type(4)));
typedef unsigned u32x2 __attribute__((ext_vector_type(2)));

constexpr int BATCH = 8, SEQ = 4096, D = 1024, T = BATCH * SEQ;
constexpr int NE = 32, NG = 4, F = 512, CHUNK = 128, NH = 8;
constexpr float EPS = 1e-6f;
constexpr int NT = 512, NWAVES = 8;

constexpr size_t MiB = 1u << 20;
constexpr size_t WS_CTL = 0;
constexpr size_t CTL_BYTES = 65536;
constexpr size_t WS_RS = 1 * MiB;
constexpr size_t WS_ASG = 1 * MiB + 512 * 1024;
constexpr size_t WS_LNS = 2 * MiB;
constexpr size_t WS_WR = 2 * MiB + 512 * 1024;
constexpr size_t WS_WM = 3 * MiB;
constexpr size_t WS_LTOK = 4 * MiB;
constexpr size_t WS_LNP = 112 * MiB;
constexpr size_t WS_LGATE = 8 * MiB;
constexpr size_t WS_LRS = 12 * MiB;
constexpr size_t WS_WA_IN = 16 * MiB;
constexpr size_t WS_WA_OUT = 22 * MiB;
constexpr size_t WS_WB_IN = 24 * MiB;
constexpr size_t WS_WB_OUT = 28 * MiB;
constexpr size_t WS_WGU = 32 * MiB;
constexpr size_t WS_WD = 64 * MiB;
constexpr size_t WS_XQ = 80 * MiB;
constexpr size_t WS_A = 128 * MiB;
constexpr size_t WS_B = 256 * MiB;
constexpr size_t WS_C = 320 * MiB;
constexpr size_t WS_D = 384 * MiB;
constexpr size_t WS_END = 449 * MiB;
constexpr int CW_CNT = 0;
constexpr int CW_BAR = 4096;

constexpr int RING_BYTES = 131072;
constexpr int TAB_OFF = RING_BYTES;
constexpr int TAB_MAX = 320;
constexpr int TABN_OFF = TAB_OFF + TAB_MAX * 16;
constexpr int BARST_OFF = TABN_OFF + 16;
constexpr int TOKTAB_OFF = RING_BYTES + 8192;
constexpr int SCTAB_OFF = TOKTAB_OFF + 2048;
constexpr int LDS_BYTES = 147456;

__device__ __forceinline__ float bf2f(unsigned b) { return __uint_as_float(b << 16); }
__device__ __forceinline__ unsigned f2bf(float f) { unsigned u = __float_as_uint(f); return (u + 0x7fffu + ((u >> 16) & 1u)) >> 16; }
__device__ __forceinline__ unsigned pk2(float lo, float hi) { return f2bf(lo) | (f2bf(hi) << 16); }
__device__ __forceinline__ unsigned cvt_pk_bf16(float lo, float hi) { unsigned r; asm volatile("v_cvt_pk_bf16_f32 %0, %1, %2" : "=v"(r) : "v"(lo), "v"(hi)); return r; }
__device__ __forceinline__ float wave_sum(float v) {
#pragma unroll
    for (int o = 1; o < 64; o <<= 1) v += __shfl_xor(v, o);
    return v;
}
__device__ __forceinline__ void unpack8(const u32x4 v, float (&f)[8]) {
    f[0] = bf2f(v.x & 0xffffu); f[1] = bf2f(v.x >> 16); f[2] = bf2f(v.y & 0xffffu); f[3] = bf2f(v.y >> 16);
    f[4] = bf2f(v.z & 0xffffu); f[5] = bf2f(v.z >> 16); f[6] = bf2f(v.w & 0xffffu); f[7] = bf2f(v.w >> 16);
}
__device__ __forceinline__ u32x4 pack8(const float (&f)[8]) {
    u32x4 o; o.x = pk2(f[0], f[1]); o.y = pk2(f[2], f[3]); o.z = pk2(f[4], f[5]); o.w = pk2(f[6], f[7]); return o;
}
__device__ __forceinline__ float gelu_tanh(float x) {
    const float x2 = x * x;
    const float t = x * (x2 * (-0.044715f * 2.0f * 0.7978845608028654f * 1.4426950408889634f) + (-2.0f * 0.7978845608028654f * 1.4426950408889634f));
    return x * __builtin_amdgcn_rcpf(1.0f + __builtin_amdgcn_exp2f(t));
}
__device__ __forceinline__ float silu(float x) { return x * __builtin_amdgcn_rcpf(1.0f + __builtin_amdgcn_exp2f(x * -1.4426950408889634f)); }
#define LDS_WAIT() asm volatile("s_waitcnt lgkmcnt(0)" ::: "memory")
__device__ __forceinline__ float clamp_fp8(float v) { return __builtin_amdgcn_fmed3f(v, -448.0f, 448.0f); }
__device__ __forceinline__ unsigned pk4_fp8(float a, float b, float c, float d) { unsigned w = 0u; a = clamp_fp8(a); b = clamp_fp8(b); c = clamp_fp8(c); d = clamp_fp8(d); w = __builtin_amdgcn_cvt_pk_fp8_f32(a, b, w, false); w = __builtin_amdgcn_cvt_pk_fp8_f32(c, d, w, true); return w; }
__device__ __forceinline__ void unpack8_fp8(const u32x2 v, float (&f)[8]) {
    const f32x2 a = __builtin_amdgcn_cvt_pk_f32_fp8(v.x, false), b = __builtin_amdgcn_cvt_pk_f32_fp8(v.x, true), c = __builtin_amdgcn_cvt_pk_f32_fp8(v.y, false), d = __builtin_amdgcn_cvt_pk_f32_fp8(v.y, true);
    f[0] = a.x; f[1] = a.y; f[2] = b.x; f[3] = b.y; f[4] = c.x; f[5] = c.y; f[6] = d.x; f[7] = d.y;
}
typedef int i32x8 __attribute__((ext_vector_type(8)));
typedef int i32x4 __attribute__((ext_vector_type(4)));
__device__ __forceinline__ int phase_tid() { int t = (int)threadIdx.x; asm volatile("" : "+v"(t)); return t; }

constexpr int BM = 256, BK = 64, HALF = 128, HTB = HALF * BK * 2, NXCD = 8, WGM = 8;
__device__ __forceinline__ int lds_byte(int r, int c) { const int st = (r >> 4) * 2 + (c >> 5), rr = r & 15, cc = c & 31, ob = rr * 64 + cc * 2; return st * 1024 + (ob ^ (((ob >> 9) & 1) << 5)); }
__device__ __forceinline__ void stage_rc(int b, int& R, int& C) { const int st = b / 1024, sb = b % 1024, swz = sb ^ (((sb >> 9) & 1) << 5); R = (st >> 1) * 16 + swz / 64; C = (st & 1) * 32 + (swz % 64) / 2; }
__device__ __forceinline__ int perm32(int rho) { const int n = rho >> 4, i = rho & 15; return 8 * (i >> 2) + 4 * n + (i & 3); }

struct Unit { int pm, pn, e, row0, nrows, slot0; };
__device__ __forceinline__ bool order_next(int i, int G, int c, int nM, int nN, int& pm, int& pn) {
    const int nwg = nM * nN; const long L = (long)i * G + c; if (L >= nwg) return false;
    int wgid = (int)L; { const int q = nwg / NXCD, r = nwg % NXCD, xcd = wgid % NXCD, off = wgid / NXCD; wgid = (xcd < r ? xcd * (q + 1) : r * (q + 1) + (xcd - r) * q) + off; }
    const int nig = WGM * nN, gid = wgid / nig, fm = gid * WGM, gsz = (nM - fm) < WGM ? (nM - fm) : WGM;
    pm = fm + ((wgid % nig) % gsz); pn = (wgid % nig) / gsz; return true;
}
struct DenseSched {
    static constexpr bool ROWTAB = false, GATHER_IDS = false;
    int nM, nN, G, c, K; const bf16_t* Bt;
    __device__ __forceinline__ bool next(int i, Unit& u) const { u.e = 0; u.row0 = 0; u.nrows = BM; u.slot0 = 0; return order_next(i, G, c, nM, nN, u.pm, u.pn); }
    __device__ __forceinline__ void aoff(const Unit& u, int tid, unsigned (&v)[2][2]) const {
        int R[2], C[2]; stage_rc(tid * 16, R[0], C[0]); stage_rc(tid * 16 + 8192, R[1], C[1]);
#pragma unroll
        for (int h = 0; h < 2; ++h)
#pragma unroll
            for (int i = 0; i < 2; ++i) v[h][i] = (unsigned)((u.pm * BM + h * HALF + R[i]) * K + C[i]) * 2u;
    }
    __device__ __forceinline__ const char* bptr(const Unit& u) const { return (const char*)Bt + (size_t)u.pn * BM * K * 2; }
};
template <bool GATHER> struct MoeSched {
    static constexpr bool ROWTAB = true, GATHER_IDS = GATHER;
    int nM, G, c, K; const unsigned char* W; const int* ltok; const LAS int* tab; const float* rowscal;
    __device__ __forceinline__ bool next(int i, Unit& u) const {
        if (G == 256) { const int rt = i * 64 + 8 * (c & 7) + ((c >> 3) & 7); if (rt >= nM) return false; u.pm = rt; u.pn = c >> 6; }
        else if (!order_next(i, G, c, nM, 4, u.pm, u.pn)) return false;
        u.e = __builtin_amdgcn_readfirstlane(tab[u.pm * 4 + 0]); u.row0 = __builtin_amdgcn_readfirstlane(tab[u.pm * 4 + 1]); u.nrows = __builtin_amdgcn_readfirstlane(tab[u.pm * 4 + 2]); u.slot0 = __builtin_amdgcn_readfirstlane(tab[u.pm * 4 + 3]); return true;
    }
    __device__ __forceinline__ void aoff(const Unit& u, int tid, unsigned (&v)[2][2]) const {
        int R[2], C[2]; stage_rc(tid * 16, R[0], C[0]); stage_rc(tid * 16 + 8192, R[1], C[1]);
#pragma unroll
        for (int h = 0; h < 2; ++h)
#pragma unroll
            for (int i = 0; i < 2; ++i) {
                if (GATHER) { const int rr = min(h * HALF + R[i], u.nrows - 1); const int tok = ltok[(size_t)u.e * T + u.row0 + rr]; v[h][i] = (unsigned)(tok * K + C[i]) * 2u; }
                else v[h][i] = (unsigned)((u.slot0 + h * HALF + R[i]) * K + C[i]) * 2u;
            }
    }
    __device__ __forceinline__ void aoff_lds(const LAS int* toktab, int tid, unsigned (&v)[2][2]) const {
        int R[2], C[2]; stage_rc(tid * 16, R[0], C[0]); stage_rc(tid * 16 + 8192, R[1], C[1]);
#pragma unroll
        for (int h = 0; h < 2; ++h)
#pragma unroll
            for (int i = 0; i < 2; ++i) v[h][i] = (unsigned)(toktab[h * HALF + R[i]] * K + C[i]) * 2u;
    }
    __device__ __forceinline__ const char* bptr(const Unit& u) const { return (const char*)W + ((size_t)u.e * 1024 + (size_t)u.pn * BM) * K * 2; }
};

template <class Epi, class Sched, bool FP8 = false>
__device__ __forceinline__ void gemm_phase(LAS unsigned char* lds, const bf16_t* Abase, const int K, const Sched& S, const Epi& E) {
    const int tid = phase_tid(), wid = __builtin_amdgcn_readfirstlane(tid >> 6), lane = tid & 63, wr = wid >> 2, wc = wid & 3, fr = lane & 15, fq = lane >> 4;
    const int nt = K / BK;
    unsigned voffB[2];
#pragma unroll
    for (int i = 0; i < 2; ++i) { int sR, sC; stage_rc(tid * 16 + i * 8192, sR, sC);
        const int Rb = Epi::WIDE ? (64 * (sR >> 5) + 16 * ((sR & 15) >> 2) + 4 * ((sR >> 4) & 1) + (sR & 3)) : ((sR & ~31) + perm32(sR & 31)); voffB[i] = (unsigned)(Rb * K + sC) * 2u; }
    const size_t kstep = (size_t)(BK * 2);
    const size_t hstepB = (size_t)(Epi::WIDE ? 8 : HALF) * K * 2;
    const unsigned ldsw = (unsigned)wid * 1024u;
    const int aoff = lds_byte(wr * 64 + fr, fq * 8), boff = lds_byte(wc * 32 + fr, fq * 8);
#define PG8_SA(b, h) (((b) * 2 + (h)) * HTB)
#define PG8_SB(b, h) ((4 + (b) * 2 + (h)) * HTB)
#define PG8_STAGE(bufoff, gbase, voff) do { _Pragma("unroll") for (int _i = 0; _i < 2; ++_i) \
        __builtin_amdgcn_global_load_lds((const unsigned*)((const char*)(gbase) + (voff)[_i]), (LAS unsigned*)(lds + (bufoff) + ldsw + _i * 8192), 16, 0, 0); } while (0)
#define PG8_LDA(dst, b, h) do { _Pragma("unroll") for (int m = 0; m < 4; ++m) { \
        const i32x4 lo_ = *(const LAS i32x4*)(lds + PG8_SA(b, h) + aoff + m * 2048), hi_ = *(const LAS i32x4*)(lds + PG8_SA(b, h) + aoff + m * 2048 + 1024); \
        if constexpr (FP8) dst##8[m] = __builtin_shufflevector(lo_, hi_, 0, 1, 2, 3, 4, 5, 6, 7); else { dst[m][0] = __builtin_bit_cast(bf16x8, lo_); dst[m][1] = __builtin_bit_cast(bf16x8, hi_); } } } while (0)
#define PG8_LDB(dst, b, h) do { _Pragma("unroll") for (int n = 0; n < 2; ++n) { \
        const i32x4 lo_ = *(const LAS i32x4*)(lds + PG8_SB(b, h) + boff + n * 2048), hi_ = *(const LAS i32x4*)(lds + PG8_SB(b, h) + boff + n * 2048 + 1024); \
        if constexpr (FP8) dst##8[n] = __builtin_shufflevector(lo_, hi_, 0, 1, 2, 3, 4, 5, 6, 7); else { dst[n][0] = __builtin_bit_cast(bf16x8, lo_); dst[n][1] = __builtin_bit_cast(bf16x8, hi_); } } } while (0)
#define PG8_MMA(ai, bj, At, Bt) do { __builtin_amdgcn_s_setprio(1); \
        if constexpr (FP8) { \
            asm volatile("s_nop 1\n\t" \
                "v_mfma_f32_16x16x128_f8f6f4 %0, %8, %10, %0\n\t" "v_mfma_f32_16x16x128_f8f6f4 %1, %9, %10, %1\n\t" \
                "v_mfma_f32_16x16x128_f8f6f4 %2, %8, %11, %2\n\t" "v_mfma_f32_16x16x128_f8f6f4 %3, %9, %11, %3\n\t" \
                "v_mfma_f32_16x16x128_f8f6f4 %4, %8, %12, %4\n\t" "v_mfma_f32_16x16x128_f8f6f4 %5, %9, %12, %5\n\t" \
                "v_mfma_f32_16x16x128_f8f6f4 %6, %8, %13, %6\n\t" "v_mfma_f32_16x16x128_f8f6f4 %7, %9, %13, %7" \
                : "+v"(acc[ai][bj][0][0]), "+v"(acc[ai][bj][0][1]), "+v"(acc[ai][bj][1][0]), "+v"(acc[ai][bj][1][1]), \
                  "+v"(acc[ai][bj][2][0]), "+v"(acc[ai][bj][2][1]), "+v"(acc[ai][bj][3][0]), "+v"(acc[ai][bj][3][1]) \
                : "v"(Bt##8[0]), "v"(Bt##8[1]), "v"(At##8[0]), "v"(At##8[1]), "v"(At##8[2]), "v"(At##8[3])); \
        } else { _Pragma("unroll") for (int m = 0; m < 4; ++m) _Pragma("unroll") for (int n = 0; n < 2; ++n) _Pragma("unroll") for (int k = 0; k < 2; ++k) \
            acc[ai][bj][m][n] = __builtin_amdgcn_mfma_f32_16x16x32_bf16(Bt[n][k], At[m][k], acc[ai][bj][m][n], 0, 0, 0); } \
        __builtin_amdgcn_s_setprio(0); } while (0)
#define PG8_WAIT_V(n) asm volatile("s_waitcnt vmcnt(" #n ")" ::: "memory")
#define PG8_WAIT_L(n) asm volatile("s_waitcnt lgkmcnt(" #n ")" ::: "memory")
#define PG8_BAR __builtin_amdgcn_s_barrier()
#define PG8_SCHED __builtin_amdgcn_sched_barrier(0)
    Unit cur, nxt; int ui = 0;
    if (!S.next(0, cur)) return;
    f32x4 acc[2][2][4][2];
#pragma unroll
    for (int a = 0; a < 2; ++a)
#pragma unroll
        for (int b = 0; b < 2; ++b)
#pragma unroll
            for (int m = 0; m < 4; ++m)
#pragma unroll
                for (int n = 0; n < 2; ++n) acc[a][b][m][n] = (f32x4){0.f, 0.f, 0.f, 0.f};
    bf16x8 At[4][2], B0[2][2], B1[2][2]; i32x8 At8[4], B08[2], B18[2];
    unsigned vA[2][2], vS[2][2];
    S.aoff(cur, tid, vA);
#pragma unroll
    for (int h = 0; h < 2; ++h)
#pragma unroll
        for (int i = 0; i < 2; ++i) vS[h][i] = vA[h][i];
    const char* const A0 = (const char*)Abase;
    const char* cB = S.bptr(cur);
    PG8_STAGE(PG8_SB(0, 0), cB, voffB); PG8_STAGE(PG8_SB(0, 1), cB + hstepB, voffB); PG8_STAGE(PG8_SA(0, 0), A0, vA[0]); PG8_STAGE(PG8_SA(0, 1), A0, vA[1]);
    if (wr == 1) PG8_BAR;
    PG8_WAIT_V(2); PG8_BAR;
    PG8_STAGE(PG8_SB(1, 0), cB + kstep, voffB); PG8_STAGE(PG8_SA(1, 0), A0 + kstep, vA[0]); PG8_STAGE(PG8_SB(1, 1), cB + hstepB + kstep, voffB);
    PG8_WAIT_V(6); PG8_BAR;
    for (;;) {
        const bool has_next = S.next(ui + 1, nxt);
        const bool full = cur.nrows > HALF;
        if constexpr (Sched::ROWTAB) {
            if (wid < 4) { const int row = wid * 64 + lane;
                __builtin_amdgcn_global_load_lds((const unsigned*)(S.rowscal + (size_t)cur.e * T + cur.row0 + min(row, cur.nrows - 1)), (LAS unsigned*)(lds + SCTAB_OFF + (ui & 1) * 1024 + wid * 256), 4, 0, 0);
                if (Sched::GATHER_IDS && has_next) __builtin_amdgcn_global_load_lds((const unsigned*)(S.ltok + (size_t)nxt.e * T + nxt.row0 + min(row, nxt.nrows - 1)), (LAS unsigned*)(lds + TOKTAB_OFF + (ui & 1) * 1024 + wid * 256), 4, 0, 0); }
        }
        const char* nB = has_next ? S.bptr(nxt) : cB;
#pragma unroll 1
        for (int t = 0; t < nt; t += 2) {
            const bool last = (t == nt - 2);
            if (last && has_next) { if constexpr (Sched::GATHER_IDS) S.aoff_lds((const LAS int*)(lds + TOKTAB_OFF + (ui & 1) * 1024), tid, vS); else S.aoff(nxt, tid, vS); }
            const char* a1 = A0 + (size_t)(t + 1) * kstep;
            const char* a2 = last ? A0 : A0 + (size_t)(t + 2) * kstep; const char* b2 = last ? nB : cB + (size_t)(t + 2) * kstep;
            const char* a3 = a2 + kstep; const char* b3 = b2 + kstep;
            PG8_LDB(B0, 0, 0); PG8_LDB(B1, 0, 1); PG8_SCHED; PG8_LDA(At, 0, 0); PG8_STAGE(PG8_SA(1, 1), a1, vA[1]);
            PG8_WAIT_V(8); PG8_WAIT_L(0); PG8_BAR; PG8_MMA(0, 0, At, B0); PG8_MMA(0, 1, At, B1); PG8_BAR; PG8_SCHED;
            PG8_LDA(At, 0, 1); PG8_STAGE(PG8_SB(0, 0), b2, voffB); PG8_STAGE(PG8_SB(0, 1), b2 + hstepB, voffB); PG8_STAGE(PG8_SA(0, 0), a2, vS[0]);
            PG8_WAIT_V(8); PG8_WAIT_L(0); PG8_BAR; if (full) { PG8_MMA(1, 0, At, B0); PG8_MMA(1, 1, At, B1); } PG8_BAR; PG8_SCHED;
            PG8_LDB(B0, 1, 0); PG8_LDB(B1, 1, 1); PG8_SCHED; PG8_LDA(At, 1, 0); PG8_STAGE(PG8_SA(0, 1), a2, vS[1]);
            PG8_WAIT_V(8); PG8_WAIT_L(0); PG8_BAR; PG8_MMA(0, 0, At, B0); PG8_MMA(0, 1, At, B1); PG8_BAR; PG8_SCHED;
            PG8_LDA(At, 1, 1); PG8_STAGE(PG8_SB(1, 0), b3, voffB); PG8_STAGE(PG8_SB(1, 1), b3 + hstepB, voffB); PG8_STAGE(PG8_SA(1, 0), a3, vS[0]);
            PG8_WAIT_V(8); PG8_WAIT_L(0); PG8_BAR; if (full) { PG8_MMA(1, 0, At, B0); PG8_MMA(1, 1, At, B1); } PG8_BAR; PG8_SCHED;
        }
        if (wr == 0) PG8_BAR;
        if constexpr (FP8) asm volatile("s_nop 7\n\ts_nop 7\n\ts_nop 7" ::: "memory");
        { const int t2 = phase_tid(), l2 = t2 & 63; E(acc, cur, wr, wc, l2 & 15, l2 >> 4, (const LAS float*)(lds + SCTAB_OFF + (ui & 1) * 1024)); }
        if (!has_next) break;
#pragma unroll
        for (int a = 0; a < 2; ++a)
#pragma unroll
            for (int b = 0; b < 2; ++b)
#pragma unroll
                for (int m = 0; m < 4; ++m)
#pragma unroll
                    for (int n = 0; n < 2; ++n) acc[a][b][m][n] = (f32x4){0.f, 0.f, 0.f, 0.f};
        cur = nxt; cB = nB; ++ui;
#pragma unroll
        for (int h = 0; h < 2; ++h)
#pragma unroll
            for (int i = 0; i < 2; ++i) vA[h][i] = vS[h][i];
        if (wr == 1) PG8_BAR;
    }
    PG8_WAIT_V(0);
    PG8_BAR;
#undef PG8_SA
#undef PG8_SB
#undef PG8_STAGE
#undef PG8_LDA
#undef PG8_LDB
#undef PG8_MMA
#undef PG8_WAIT_V
#undef PG8_WAIT_L
#undef PG8_BAR
#undef PG8_SCHED
}

__device__ __forceinline__ u32x4 pack_rows(const f32x4 v0, const f32x4 v1) { u32x4 w; w.x = cvt_pk_bf16(v0[0], v0[1]); w.y = cvt_pk_bf16(v0[2], v0[3]); w.z = cvt_pk_bf16(v1[0], v1[1]); w.w = cvt_pk_bf16(v1[2], v1[3]); return w; }
struct EpiG1 {
    static constexpr bool WIDE = false;
    bf16_t* ZB;
    __device__ __forceinline__ void operator()(const f32x4 (&acc)[2][2][4][2], const Unit& u, int wr, int wc, int fr, int fq, const LAS float* sct) const {
        const int row0 = u.pm * BM + wr * 64 + fr;
#pragma unroll
        for (int ai = 0; ai < 2; ++ai)
#pragma unroll
            for (int m = 0; m < 4; ++m) { bf16_t* rowp = ZB + (size_t)(row0 + ai * HALF + m * 16) * D;
                if (u.pn < 8) { *(u32x4*)(rowp + u.pn * 128 + wc * 32 + 8 * fq) = pack_rows(acc[ai][0][m][0] * acc[ai][1][m][0], acc[ai][0][m][1] * acc[ai][1][m][1]); }
                else {
#pragma unroll
                    for (int bj = 0; bj < 2; ++bj) *(u32x4*)(rowp + (size_t)T * D + (u.pn - 8) * BM + bj * HALF + wc * 32 + 8 * fq) = pack_rows(acc[ai][bj][m][0], acc[ai][bj][m][1]); } }
    }
};
template <bool SCALED> struct EpiRes {
    static constexpr bool WIDE = true;
    const bf16_t* res; bf16_t* X; unsigned char* XQ; const float* rinv; const float* gcol;
    __device__ __forceinline__ void operator()(const f32x4 (&acc)[2][2][4][2], const Unit& u, int wr, int wc, int fr, int fq, const LAS float* sct) const {
        const int row0 = u.pm * BM + wr * 64 + fr, col0 = u.pn * BM + wc * 64 + 16 * fq;
        float gi[2][8];
        if (SCALED) {
#pragma unroll
            for (int bj = 0; bj < 2; ++bj) { const f32x4 g0 = *(const f32x4*)(gcol + col0 + 8 * bj), g1 = *(const f32x4*)(gcol + col0 + 8 * bj + 4);
                gi[bj][0] = __builtin_amdgcn_rcpf(g0.x); gi[bj][1] = __builtin_amdgcn_rcpf(g0.y); gi[bj][2] = __builtin_amdgcn_rcpf(g0.z); gi[bj][3] = __builtin_amdgcn_rcpf(g0.w);
                gi[bj][4] = __builtin_amdgcn_rcpf(g1.x); gi[bj][5] = __builtin_amdgcn_rcpf(g1.y); gi[bj][6] = __builtin_amdgcn_rcpf(g1.z); gi[bj][7] = __builtin_amdgcn_rcpf(g1.w); } }
#pragma unroll
        for (int ai = 0; ai < 2; ++ai) {
            u32x4 rb[4][2]; float ri[4];
#pragma unroll
            for (int m = 0; m < 4; ++m) { const size_t off = (size_t)(row0 + ai * HALF + m * 16) * D + col0; ri[m] = SCALED ? rinv[row0 + ai * HALF + m * 16] : 1.0f;
#pragma unroll
                for (int bj = 0; bj < 2; ++bj) rb[m][bj] = __builtin_nontemporal_load((const u32x4*)(res + off + 8 * bj)); }
#pragma unroll
            for (int m = 0; m < 4; ++m) { const size_t off = (size_t)(row0 + ai * HALF + m * 16) * D + col0; u32x4 q;
#pragma unroll
                for (int bj = 0; bj < 2; ++bj) { float f[8]; unpack8(rb[m][bj], f);
                    if (SCALED) {
#pragma unroll
                        for (int e = 0; e < 8; ++e) f[e] = f[e] * ri[m] * gi[bj][e]; }
                    const f32x4 o0 = (f32x4){f[0], f[1], f[2], f[3]} + acc[ai][bj][m][0], o1 = (f32x4){f[4], f[5], f[6], f[7]} + acc[ai][bj][m][1];
                    *(u32x4*)(X + off + 8 * bj) = pack_rows(o0, o1);
                    q[2 * bj] = pk4_fp8(2.f * o0[0], 2.f * o0[1], 2.f * o0[2], 2.f * o0[3]); q[2 * bj + 1] = pk4_fp8(2.f * o1[0], 2.f * o1[1], 2.f * o1[2], 2.f * o1[3]); }
                *(u32x4*)(XQ + off) = q; }
        }
    }
};
struct EpiG3 {
    static constexpr bool WIDE = false;
    const float* lrs; unsigned char* H;
    __device__ __forceinline__ void operator()(const f32x4 (&acc)[2][2][4][2], const Unit& u, int wr, int wc, int fr, int fq, const LAS float* sct) const {
        float scv[2][4];
#pragma unroll
        for (int ai = 0; ai < 2; ++ai)
#pragma unroll
            for (int m = 0; m < 4; ++m) { const int r = ai * HALF + wr * 64 + m * 16 + fr; scv[ai][m] = sct[r]; }
#pragma unroll
        for (int ai = 0; ai < 2; ++ai)
#pragma unroll
            for (int m = 0; m < 4; ++m) { const int r = ai * HALF + wr * 64 + m * 16 + fr;
                if (r < u.nrows) { const float sc = scv[ai][m] * (1.0f / 64.0f); f32x4 o[2];
#pragma unroll
                    for (int n = 0; n < 2; ++n)
#pragma unroll
                        for (int j = 0; j < 4; ++j) o[n][j] = 4.0f * silu(sc * acc[ai][0][m][n][j]) * (sc * acc[ai][1][m][n][j]);
                    u32x2 q; q.x = pk4_fp8(o[0][0], o[0][1], o[0][2], o[0][3]); q.y = pk4_fp8(o[1][0], o[1][1], o[1][2], o[1][3]);
                    *(u32x2*)(H + (size_t)(u.slot0 + r) * F + u.pn * 128 + wc * 32 + 8 * fq) = q; } }
    }
};
struct EpiG4 {
    static constexpr bool WIDE = true;
    const float* lgate; unsigned char* YS;
    __device__ __forceinline__ void operator()(const f32x4 (&acc)[2][2][4][2], const Unit& u, int wr, int wc, int fr, int fq, const LAS float* sct) const {
        float gv[2][4];
#pragma unroll
        for (int ai = 0; ai < 2; ++ai)
#pragma unroll
            for (int m = 0; m < 4; ++m) { const int r = ai * HALF + wr * 64 + m * 16 + fr; gv[ai][m] = sct[r]; }
#pragma unroll
        for (int ai = 0; ai < 2; ++ai)
#pragma unroll
            for (int m = 0; m < 4; ++m) { const int r = ai * HALF + wr * 64 + m * 16 + fr;
                if (r < u.nrows) { const float g = gv[ai][m] * (16.0f / 128.0f);
                    u32x4 q;
#pragma unroll
                    for (int bj = 0; bj < 2; ++bj) { const f32x4 o0 = acc[ai][bj][m][0] * g, o1 = acc[ai][bj][m][1] * g; q[2 * bj] = pk4_fp8(o0[0], o0[1], o0[2], o0[3]); q[2 * bj + 1] = pk4_fp8(o1[0], o1[1], o1[2], o1[3]); }
                    *(u32x4*)(YS + (size_t)(u.slot0 + r) * D + u.pn * BM + wc * 64 + 16 * fq) = q; } }
    }
};
struct EpiG5 {
    static constexpr bool WIDE = true;
    const float* rs; const float* bias; bf16_t* UV; f32x2* lnp;
    __device__ __forceinline__ void operator()(const f32x4 (&acc)[2][2][4][2], const Unit& u, int wr, int wc, int fr, int fq, const LAS float* sct) const {
        const int row0 = u.pm * BM + wr * 64 + fr, col0 = u.pn * BM + wc * 64 + 16 * fq;
        f32x4 bv[2][2];
#pragma unroll
        for (int bj = 0; bj < 2; ++bj)
#pragma unroll
            for (int n = 0; n < 2; ++n) bv[bj][n] = *(const f32x4*)(bias + col0 + 8 * bj + 4 * n);
        float scv[2][4];
#pragma unroll
        for (int ai = 0; ai < 2; ++ai)
#pragma unroll
            for (int m = 0; m < 4; ++m) scv[ai][m] = rs[row0 + ai * HALF + m * 16];
#pragma unroll
        for (int ai = 0; ai < 2; ++ai)
#pragma unroll
            for (int m = 0; m < 4; ++m) { const int row = row0 + ai * HALF + m * 16; const float sc = scv[ai][m];
                float ps = 0.f, pq = 0.f;
#pragma unroll
                for (int bj = 0; bj < 2; ++bj) { f32x4 o[2];
#pragma unroll
                    for (int n = 0; n < 2; ++n)
#pragma unroll
                        for (int j = 0; j < 4; ++j) { o[n][j] = gelu_tanh(sc * acc[ai][bj][m][n][j] + bv[bj][n][j]); ps += o[n][j]; pq += o[n][j] * o[n][j]; }
                    *(u32x4*)(UV + (u.pn >= 4 ? (size_t)T * D : (size_t)0) + (size_t)row * D + (col0 & (D - 1)) + 8 * bj) = pack_rows(o[0], o[1]); }
                if (u.pn >= 4) { ps += __shfl_xor(ps, 16); ps += __shfl_xor(ps, 32); pq += __shfl_xor(pq, 16); pq += __shfl_xor(pq, 32);
                    if (fq == 0) lnp[(size_t)row * 16 + (u.pn - 4) * 4 + wc] = (f32x2){ps, pq}; } }
    }
};

struct Part { int base_row, nrows, j, nb; };
__device__ __forceinline__ void ph_prep_x(const float* __restrict__ x, const float* __restrict__ g, bf16_t* __restrict__ xn, float* __restrict__ rinv) {
    const int tid = phase_tid(), lane = tid & 63, gw = ((int)blockIdx.x * NT + tid) >> 6, ngw = ((int)gridDim.x * NT) >> 6;
    f32x4 gv[4];
#pragma unroll
    for (int j = 0; j < 4; ++j) gv[j] = ((const f32x4*)g)[lane + 64 * j];
    for (int row = gw; row < T; row += 2 * ngw) {
        const int row2 = row + ngw;
        const bool has2 = row2 < T;
        const f32x4* xr = (const f32x4*)(x + (size_t)row * D) + lane; const f32x4* xr2 = (const f32x4*)(x + (size_t)(has2 ? row2 : row) * D) + lane;
        f32x4 v[4], w[4]; float s = 0.f, s2 = 0.f;
#pragma unroll
        for (int j = 0; j < 4; ++j) { v[j] = __builtin_nontemporal_load(xr + 64 * j); w[j] = __builtin_nontemporal_load(xr2 + 64 * j); }
#pragma unroll
        for (int j = 0; j < 4; ++j) { s += (v[j].x * v[j].x + v[j].y * v[j].y) + (v[j].z * v[j].z + v[j].w * v[j].w); s2 += (w[j].x * w[j].x + w[j].y * w[j].y) + (w[j].z * w[j].z + w[j].w * w[j].w); }
        const float r = rsqrtf(wave_sum(s) * (1.0f / D) + EPS), r2 = rsqrtf(wave_sum(s2) * (1.0f / D) + EPS);
        if (lane == 0) { rinv[row] = 1.0f / r; if (has2) rinv[row2] = 1.0f / r2; }
        u32x2* o = (u32x2*)(xn + (size_t)row * D) + lane; u32x2* o2 = (u32x2*)(xn + (size_t)row2 * D) + lane;
#pragma unroll
        for (int j = 0; j < 4; ++j) { u32x2 q; q.x = pk2(v[j].x * r * gv[j].x, v[j].y * r * gv[j].y); q.y = pk2(v[j].z * r * gv[j].z, v[j].w * r * gv[j].w); o[64 * j] = q; }
        if (has2) {
#pragma unroll
            for (int j = 0; j < 4; ++j) { u32x2 q; q.x = pk2(w[j].x * r2 * gv[j].x, w[j].y * r2 * gv[j].y); q.y = pk2(w[j].z * r2 * gv[j].z, w[j].w * r2 * gv[j].w); o2[64 * j] = q; } }
    }
}
__device__ __forceinline__ int map_row(int mapkind, int n) {
    if (mapkind == 0) return n;
    if (mapkind == 1) { if (n < D) return 2 * D + n; const int ch = (n - D) & (D - 1), second = (n >= 2 * D); return 256 * (ch >> 7) + 128 * second + (ch & 127); }
    return 256 * (n >> 7) + (mapkind == 3 ? 128 : 0) + (n & 127);
}
struct TrItem { const float* src; int k0, n0; };
__device__ __forceinline__ void tr_load(const float* __restrict__ W, int N, int item, int lane, f32x4 (&v)[16]) {
    const int nblk = N / 64, kb = item / nblk, nb = item % nblk, k0 = 64 * kb, n0 = 64 * nb, kq = lane >> 4, nn = 4 * (lane & 15);
#pragma unroll
    for (int i = 0; i < 16; ++i) v[i] = __builtin_nontemporal_load((const f32x4*)(W + (size_t)(k0 + 4 * i + kq) * N + n0 + nn));
}
template <bool FP8OUT> __device__ __forceinline__ void tr_process(const f32x4 (&v)[16], int K, int N, void* __restrict__ WTv, int mapkind, const float* __restrict__ kscale, LAS float* scr, int item, int lane) {
    const int nblk = N / 64, kb = item / nblk, nb = item % nblk, k0 = 64 * kb, n0 = 64 * nb, kq = lane >> 4, nn = 4 * (lane & 15);
#pragma unroll
    for (int i = 0; i < 16; ++i) { const int kk = 4 * i + kq; const float sc = (kscale ? kscale[k0 + kk] : 1.0f) * (FP8OUT ? 32.0f : 1.0f); LAS float* d = scr + kk * 65 + nn;
        d[0] = v[i].x * sc; d[1] = v[i].y * sc; d[2] = v[i].z * sc; d[3] = v[i].w * sc; }
    LDS_WAIT();
    if constexpr (!FP8OUT) {
        bf16_t* WT = (bf16_t*)WTv; const int c = lane & 7;
#pragma unroll
        for (int j = 0; j < 8; ++j) { const int n = (lane >> 3) + 8 * j; const LAS float* sp = scr + (8 * c) * 65 + n;
            u32x4 o; o.x = pk2(sp[0 * 65], sp[1 * 65]); o.y = pk2(sp[2 * 65], sp[3 * 65]); o.z = pk2(sp[4 * 65], sp[5 * 65]); o.w = pk2(sp[6 * 65], sp[7 * 65]);
            *(u32x4*)(WT + (size_t)map_row(mapkind, n0 + n) * K + k0 + 8 * c) = o; }
    } else {
        unsigned char* WT = (unsigned char*)WTv; const int c = lane & 3;
#pragma unroll
        for (int j = 0; j < 4; ++j) { const int n = (lane >> 2) + 16 * j; const LAS float* sp = scr + (16 * c) * 65 + n;
            u32x4 o; o.x = pk4_fp8(sp[0 * 65], sp[1 * 65], sp[2 * 65], sp[3 * 65]); o.y = pk4_fp8(sp[4 * 65], sp[5 * 65], sp[6 * 65], sp[7 * 65]);
            o.z = pk4_fp8(sp[8 * 65], sp[9 * 65], sp[10 * 65], sp[11 * 65]); o.w = pk4_fp8(sp[12 * 65], sp[13 * 65], sp[14 * 65], sp[15 * 65]);
            *(u32x4*)(WT + (size_t)map_row(mapkind, n0 + n) * K + k0 + 16 * c) = o; }
    }
    LDS_WAIT();
}
template <bool FP8OUT> __device__ __forceinline__ void ph_transpose(LAS unsigned char* lds, const float* W, int K, int N, void* WT, int mapkind, const float* kscale, int nbatch, size_t sstride, size_t dstride, int shift = 0) {
    const int tid = phase_tid(), lane = tid & 63, wave = tid >> 6, ngw = (int)gridDim.x * NWAVES, gw = ((int)blockIdx.x * NWAVES + wave + ngw - (shift % ngw)) % ngw;
    LAS float* scr = (LAS float*)(lds + wave * 16640);
    const int per = (K / 64) * (N / 64), nitems = per * nbatch;
    f32x4 v[16], vn[16];
    int it = gw;
    if (it < nitems) tr_load(W + (size_t)(it / per) * sstride, N, it % per, lane, v);
    while (it < nitems) {
        const int nx = it + ngw;
        if (nx < nitems) tr_load(W + (size_t)(nx / per) * sstride, N, nx % per, lane, vn);
        tr_process<FP8OUT>(v, K, N, (unsigned char*)WT + (size_t)(it / per) * dstride * (FP8OUT ? 1 : 2), mapkind, kscale, scr, it % per, lane);
#pragma unroll
        for (int i = 0; i < 16; ++i) v[i] = vn[i];
        it = nx;
    }
}
__device__ __forceinline__ void ph_prep_experts(LAS unsigned char* lds, int layer, const float* w_gate, const float* w_up, const float* w_down, const float* ln2, unsigned char* WGU, unsigned char* WD) {
    ph_transpose<true>(lds, w_gate + (size_t)layer * NE * D * F, D, F, WGU, 2, ln2 + layer * D, NE, (size_t)D * F, (size_t)1024 * D);
    ph_transpose<true>(lds, w_up + (size_t)layer * NE * D * F, D, F, WGU, 3, ln2 + layer * D, NE, (size_t)D * F, (size_t)1024 * D);
    ph_transpose<true>(lds, w_down + (size_t)layer * NE * F * D, F, D, WD, 0, nullptr, NE, (size_t)F * D, (size_t)D * F);
}
__device__ __forceinline__ void ph_prep_router(const float* __restrict__ ln2, const float* __restrict__ wg, const float* __restrict__ we, bf16_t* __restrict__ wr) {
    for (int i = (int)blockIdx.x * NT + phase_tid(); i < 2 * 48 * D; i += (int)gridDim.x * NT) {
        const int l = i / (48 * D), j = (i / D) % 48, k = i % D;
        float w = 0.f;
        if (j < 4) w = wg[((size_t)l * D + k) * NG + j]; else if (j < 36) w = we[((size_t)l * D + k) * NE + (j - 4)];
        w *= ln2[l * D + k];
        const unsigned hi = f2bf(w); const unsigned lo = f2bf(w - bf2f(hi));
        wr[((size_t)l * 2 + 0) * 48 * D + (size_t)j * D + k] = (bf16_t)hi; wr[((size_t)l * 2 + 1) * 48 * D + (size_t)j * D + k] = (bf16_t)lo;
    }
}
__device__ __forceinline__ void ph_prep_wm(const float* __restrict__ ws, bf16_t* __restrict__ wm) {
    for (int i = (int)blockIdx.x * NT + phase_tid(); i < NH * CHUNK * CHUNK; i += (int)gridDim.x * NT) { const int t = (i / CHUNK) % CHUNK, s = i % CHUNK; wm[i] = (bf16_t)f2bf(t >= s ? ws[i] : 0.f); }
}
__device__ __forceinline__ void ph_conv(const Part P, const bf16_t* __restrict__ ZB, const float* __restrict__ cw, bf16_t* __restrict__ Y) {
    constexpr int RB = 8;
    const int nitems = (P.nrows / RB) * (D / 8);
    for (int it = P.j * NT + phase_tid(); it < nitems; it += P.nb * NT) {
        const int cg8 = it & 127, rb = it >> 7, r0 = P.base_row + rb * RB, ch = cg8 * 8, t0 = r0 & (SEQ - 1);
        float w[3][8];
#pragma unroll
        for (int k = 0; k < 3; ++k)
#pragma unroll
            for (int i = 0; i < 8; ++i) w[k][i] = cw[k * D + ch + i];
        float zm2[8], zm1[8];
        if (t0 >= 2) { unpack8(__builtin_nontemporal_load((const u32x4*)(ZB + (size_t)(r0 - 2) * D + ch)), zm2); unpack8(__builtin_nontemporal_load((const u32x4*)(ZB + (size_t)(r0 - 1) * D + ch)), zm1); }
        else {
#pragma unroll
            for (int i = 0; i < 8; ++i) { zm2[i] = 0.f; zm1[i] = 0.f; } }
#pragma unroll
        for (int r = 0; r < RB; ++r) {
            float z[8], b[8], o[8];
            unpack8(__builtin_nontemporal_load((const u32x4*)(ZB + (size_t)(r0 + r) * D + ch)), z); unpack8(__builtin_nontemporal_load((const u32x4*)(ZB + (size_t)T * D + (size_t)(r0 + r) * D + ch)), b);
#pragma unroll
            for (int i = 0; i < 8; ++i) { o[i] = b[i] * (w[0][i] * zm2[i] + w[1][i] * zm1[i] + w[2][i] * z[i]); zm2[i] = zm1[i]; zm1[i] = z[i]; }
            *(u32x4*)(Y + (size_t)(r0 + r) * D + ch) = pack8(o);
        }
    }
}
__device__ __forceinline__ void ph_route(const Part P, LAS unsigned char* lds, const bf16_t* __restrict__ X, const bf16_t* __restrict__ wrh, const float* __restrict__ bg, const float* __restrict__ be,
                                         unsigned* __restrict__ cnt, unsigned* __restrict__ asg, int* __restrict__ ltok, float* __restrict__ lgate, float* __restrict__ lrs) {
    const int tid = phase_tid(), wave = tid >> 6, lane = tid & 63, fr = lane & 15, fq = lane >> 4;
    LAS float* lgs = (LAS float*)(lds + wave * 4096);
    LAS int* s_e = (LAS int*)(lds + 32768); LAS float* s_g = (LAS float*)(lds + 32768 + 1024); LAS float* s_r = (LAS float*)(lds + 32768 + 2048);
    LAS unsigned* s_cnt = (LAS unsigned*)(lds + 32768 + 3072); LAS unsigned* s_base = (LAS unsigned*)(lds + 32768 + 3200); LAS unsigned* s_rank = (LAS unsigned*)(lds + 32768 + 3328);
    const bf16_t* wrl = wrh + 48 * D;
    for (int tbl = P.j * 128; tbl < P.nrows; tbl += P.nb * 128) {
        const int tb = P.base_row + tbl;
        if (tid < NE) s_cnt[tid] = 0u;
        const int tok0 = tb + wave * 16;
        f32x4 acc[3]; float ss = 0.f;
#pragma unroll
        for (int n = 0; n < 3; ++n) acc[n] = (f32x4){0.f, 0.f, 0.f, 0.f};
        constexpr int WCH_PITCH = 272, WCH_BYTES = 2 * 48 * WCH_PITCH;
        LAS unsigned char* wbuf = lds + 49152;
        u32x4 wreg[3], araw[4];
#pragma unroll
        for (int p = 0; p < 3; ++p) { const int pc = tid + 512 * p, hl = pc / 768, row = (pc % 768) >> 4, kc = pc & 15; wreg[p] = *(const u32x4*)(wrh + (size_t)hl * 48 * D + (size_t)row * D + kc * 8); }
#pragma unroll
        for (int q = 0; q < 4; ++q) araw[q] = *(const u32x4*)(X + (size_t)(tok0 + fr) * D + q * 32 + fq * 8);
#pragma unroll 1
        for (int kb = 0; kb < D / 128; ++kb) {
            LAS unsigned char* wb = wbuf + (kb & 1) * WCH_BYTES;
#pragma unroll
            for (int p = 0; p < 3; ++p) { const int pc = tid + 512 * p, hl = pc / 768, row = (pc % 768) >> 4, kc = pc & 15; *(LAS u32x4*)(wb + (hl * 48 + row) * WCH_PITCH + kc * 16) = wreg[p]; }
            u32x4 acur[4];
#pragma unroll
            for (int q = 0; q < 4; ++q) acur[q] = araw[q];
            __syncthreads();
            if (kb + 1 < D / 128) {
#pragma unroll
                for (int p = 0; p < 3; ++p) { const int pc = tid + 512 * p, hl = pc / 768, row = (pc % 768) >> 4, kc = pc & 15; wreg[p] = *(const u32x4*)(wrh + (size_t)hl * 48 * D + (size_t)row * D + (kb + 1) * 128 + kc * 8); }
#pragma unroll
                for (int q = 0; q < 4; ++q) araw[q] = *(const u32x4*)(X + (size_t)(tok0 + fr) * D + ((kb + 1) * 4 + q) * 32 + fq * 8);
            }
#pragma unroll
            for (int q = 0; q < 4; ++q) {
                float af[8]; unpack8(acur[q], af);
#pragma unroll
                for (int e = 0; e < 8; ++e) ss += af[e] * af[e];
                const bf16x8 a = __builtin_bit_cast(bf16x8, acur[q]);
#pragma unroll
                for (int n = 0; n < 3; ++n) {
                    const bf16x8 bh = *(const LAS bf16x8*)(wb + (n * 16 + fr) * WCH_PITCH + (q * 32 + fq * 8) * 2);
                    const bf16x8 bl = *(const LAS bf16x8*)(wb + (48 + n * 16 + fr) * WCH_PITCH + (q * 32 + fq * 8) * 2);
                    acc[n] = __builtin_amdgcn_mfma_f32_16x16x32_bf16(a, bh, acc[n], 0, 0, 0); acc[n] = __builtin_amdgcn_mfma_f32_16x16x32_bf16(a, bl, acc[n], 0, 0, 0); }
            }
        }
        __syncthreads();
        ss += __shfl_xor(ss, 16); ss += __shfl_xor(ss, 32);
#pragma unroll
        for (int n = 0; n < 3; ++n)
#pragma unroll
            for (int j = 0; j < 4; ++j) lgs[(fq * 4 + j) * 49 + n * 16 + fr] = acc[n][j];
        if (fq == 0) lgs[16 * 49 + fr] = rsqrtf(ss * (1.0f / D) + EPS);
        LDS_WAIT();
        if (lane < 16) {
            const float r = lgs[16 * 49 + lane]; const LAS float* L = lgs + lane * 49;
            float lg[36];
#pragma unroll
            for (int j = 0; j < 36; ++j) lg[j] = L[j] * r + (j < 4 ? bg[j] : be[j - 4]);
            int gi = 0; float gm = lg[0];
#pragma unroll
            for (int j = 1; j < 4; ++j) if (lg[j] > gm) { gm = lg[j]; gi = j; }
            float gs = 0.f;
#pragma unroll
            for (int j = 0; j < 4; ++j) gs += __expf(lg[j] - gm);
            const float gp = 1.0f / gs;
            float el[8];
#pragma unroll
            for (int j = 0; j < 8; ++j) { el[j] = lg[4 + j];
#pragma unroll
                for (int g = 1; g < 4; ++g) el[j] = (gi == g) ? lg[4 + g * 8 + j] : el[j]; }
            int i0 = 0; float m0 = el[0];
#pragma unroll
            for (int j = 1; j < 8; ++j) if (el[j] > m0) { m0 = el[j]; i0 = j; }
            int i1 = 0; float m1 = -3.0e38f;
#pragma unroll
            for (int j = 0; j < 8; ++j) if (j != i0 && el[j] > m1) { m1 = el[j]; i1 = j; }
            const float eb = __expf(m1 - m0), den = 1.0f / (1.0f + eb);
            const int tl = wave * 16 + lane;
            s_e[2 * tl] = gi * 8 + i0; s_e[2 * tl + 1] = gi * 8 + i1; s_g[2 * tl] = gp * den; s_g[2 * tl + 1] = gp * eb * den; s_r[tl] = r;
        }
        __syncthreads();
        if (tid < 256) s_rank[tid] = atomicAdd((unsigned*)&s_cnt[s_e[tid]], 1u);
        __syncthreads();
        if (tid < NE) s_base[tid] = s_cnt[tid] ? atomicAdd(&cnt[tid], s_cnt[tid]) : 0u;
        __syncthreads();
        if (tid < 256) { const int e = s_e[tid], tok = tb + (tid >> 1); const unsigned pos = s_base[e] + s_rank[tid];
            ltok[(size_t)e * T + pos] = tok; lgate[(size_t)e * T + pos] = s_g[tid]; lrs[(size_t)e * T + pos] = s_r[tid >> 1];
            asg[(size_t)tok * 4 + (tid & 1) * 2] = ((unsigned)e << 24) | pos; asg[(size_t)tok * 4 + (tid & 1) * 2 + 1] = __float_as_uint(s_g[tid]); }
        __syncthreads();
    }
}
__device__ __forceinline__ int build_tile_table(LAS unsigned char* lds, const unsigned* __restrict__ cnt) {
    LAS int* tab = (LAS int*)(lds + TAB_OFF); LAS int* tabn = (LAS int*)(lds + TABN_OFF);
    const int tid = phase_tid();
    if (tid < NE) {
        int bacc = 0, sacc_small = 0, sacc = 0, mine = 0, nbig_all = 0, nsmall_all = 0;
        for (int e = 0; e < NE; ++e) { const int n = (int)cnt[e], full = n / BM, rem = n % BM, nb = full + (rem > HALF ? 1 : 0), ns = (rem > 0 && rem <= HALF) ? 1 : 0;
            if (e == tid) mine = n; if (e < tid) { bacc += nb; sacc_small += ns; sacc += n; } nbig_all += nb; nsmall_all += ns; }
        const int full = mine / BM, rem = mine % BM, nb = full + (rem > HALF ? 1 : 0);
        for (int j = 0; j < nb; ++j) { const int ti = bacc + j; if (ti < TAB_MAX) { tab[ti * 4 + 0] = tid; tab[ti * 4 + 1] = j * BM; tab[ti * 4 + 2] = min(BM, mine - j * BM); tab[ti * 4 + 3] = sacc + j * BM; } }
        if (rem > 0 && rem <= HALF) { const int ti = nbig_all + sacc_small; if (ti < TAB_MAX) { tab[ti * 4 + 0] = tid; tab[ti * 4 + 1] = full * BM; tab[ti * 4 + 2] = rem; tab[ti * 4 + 3] = sacc + full * BM; } }
        if (tid == NE - 1) tabn[0] = min(nbig_all + nsmall_all, TAB_MAX);
    }
    __syncthreads();
    return __builtin_amdgcn_readfirstlane(tabn[0]);
}
template <bool FINAL> __device__ __forceinline__ void ph_combine(const Part P, const bf16_t* __restrict__ X, const unsigned char* __restrict__ YS, const unsigned* __restrict__ cnt, const unsigned* __restrict__ asg,
                                                                 bf16_t* __restrict__ Xo, float* __restrict__ rs, const float* __restrict__ g, float* __restrict__ out) {
    const int tid = phase_tid(), lane = tid & 63, gw = (P.j * NT + tid) >> 6, ngw = (P.nb * NT) >> 6;
    unsigned c = lane < NE ? cnt[lane] : 0u, inc = c;
#pragma unroll
    for (int o = 1; o < 32; o <<= 1) { const unsigned t = __shfl_up(inc, o); if (lane >= o) inc += t; }
    const unsigned excl = inc - c;
    for (int rowl = gw; rowl < P.nrows; rowl += 2 * ngw) {
        int rows[2]; rows[0] = P.base_row + rowl; rows[1] = (rowl + ngw < P.nrows) ? P.base_row + rowl + ngw : rows[0];
        unsigned sa[2], sb[2];
#pragma unroll
        for (int q = 0; q < 2; ++q) { const u32x4 cw = *(const u32x4*)(asg + (size_t)rows[q] * 4); sa[q] = __shfl(excl, (int)(cw.x >> 24)) + (cw.x & 0xffffffu); sb[q] = __shfl(excl, (int)(cw.z >> 24)) + (cw.z & 0xffffffu); }
        u32x4 xr[2][2]; u32x2 ar[2][2], br[2][2];
#pragma unroll
        for (int q = 0; q < 2; ++q)
#pragma unroll
            for (int h = 0; h < 2; ++h) { xr[q][h] = __builtin_nontemporal_load((const u32x4*)(X + (size_t)rows[q] * D + h * 512 + lane * 8)); ar[q][h] = __builtin_nontemporal_load((const u32x2*)(YS + (size_t)sa[q] * D + h * 512 + lane * 8)); br[q][h] = __builtin_nontemporal_load((const u32x2*)(YS + (size_t)sb[q] * D + h * 512 + lane * 8)); }
#pragma unroll
        for (int q = 0; q < 2; ++q) {
            if (q == 1 && rows[1] == rows[0]) break;
            const int row = rows[q];
            float v[16];
#pragma unroll
            for (int h = 0; h < 2; ++h) { float x8[8], a[8], b[8]; unpack8(xr[q][h], x8); unpack8_fp8(ar[q][h], a); unpack8_fp8(br[q][h], b);
#pragma unroll
                for (int i = 0; i < 8; ++i) v[h * 8 + i] = x8[i] + (a[i] + b[i]) * (1.0f / 16.0f); }
            if (!FINAL) {
                float ss = 0.f;
#pragma unroll
                for (int h = 0; h < 2; ++h) { float o8[8];
#pragma unroll
                    for (int i = 0; i < 8; ++i) { o8[i] = bf2f(f2bf(v[h * 8 + i])); ss += o8[i] * o8[i]; }
                    *(u32x4*)(Xo + (size_t)row * D + h * 512 + lane * 8) = pack8(o8); }
                const float r = rsqrtf(wave_sum(ss) * (1.0f / D) + EPS);
                if (lane == 0) rs[row] = r;
            } else {
                float ss = 0.f;
#pragma unroll
                for (int i = 0; i < 16; ++i) ss += v[i] * v[i];
                const float r = rsqrtf(wave_sum(ss) * (1.0f / D) + EPS);
#pragma unroll
                for (int h = 0; h < 2; ++h) { const f32x4 g0 = *(const f32x4*)(g + h * 512 + lane * 8), g1 = *(const f32x4*)(g + h * 512 + lane * 8 + 4);
                    f32x4 o0, o1; o0.x = v[h * 8 + 0] * r * g0.x; o0.y = v[h * 8 + 1] * r * g0.y; o0.z = v[h * 8 + 2] * r * g0.z; o0.w = v[h * 8 + 3] * r * g0.w;
                    o1.x = v[h * 8 + 4] * r * g1.x; o1.y = v[h * 8 + 5] * r * g1.y; o1.z = v[h * 8 + 6] * r * g1.z; o1.w = v[h * 8 + 7] * r * g1.w;
                    __builtin_nontemporal_store(o0, (f32x4*)(out + (size_t)row * D + h * 512 + lane * 8)); __builtin_nontemporal_store(o1, (f32x4*)(out + (size_t)row * D + h * 512 + lane * 8 + 4)); }
            }
        }
    }
}
constexpr int MIX_PITCH = 272, MIX_BUF = CHUNK * MIX_PITCH, MIX_STAT_OFF = 2 * MIX_BUF;
typedef short s16x4 __attribute__((ext_vector_type(4)));
__device__ __forceinline__ void ph_mix(const Part P, LAS unsigned char* lds, const bf16_t* __restrict__ UV, const f32x2* __restrict__ lnp, const float* __restrict__ vg, const float* __restrict__ vbeta,
                                       const bf16_t* __restrict__ wm, const float* __restrict__ bs, bf16_t* __restrict__ YM) {
    const int tid = phase_tid(), wave = tid >> 6, lane = tid & 63, fr = lane & 15, fq = lane >> 4, wt = wave >> 1, wd = wave & 1;
    LAS float* stat = (LAS float*)(lds + MIX_STAT_OFF);
    const int ch = tid & 15, srow = tid >> 4;
    const int cgrp = ch >> 2, ca = ch & 3;
    for (int bcl = P.j; bcl < P.nrows / CHUNK; bcl += P.nb) {
        const int row0 = P.base_row + bcl * CHUNK;
        if (tid < CHUNK) { const f32x4* pp = (const f32x4*)(lnp + (size_t)(row0 + tid) * 16); float sm = 0.f, sq = 0.f;
#pragma unroll
            for (int i = 0; i < 8; ++i) { const f32x4 pv = pp[i]; sm += pv.x + pv.z; sq += pv.y + pv.w; }
            const float mu = sm * (1.0f / D), var = fmaxf(sq * (1.0f / D) - mu * mu, 0.f);
            stat[2 * tid] = mu; stat[2 * tid + 1] = rsqrtf(var + EPS); }
        __syncthreads();
        u32x4 vraw[4];
#pragma unroll
        for (int p = 0; p < 4; ++p) vraw[p] = __builtin_nontemporal_load((const u32x4*)(UV + (size_t)T * D + (size_t)(row0 + srow + 32 * p) * D + 0 * 128 + 8 * ch));
#pragma unroll 1
        for (int h = 0; h < NH; ++h) {
            LAS unsigned char* buf = lds + (h & 1) * MIX_BUF;
            float g8[8], b8[8];
            { const f32x4 ga = *(const f32x4*)(vg + h * 128 + 8 * ch), gb = *(const f32x4*)(vg + h * 128 + 8 * ch + 4), ba = *(const f32x4*)(vbeta + h * 128 + 8 * ch), bb = *(const f32x4*)(vbeta + h * 128 + 8 * ch + 4);
              g8[0] = ga.x; g8[1] = ga.y; g8[2] = ga.z; g8[3] = ga.w; g8[4] = gb.x; g8[5] = gb.y; g8[6] = gb.z; g8[7] = gb.w;
              b8[0] = ba.x; b8[1] = ba.y; b8[2] = ba.z; b8[3] = ba.w; b8[4] = bb.x; b8[5] = bb.y; b8[6] = bb.z; b8[7] = bb.w; }
#pragma unroll
            for (int p = 0; p < 4; ++p) { const int sr = srow + 32 * p; float v[8]; unpack8(vraw[p], v);
                const float mu = stat[2 * sr], rstd = stat[2 * sr + 1];
#pragma unroll
                for (int q = 0; q < 8; ++q) v[q] = (v[q] - mu) * rstd * g8[q] + b8[q];
                u32x2 lo, hi; lo.x = pk2(v[0], v[1]); lo.y = pk2(v[2], v[3]); hi.x = pk2(v[4], v[5]); hi.y = pk2(v[6], v[7]);
                *(LAS u32x2*)(buf + sr * MIX_PITCH + (32 * cgrp + 4 * ca) * 2) = lo; *(LAS u32x2*)(buf + sr * MIX_PITCH + (32 * cgrp + 16 + 4 * ca) * 2) = hi; }
            __syncthreads();
            if (h + 1 < NH) {
#pragma unroll
                for (int p = 0; p < 4; ++p) vraw[p] = __builtin_nontemporal_load((const u32x4*)(UV + (size_t)T * D + (size_t)(row0 + srow + 32 * p) * D + (h + 1) * 128 + 8 * ch)); }
            u32x4 uraw[2][2]; float bsv[2];
#pragma unroll
            for (int m = 0; m < 2; ++m) { const int t = 32 * wt + 16 * m + fr; bsv[m] = bs[h * CHUNK + t];
#pragma unroll
                for (int cc = 0; cc < 2; ++cc) uraw[m][cc] = __builtin_nontemporal_load((const u32x4*)(UV + (size_t)(row0 + t) * D + h * 128 + 32 * (2 * wd + cc) + 8 * fq)); }
            bf16x8 af[4][2];
#pragma unroll
            for (int kk = 0; kk < 4; ++kk)
#pragma unroll
                for (int m = 0; m < 2; ++m) af[kk][m] = *(const bf16x8*)(wm + ((size_t)(h * CHUNK + 32 * wt + 16 * m + fr)) * CHUNK + 32 * (kk <= wt ? kk : wt) + 8 * fq);
            f32x4 acc[2][4];
#pragma unroll
            for (int m = 0; m < 2; ++m)
#pragma unroll
                for (int n = 0; n < 4; ++n) acc[m][n] = (f32x4){0.f, 0.f, 0.f, 0.f};
            const int q4 = (lane & 15) >> 2, p4 = lane & 3;
#pragma unroll
            for (int kk = 0; kk < 4; ++kk) {
                if (kk <= wt) {
#pragma unroll
                    for (int n = 0; n < 4; ++n) {
                        const int colpos = 32 * (2 * wd + (n >> 1)) + 16 * (n & 1);
                        LAS unsigned char* base = buf + (32 * kk + 8 * fq + q4) * MIX_PITCH + colpos * 2 + 8 * p4;
                        const s16x4 t0 = __builtin_amdgcn_ds_read_tr16_b64_v4i16((LAS s16x4*)base);
                        const s16x4 t1 = __builtin_amdgcn_ds_read_tr16_b64_v4i16((LAS s16x4*)(base + 4 * MIX_PITCH));
                        bf16x8 bfrag; bfrag[0] = t0[0]; bfrag[1] = t0[1]; bfrag[2] = t0[2]; bfrag[3] = t0[3]; bfrag[4] = t1[0]; bfrag[5] = t1[1]; bfrag[6] = t1[2]; bfrag[7] = t1[3];
#pragma unroll
                        for (int m = 0; m < 2; ++m) acc[m][n] = __builtin_amdgcn_mfma_f32_16x16x32_bf16(bfrag, af[kk][m], acc[m][n], 0, 0, 0);
                    }
                }
            }
#pragma unroll
            for (int m = 0; m < 2; ++m) { const int t = 32 * wt + 16 * m + fr;
#pragma unroll
                for (int cc = 0; cc < 2; ++cc) { const int col = h * 128 + 32 * (2 * wd + cc) + 8 * fq; float u8[8], o8[8];
                    unpack8(uraw[m][cc], u8);
#pragma unroll
                    for (int n = 0; n < 2; ++n)
#pragma unroll
                        for (int r = 0; r < 4; ++r) o8[4 * n + r] = u8[4 * n + r] * (acc[m][2 * cc + n][r] + bsv[m]);
                    *(u32x4*)(YM + (size_t)(row0 + t) * D + col) = pack8(o8); } }
        }
        __syncthreads();
    }
}

#define XB_TMO      128
#define XB_XCNT(j)  (256  + 64 * (j))
#define XB_XSUB(j)  (1280 + 64 * (j))
#define XB_XGEN(j)  (2304 + 64 * (j))
#define XB_TOP      3328
#define XB_TOPGEN   3392
#define XCD_BAR_WORDS 3456
#define XB_SPIN_CAP (1u << 22)
__device__ __forceinline__ unsigned xb_ld(unsigned* p)              { return __hip_atomic_load(p, __ATOMIC_RELAXED, __HIP_MEMORY_SCOPE_AGENT); }
__device__ __forceinline__ unsigned xb_add(unsigned* p, unsigned v) { return __hip_atomic_fetch_add(p, v, __ATOMIC_RELAXED, __HIP_MEMORY_SCOPE_AGENT); }
__device__ __forceinline__ unsigned xb_xcc_id() { return (unsigned)__builtin_amdgcn_s_getreg((3 << 11) | 20) & 0xFu; }
#define XB_SPIN(cond, bar) do { unsigned _sp = 0; while (cond) { __builtin_amdgcn_s_sleep(1); \
    if ((++_sp & 255u) == 0u) { if (xb_ld(&(bar)[XB_TMO])) break; if (_sp > XB_SPIN_CAP) { atomicAdd(&(bar)[XB_TMO], 1u); break; } } } } while (0)
struct XcdBarrier { unsigned* bar; unsigned x; volatile LAS unsigned* st; };
__device__ __forceinline__ XcdBarrier xcd_barrier_post(unsigned* bar, volatile LAS unsigned* st) {
    XcdBarrier b; b.bar = bar; b.x = xb_xcc_id(); b.st = st;
    if (threadIdx.x == 0) st[2] = xb_add(&bar[XB_XCNT(b.x)], 1u);
    return b;
}
__device__ __forceinline__ void xcd_barrier_complete(unsigned* bar, unsigned x, unsigned& nloc, unsigned& nx) {
    const unsigned G = gridDim.x * gridDim.y * gridDim.z;
    unsigned sum, cnt, mine, sp = 0u;
    for (;;) {
        sum = 0u; cnt = 0u; mine = 0u;
#pragma unroll
        for (unsigned j = 0; j < 16; ++j) { const unsigned c = xb_ld(&bar[XB_XCNT(j)]); sum += c; cnt += (c > 0u) ? 1u : 0u; mine = (j == x) ? c : mine; }
        if (sum == G) break;
        __builtin_amdgcn_s_sleep(1);
        if ((++sp & 255u) == 0u) { if (xb_ld(&bar[XB_TMO])) break; if (sp > XB_SPIN_CAP) { atomicAdd(&bar[XB_TMO], 1u); break; } }
    }
    nloc = mine > 0u ? mine : 1u; nx = cnt > 0u ? cnt : 1u;
}
__device__ __forceinline__ void xcd_barrier(const XcdBarrier& b) {
    asm volatile("s_waitcnt vmcnt(0)" ::: "memory");
    __syncthreads();
    if (threadIdx.x == 0) {
        unsigned* bar = b.bar;
        __builtin_amdgcn_s_waitcnt(0);
        unsigned nloc = b.st[0], nx = b.st[1];
        if (nloc == 0u) { xcd_barrier_complete(bar, b.x, nloc, nx); b.st[0] = nloc; b.st[1] = nx; }
        const unsigned old = xb_add(&bar[XB_XSUB(b.x)], 1u);
        const unsigned gen = old / nloc;
        if (old + 1u == (gen + 1u) * nloc) {
            __builtin_amdgcn_fence(__ATOMIC_RELEASE, "agent");
            asm volatile("s_waitcnt vmcnt(0)" ::: "memory");
            const unsigned og = xb_add(&bar[XB_TOP], 1u);
            const unsigned tg = og / nx;
            if (og + 1u == (tg + 1u) * nx) xb_add(&bar[XB_TOPGEN], 1u);
            else XB_SPIN(xb_ld(&bar[XB_TOPGEN]) == tg, bar);
            __builtin_amdgcn_fence(__ATOMIC_ACQUIRE, "agent");
            xb_add(&bar[XB_XGEN(b.x)], 1u);
            asm volatile("s_waitcnt vmcnt(0)" ::: "memory");
        } else {
            XB_SPIN(xb_ld(&bar[XB_XGEN(b.x)]) == gen, bar);
            __builtin_amdgcn_fence(__ATOMIC_ACQUIRE, "agent");
            asm volatile("s_waitcnt vmcnt(0)" ::: "memory");
        }
    }
    __syncthreads();
}

#define XB_LSUB(j)  (3520 + 64 * (j))
#define XB_LGEN(j)  (4544 + 64 * (j))
__device__ __forceinline__ void xcd_local_barrier(const XcdBarrier& b, const unsigned nloc) {
    asm volatile("s_waitcnt vmcnt(0)" ::: "memory");
    __syncthreads();
    if (threadIdx.x == 0) {
        unsigned* bar = b.bar;
        __builtin_amdgcn_s_waitcnt(0);
        const unsigned old = xb_add(&bar[XB_LSUB(b.x)], 1u);
        const unsigned gen = old / nloc;
        if (old + 1u == (gen + 1u) * nloc) xb_add(&bar[XB_LGEN(b.x)], 1u);
        else XB_SPIN(xb_ld(&bar[XB_LGEN(b.x)]) == gen, bar);
        __builtin_amdgcn_fence(__ATOMIC_ACQUIRE, "agent");
        asm volatile("s_waitcnt vmcnt(0)" ::: "memory");
    }
    __syncthreads();
}

#define GSYNC() xcd_barrier(xbar)
struct Params { const float* in[22]; float* out; unsigned char* ws; };
__global__ void __launch_bounds__(NT, 2) mega_fwd(Params P) {
    extern __shared__ __attribute__((aligned(16))) unsigned char lds_raw[];
    LAS unsigned char* lds = (LAS unsigned char*)lds_raw;
    cg::grid_group grid = cg::this_grid();
    const int G = (int)gridDim.x, bid = (int)blockIdx.x;
    if (P.ws == nullptr) grid.sync();
    if (threadIdx.x < 4) ((LAS unsigned*)(lds + BARST_OFF))[threadIdx.x] = 0u;
    __syncthreads();
    const XcdBarrier xbar = xcd_barrier_post((unsigned*)(P.ws + WS_CTL) + CW_BAR, (volatile LAS unsigned*)(lds + BARST_OFF));
    const float* x = P.in[0]; const float* ln_a = P.in[1]; const float* w_in_a = P.in[2]; const float* conv_w = P.in[3];
    const float* w_out_a = P.in[4]; const float* ln_b = P.in[5]; const float* w_in_b = P.in[6]; const float* b_in_b = P.in[7];
    const float* v_ln_g = P.in[8]; const float* v_ln_b = P.in[9]; const float* w_s = P.in[10]; const float* b_s = P.in[11];
    const float* w_out_b = P.in[12]; const float* ln2 = P.in[13]; const float* w_group = P.in[14]; const float* b_group = P.in[15];
    const float* w_expert = P.in[16]; const float* b_expert = P.in[17]; const float* w_gate = P.in[18]; const float* w_up = P.in[19];
    const float* w_down = P.in[20]; const float* ln_f = P.in[21];
    unsigned char* ws = P.ws; float* out = P.out;
    unsigned* ctl = (unsigned*)(ws + WS_CTL); float* RS = (float*)(ws + WS_RS); unsigned* ASG = (unsigned*)(ws + WS_ASG); float* LNS = (float*)(ws + WS_LNS);
    int* LTOK = (int*)(ws + WS_LTOK); float* LGATE = (float*)(ws + WS_LGATE); float* LRS = (float*)(ws + WS_LRS); bf16_t* WR = (bf16_t*)(ws + WS_WR); bf16_t* WM = (bf16_t*)(ws + WS_WM);
    bf16_t* WA_IN = (bf16_t*)(ws + WS_WA_IN); bf16_t* WA_OUT = (bf16_t*)(ws + WS_WA_OUT); bf16_t* WB_IN = (bf16_t*)(ws + WS_WB_IN); bf16_t* WB_OUT = (bf16_t*)(ws + WS_WB_OUT);
    unsigned char* WGU = ws + WS_WGU; unsigned char* WD = ws + WS_WD; unsigned char* XQ = ws + WS_XQ;
    bf16_t* bufA = (bf16_t*)(ws + WS_A); bf16_t* bufB = (bf16_t*)(ws + WS_B); bf16_t* bufC = (bf16_t*)(ws + WS_C); bf16_t* bufD = (bf16_t*)(ws + WS_D);

    int vb = bid; bool loc = false; unsigned nloc = 1u;
    Part part{0, T, bid, G};
#define DENSE_GEMM(EPI_T, epi_init, Aptr, Bptr, NCOLS) do { DenseSched S{T / BM, (NCOLS) / BM, G, vb, D, (Bptr)}; EPI_T E epi_init; gemm_phase<EPI_T, DenseSched>(lds, (Aptr), D, S, E); } while (0)
#define LSYNC() do { if (loc) xcd_local_barrier(xbar, nloc); else xcd_barrier(xbar); } while (0)
#define MOE_PHASES(layer, Xin, Hb) do { \
        unsigned* cnt_ = ctl + CW_CNT + (layer) * NE; \
        ph_route(part, lds, (Xin), WR + (size_t)(layer) * 2 * 48 * D, b_group + (layer) * NG, b_expert + (layer) * NE, cnt_, ASG, LTOK, LGATE, LRS); \
        GSYNC(); \
        { const int ntm = build_tile_table(lds, cnt_); \
          { MoeSched<true> S{ntm, G, vb, D / 2, WGU, LTOK, (const LAS int*)(lds + TAB_OFF), LRS}; EpiG3 E{LRS, (unsigned char*)(Hb)}; gemm_phase<EpiG3, MoeSched<true>, true>(lds, (const bf16_t*)XQ, D / 2, S, E); } \
          LSYNC(); \
          { MoeSched<false> S{ntm, G, vb, F / 2, WD, LTOK, (const LAS int*)(lds + TAB_OFF), LGATE}; EpiG4 E{LGATE, (unsigned char*)bufA}; gemm_phase<EpiG4, MoeSched<false>, true>(lds, (const bf16_t*)(Hb), F / 2, S, E); } } \
        GSYNC(); } while (0)

    ph_prep_x(x, ln_a, bufB, RS);
    ph_transpose<false>(lds, w_in_a, D, 3 * D, WA_IN, 1, nullptr, 1, 0, 0, 0);
    ph_transpose<false>(lds, w_out_a, D, D, WA_OUT, 0, nullptr, 1, 0, 0, 768);
    ph_transpose<false>(lds, w_in_b, D, 2 * D, WB_IN, 0, ln_b, 1, 0, 0, 1024);
    ph_transpose<false>(lds, w_out_b, D, D, WB_OUT, 0, nullptr, 1, 0, 0, 1536);
    ph_prep_router(ln2, w_group, w_expert, WR);
    ph_prep_wm(w_s, WM);
    ph_prep_experts(lds, 0, w_gate, w_up, w_down, ln2, WGU, WD);
    GSYNC();
    {
        unsigned okc = 0u, bad = 0u;
#pragma unroll
        for (unsigned j = 0; j < 16; ++j) { const unsigned cn = xb_ld((unsigned*)(ws + WS_CTL) + CW_BAR + XB_XCNT(j)); if (cn == 32u && j < 8u) ++okc; else if (cn != 0u) ++bad; }
        const unsigned rank = ((volatile LAS unsigned*)(lds + BARST_OFF))[2];
        loc = (G == 256) && (okc == 8u) && (bad == 0u) && (xbar.x < 8u) && (rank < 32u);
        if (loc) { vb = (int)(rank * 8u + xbar.x); nloc = 32u; part = Part{(vb & 7) * SEQ, SEQ, vb >> 3, 32}; }
    }
    DENSE_GEMM(EpiG1, {bufA}, bufB, WA_IN, 3 * D);
    LSYNC();
    ph_conv(part, bufA, conv_w, bufC);
    LSYNC();
    DENSE_GEMM(EpiRes<true>, ({bufB, bufD, XQ, RS, ln_a}), bufC, WA_OUT, D);
    LSYNC();
    MOE_PHASES(0, bufD, bufB);
    ph_combine<false>(part, bufD, (const unsigned char*)bufA, ctl + CW_CNT, ASG, bufC, RS, nullptr, nullptr);
    ph_prep_experts(lds, 1, w_gate, w_up, w_down, ln2, WGU, WD);
    LSYNC();
    DENSE_GEMM(EpiG5, ({RS, b_in_b, bufA, (f32x2*)(ws + WS_LNP)}), bufC, WB_IN, 2 * D);
    LSYNC();
    ph_mix(part, lds, bufA, (const f32x2*)(ws + WS_LNP), v_ln_g, v_ln_b, WM, b_s, bufD);
    LSYNC();
    DENSE_GEMM(EpiRes<false>, ({bufC, bufB, XQ, nullptr, nullptr}), bufD, WB_OUT, D);
    LSYNC();
    MOE_PHASES(1, bufB, bufC);
    ph_combine<true>(part, bufB, (const unsigned char*)bufA, ctl + CW_CNT + NE, ASG, nullptr, nullptr, ln_f, out);
}
}

extern "C" void kernel_launch(void* const* d_in, const int* in_sizes, int n_in, void* d_out, int out_size, void* d_ws, size_t ws_size, hipStream_t stream) {
    if (n_in != 22 || ws_size < WS_END) { fprintf(stderr, "kernel_launch: unexpected n_in %d / ws_size %zu\n", n_in, ws_size); return; }
    static int grid_blocks = 0;
    if (!grid_blocks) {
        int dev = 0, cus = 0, per_cu = 0;
        (void)hipGetDevice(&dev);
        (void)hipDeviceGetAttribute(&cus, hipDeviceAttributeMultiprocessorCount, dev);
        (void)hipFuncSetAttribute((const void*)mega_fwd, hipFuncAttributeMaxDynamicSharedMemorySize, LDS_BYTES);
        (void)hipOccupancyMaxActiveBlocksPerMultiprocessor(&per_cu, (const void*)mega_fwd, NT, LDS_BYTES);
        if (per_cu < 1) fprintf(stderr, "kernel_launch: occupancy query says %d blocks per CU\n", per_cu);
        grid_blocks = cus;
    }
    (void)hipMemsetAsync((unsigned char*)d_ws + WS_CTL, 0, CTL_BYTES, stream);
    Params p{};
    for (int i = 0; i < 22; ++i) p.in[i] = (const float*)d_in[i];
    p.out = (float*)d_out; p.ws = (unsigned char*)d_ws;
    void* args[] = {&p};
    hipError_t e = hipLaunchCooperativeKernel((const void*)mega_fwd, dim3(grid_blocks), dim3(NT), args, LDS_BYTES, stream);
    if (e != hipSuccess) fprintf(stderr, "cooperative launch failed: %s (grid %d)\n", hipGetErrorString(e), grid_blocks);
}
```

```cpp
#include <hip/hip_runtime.h>
#include <hip/hip_cooperative_groups.h>
#include <cstdint>
#include <cstdio>

namespace cg = cooperative_groups;
namespace {
#define LAS __attribute__((address_space(3)))
typedef unsigned short bf16_t;
typedef short bf16x8 __attribute__((ext_vector_type(8)));
typedef float f32x4 __attribute__((ext_vector_type(4)));
typedef float f32x2 __attribute__((ext_vector_type(2)));
typedef unsigned u32x4 __attribute__((ext_vector_type(4)));
typedef unsigned u32x2 __attribute__((ext_vector_type(2)));

constexpr int BATCH = 8, SEQ = 4096, D = 1024, T = BATCH * SEQ;
constexpr int NE = 32, NG = 4, F = 512, CHUNK = 128, NH = 8;
constexpr float EPS = 1e-6f;
constexpr int NT = 512, NWAVES = 8;

constexpr size_t MiB = 1u << 20;
constexpr size_t WS_CTL = 0;
constexpr size_t CTL_BYTES = 65536;
constexpr size_t WS_RS = 1 * MiB;
constexpr size_t WS_ASG = 1 * MiB + 512 * 1024;
constexpr size_t WS_LNS = 2 * MiB;
constexpr size_t WS_WR = 2 * MiB + 512 * 1024;
constexpr size_t WS_WM = 3 * MiB;
constexpr size_t WS_LTOK = 4 * MiB;
constexpr size_t WS_LNP = 112 * MiB;
constexpr size_t WS_LGATE = 8 * MiB;
constexpr size_t WS_LRS = 12 * MiB;
constexpr size_t WS_WA_IN = 16 * MiB;
constexpr size_t WS_WA_OUT = 22 * MiB;
constexpr size_t WS_WB_IN = 24 * MiB;
constexpr size_t WS_WB_OUT = 28 * MiB;
constexpr size_t WS_WGU = 32 * MiB;
constexpr size_t WS_WD = 64 * MiB;
constexpr size_t WS_XQ = 80 * MiB;
constexpr size_t WS_A = 128 * MiB;
constexpr size_t WS_B = 256 * MiB;
constexpr size_t WS_C = 320 * MiB;
constexpr size_t WS_D = 384 * MiB;
constexpr size_t WS_END = 449 * MiB;
constexpr int CW_CNT = 0;
constexpr int CW_BAR = 4096;

constexpr int RING_BYTES = 131072;
constexpr int TAB_OFF = RING_BYTES;
constexpr int TAB_MAX = 320;
constexpr int TABN_OFF = TAB_OFF + TAB_MAX * 16;
constexpr int BARST_OFF = TABN_OFF + 16;
constexpr int TOKTAB_OFF = RING_BYTES + 8192;
constexpr int SCTAB_OFF = TOKTAB_OFF + 2048;
constexpr int LDS_BYTES = 147456;

__device__ __forceinline__ float bf2f(unsigned b) { return __uint_as_float(b << 16); }
__device__ __forceinline__ unsigned f2bf(float f) { unsigned u = __float_as_uint(f); return (u + 0x7fffu + ((u >> 16) & 1u)) >> 16; }
__device__ __forceinline__ unsigned pk2(float lo, float hi) { return f2bf(lo) | (f2bf(hi) << 16); }
__device__ __forceinline__ unsigned cvt_pk_bf16(float lo, float hi) { unsigned r; asm volatile("v_cvt_pk_bf16_f32 %0, %1, %2" : "=v"(r) : "v"(lo), "v"(hi)); return r; }
__device__ __forceinline__ float wave_sum(float v) {
#pragma unroll
    for (int o = 1; o < 64; o <<= 1) v += __shfl_xor(v, o);
    return v;
}
__device__ __forceinline__ void unpack8(const u32x4 v, float (&f)[8]) {
    f[0] = bf2f(v.x & 0xffffu); f[1] = bf2f(v.x >> 16); f[2] = bf2f(v.y & 0xffffu); f[3] = bf2f(v.y >> 16);
    f[4] = bf2f(v.z & 0xffffu); f[5] = bf2f(v.z >> 16); f[6] = bf2f(v.w & 0xffffu); f[7] = bf2f(v.w >> 16);
}
__device__ __forceinline__ u32x4 pack8(const float (&f)[8]) {
    u32x4 o; o.x = pk2(f[0], f[1]); o.y = pk2(f[2], f[3]); o.z = pk2(f[4], f[5]); o.w = pk2(f[6], f[7]); return o;
}
__device__ __forceinline__ float gelu_tanh(float x) {
    const float x2 = x * x;
    const float t = x * (x2 * (-0.044715f * 2.0f * 0.7978845608028654f * 1.4426950408889634f) + (-2.0f * 0.7978845608028654f * 1.4426950408889634f));
    return x * __builtin_amdgcn_rcpf(1.0f + __builtin_amdgcn_exp2f(t));
}
__device__ __forceinline__ float silu(float x) { return x * __builtin_amdgcn_rcpf(1.0f + __builtin_amdgcn_exp2f(x * -1.4426950408889634f)); }
#define LDS_WAIT() asm volatile("s_waitcnt lgkmcnt(0)" ::: "memory")
__device__ __forceinline__ float clamp_fp8(float v) { return __builtin_amdgcn_fmed3f(v, -448.0f, 448.0f); }
__device__ __forceinline__ unsigned pk4_fp8(float a, float b, float c, float d) { unsigned w = 0u; a = clamp_fp8(a); b = clamp_fp8(b); c = clamp_fp8(c); d = clamp_fp8(d); w = __builtin_amdgcn_cvt_pk_fp8_f32(a, b, w, false); w = __builtin_amdgcn_cvt_pk_fp8_f32(c, d, w, true); return w; }
__device__ __forceinline__ void unpack8_fp8(const u32x2 v, float (&f)[8]) {
    const f32x2 a = __builtin_amdgcn_cvt_pk_f32_fp8(v.x, false), b = __builtin_amdgcn_cvt_pk_f32_fp8(v.x, true), c = __builtin_amdgcn_cvt_pk_f32_fp8(v.y, false), d = __builtin_amdgcn_cvt_pk_f32_fp8(v.y, true);
    f[0] = a.x; f[1] = a.y; f[2] = b.x; f[3] = b.y; f[4] = c.x; f[5] = c.y; f[6] = d.x; f[7] = d.y;
}
typedef int i32x8 __attribute__((ext_vector_type(8)));
typedef int i32x4 __attribute__((ext_vector_type(4)));
__device__ __forceinline__ int phase_tid() { int t = (int)threadIdx.x; asm volatile("" : "+v"(t)); return t; }

constexpr int BM = 256, BK = 64, HALF = 128, HTB = HALF * BK * 2, NXCD = 8, WGM = 8;
__device__ __forceinline__ int lds_byte(int r, int c) { const int st = (r >> 4) * 2 + (c >> 5), rr = r & 15, cc = c & 31, ob = rr * 64 + cc * 2; return st * 1024 + (ob ^ (((ob >> 9) & 1) << 5)); }
__device__ __forceinline__ void stage_rc(int b, int& R, int& C) { const int st = b / 1024, sb = b % 1024, swz = sb ^ (((sb >> 9) & 1) << 5); R = (st >> 1) * 16 + swz / 64; C = (st & 1) * 32 + (swz % 64) / 2; }
__device__ __forceinline__ int perm32(int rho) { const int n = rho >> 4, i = rho & 15; return 8 * (i >> 2) + 4 * n + (i & 3); }

struct Unit { int pm, pn, e, row0, nrows, slot0; };
__device__ __forceinline__ bool order_next(int i, int G, int c, int nM, int nN, int& pm, int& pn) {
    const int nwg = nM * nN; const long L = (long)i * G + c; if (L >= nwg) return false;
    int wgid = (int)L; { const int q = nwg / NXCD, r = nwg % NXCD, xcd = wgid % NXCD, off = wgid / NXCD; wgid = (xcd < r ? xcd * (q + 1) : r * (q + 1) + (xcd - r) * q) + off; }
    const int nig = WGM * nN, gid = wgid / nig, fm = gid * WGM, gsz = (nM - fm) < WGM ? (nM - fm) : WGM;
    pm = fm + ((wgid % nig) % gsz); pn = (wgid % nig) / gsz; return true;
}
struct DenseSched {
    static constexpr bool ROWTAB = false, GATHER_IDS = false;
    int nM, nN, G, c, K; const bf16_t* Bt;
    __device__ __forceinline__ bool next(int i, Unit& u) const { u.e = 0; u.row0 = 0; u.nrows = BM; u.slot0 = 0; return order_next(i, G, c, nM, nN, u.pm, u.pn); }
    __device__ __forceinline__ void aoff(const Unit& u, int tid, unsigned (&v)[2][2]) const {
        int R[2], C[2]; stage_rc(tid * 16, R[0], C[0]); stage_rc(tid * 16 + 8192, R[1], C[1]);
#pragma unroll
        for (int h = 0; h < 2; ++h)
#pragma unroll
            for (int i = 0; i < 2; ++i) v[h][i] = (unsigned)((u.pm * BM + h * HALF + R[i]) * K + C[i]) * 2u;
    }
    __device__ __forceinline__ const char* bptr(const Unit& u) const { return (const char*)Bt + (size_t)u.pn * BM * K * 2; }
};
template <bool GATHER> struct MoeSched {
    static constexpr bool ROWTAB = true, GATHER_IDS = GATHER;
    int nM, G, c, K; const unsigned char* W; const int* ltok; const LAS int* tab; const float* rowscal;
    __device__ __forceinline__ bool next(int i, Unit& u) const {
        if (G == 256) { const int rt = i * 64 + 8 * (c & 7) + ((c >> 3) & 7); if (rt >= nM) return false; u.pm = rt; u.pn = c >> 6; }
        else if (!order_next(i, G, c, nM, 4, u.pm, u.pn)) return false;
        u.e = __builtin_amdgcn_readfirstlane(tab[u.pm * 4 + 0]); u.row0 = __builtin_amdgcn_readfirstlane(tab[u.pm * 4 + 1]); u.nrows = __builtin_amdgcn_readfirstlane(tab[u.pm * 4 + 2]); u.slot0 = __builtin_amdgcn_readfirstlane(tab[u.pm * 4 + 3]); return true;
    }
    __device__ __forceinline__ void aoff(const Unit& u, int tid, unsigned (&v)[2][2]) const {
        int R[2], C[2]; stage_rc(tid * 16, R[0], C[0]); stage_rc(tid * 16 + 8192, R[1], C[1]);
#pragma unroll
        for (int h = 0; h < 2; ++h)
#pragma unroll
            for (int i = 0; i < 2; ++i) {
                if (GATHER) { const int rr = min(h * HALF + R[i], u.nrows - 1); const int tok = ltok[(size_t)u.e * T + u.row0 + rr]; v[h][i] = (unsigned)(tok * K + C[i]) * 2u; }
                else v[h][i] = (unsigned)((u.slot0 + h * HALF + R[i]) * K + C[i]) * 2u;
            }
    }
    __device__ __forceinline__ void aoff_lds(const LAS int* toktab, int tid, unsigned (&v)[2][2]) const {
        int R[2], C[2]; stage_rc(tid * 16, R[0], C[0]); stage_rc(tid * 16 + 8192, R[1], C[1]);
#pragma unroll
        for (int h = 0; h < 2; ++h)
#pragma unroll
            for (int i = 0; i < 2; ++i) v[h][i] = (unsigned)(toktab[h * HALF + R[i]] * K + C[i]) * 2u;
    }
    __device__ __forceinline__ const char* bptr(const Unit& u) const { return (const char*)W + ((size_t)u.e * 1024 + (size_t)u.pn * BM) * K * 2; }
};

template <class Epi, class Sched, bool FP8 = false>
__device__ __forceinline__ void gemm_phase(LAS unsigned char* lds, const bf16_t* Abase, const int K, const Sched& S, const Epi& E) {
    const int tid = phase_tid(), wid = __builtin_amdgcn_readfirstlane(tid >> 6), lane = tid & 63, wr = wid >> 2, wc = wid & 3, fr = lane & 15, fq = lane >> 4;
    const int nt = K / BK;
    unsigned voffB[2];
#pragma unroll
    for (int i = 0; i < 2; ++i) { int sR, sC; stage_rc(tid * 16 + i * 8192, sR, sC);
        const int Rb = Epi::WIDE ? (64 * (sR >> 5) + 16 * ((sR & 15) >> 2) + 4 * ((sR >> 4) & 1) + (sR & 3)) : ((sR & ~31) + perm32(sR & 31)); voffB[i] = (unsigned)(Rb * K + sC) * 2u; }
    const size_t kstep = (size_t)(BK * 2);
    const size_t hstepB = (size_t)(Epi::WIDE ? 8 : HALF) * K * 2;
    const unsigned ldsw = (unsigned)wid * 1024u;
    const int aoff = lds_byte(wr * 64 + fr, fq * 8), boff = lds_byte(wc * 32 + fr, fq * 8);
#define PG8_SA(b, h) (((b) * 2 + (h)) * HTB)
#define PG8_SB(b, h) ((4 + (b) * 2 + (h)) * HTB)
#define PG8_STAGE(bufoff, gbase, voff) do { _Pragma("unroll") for (int _i = 0; _i < 2; ++_i) \
        __builtin_amdgcn_global_load_lds((const unsigned*)((const char*)(gbase) + (voff)[_i]), (LAS unsigned*)(lds + (bufoff) + ldsw + _i * 8192), 16, 0, 0); } while (0)
#define PG8_LDA(dst, b, h) do { _Pragma("unroll") for (int m = 0; m < 4; ++m) { \
        const i32x4 lo_ = *(const LAS i32x4*)(lds + PG8_SA(b, h) + aoff + m * 2048), hi_ = *(const LAS i32x4*)(lds + PG8_SA(b, h) + aoff + m * 2048 + 1024); \
        if constexpr (FP8) dst##8[m] = __builtin_shufflevector(lo_, hi_, 0, 1, 2, 3, 4, 5, 6, 7); else { dst[m][0] = __builtin_bit_cast(bf16x8, lo_); dst[m][1] = __builtin_bit_cast(bf16x8, hi_); } } } while (0)
#define PG8_LDB(dst, b, h) do { _Pragma("unroll") for (int n = 0; n < 2; ++n) { \
        const i32x4 lo_ = *(const LAS i32x4*)(lds + PG8_SB(b, h) + boff + n * 2048), hi_ = *(const LAS i32x4*)(lds + PG8_SB(b, h) + boff + n * 2048 + 1024); \
        if constexpr (FP8) dst##8[n] = __builtin_shufflevector(lo_, hi_, 0, 1, 2, 3, 4, 5, 6, 7); else { dst[n][0] = __builtin_bit_cast(bf16x8, lo_); dst[n][1] = __builtin_bit_cast(bf16x8, hi_); } } } while (0)
#define PG8_MMA(ai, bj, At, Bt) do { __builtin_amdgcn_s_setprio(1); \
        if constexpr (FP8) { \
            asm volatile("s_nop 1\n\t" \
                "v_mfma_f32_16x16x128_f8f6f4 %0, %8, %10, %0\n\t" "v_mfma_f32_16x16x128_f8f6f4 %1, %9, %10, %1\n\t" \
                "v_mfma_f32_16x16x128_f8f6f4 %2, %8, %11, %2\n\t" "v_mfma_f32_16x16x128_f8f6f4 %3, %9, %11, %3\n\t" \
                "v_mfma_f32_16x16x128_f8f6f4 %4, %8, %12, %4\n\t" "v_mfma_f32_16x16x128_f8f6f4 %5, %9, %12, %5\n\t" \
                "v_mfma_f32_16x16x128_f8f6f4 %6, %8, %13, %6\n\t" "v_mfma_f32_16x16x128_f8f6f4 %7, %9, %13, %7" \
                : "+v"(acc[ai][bj][0][0]), "+v"(acc[ai][bj][0][1]), "+v"(acc[ai][bj][1][0]), "+v"(acc[ai][bj][1][1]), \
                  "+v"(acc[ai][bj][2][0]), "+v"(acc[ai][bj][2][1]), "+v"(acc[ai][bj][3][0]), "+v"(acc[ai][bj][3][1]) \
                : "v"(Bt##8[0]), "v"(Bt##8[1]), "v"(At##8[0]), "v"(At##8[1]), "v"(At##8[2]), "v"(At##8[3])); \
        } else { _Pragma("unroll") for (int m = 0; m < 4; ++m) _Pragma("unroll") for (int n = 0; n < 2; ++n) _Pragma("unroll") for (int k = 0; k < 2; ++k) \
            acc[ai][bj][m][n] = __builtin_amdgcn_mfma_f32_16x16x32_bf16(Bt[n][k], At[m][k], acc[ai][bj][m][n], 0, 0, 0); } \
        __builtin_amdgcn_s_setprio(0); } while (0)
#define PG8_WAIT_V(n) asm volatile("s_waitcnt vmcnt(" #n ")" ::: "memory")
#define PG8_WAIT_L(n) asm volatile("s_waitcnt lgkmcnt(" #n ")" ::: "memory")
#define PG8_BAR __builtin_amdgcn_s_barrier()
#define PG8_SCHED __builtin_amdgcn_sched_barrier(0)
    Unit cur, nxt; int ui = 0;
    if (!S.next(0, cur)) return;
    f32x4 acc[2][2][4][2];
#pragma unroll
    for (int a = 0; a < 2; ++a)
#pragma unroll
        for (int b = 0; b < 2; ++b)
#pragma unroll
            for (int m = 0; m < 4; ++m)
#pragma unroll
                for (int n = 0; n < 2; ++n) acc[a][b][m][n] = (f32x4){0.f, 0.f, 0.f, 0.f};
    bf16x8 At[4][2], B0[2][2], B1[2][2]; i32x8 At8[4], B08[2], B18[2];
    unsigned vA[2][2], vS[2][2];
    S.aoff(cur, tid, vA);
#pragma unroll
    for (int h = 0; h < 2; ++h)
#pragma unroll
        for (int i = 0; i < 2; ++i) vS[h][i] = vA[h][i];
    const char* const A0 = (const char*)Abase;
    const char* cB = S.bptr(cur);
    PG8_STAGE(PG8_SB(0, 0), cB, voffB); PG8_STAGE(PG8_SB(0, 1), cB + hstepB, voffB); PG8_STAGE(PG8_SA(0, 0), A0, vA[0]); PG8_STAGE(PG8_SA(0, 1), A0, vA[1]);
    if (wr == 1) PG8_BAR;
    PG8_WAIT_V(2); PG8_BAR;
    PG8_STAGE(PG8_SB(1, 0), cB + kstep, voffB); PG8_STAGE(PG8_SA(1, 0), A0 + kstep, vA[0]); PG8_STAGE(PG8_SB(1, 1), cB + hstepB + kstep, voffB);
    PG8_WAIT_V(6); PG8_BAR;
    for (;;) {
        const bool has_next = S.next(ui + 1, nxt);
        const bool full = cur.nrows > HALF;
        if constexpr (Sched::ROWTAB) {
            if (wid < 4) { const int row = wid * 64 + lane;
                __builtin_amdgcn_global_load_lds((const unsigned*)(S.rowscal + (size_t)cur.e * T + cur.row0 + min(row, cur.nrows - 1)), (LAS unsigned*)(lds + SCTAB_OFF + (ui & 1) * 1024 + wid * 256), 4, 0, 0);
                if (Sched::GATHER_IDS && has_next) __builtin_amdgcn_global_load_lds((const unsigned*)(S.ltok + (size_t)nxt.e * T + nxt.row0 + min(row, nxt.nrows - 1)), (LAS unsigned*)(lds + TOKTAB_OFF + (ui & 1) * 1024 + wid * 256), 4, 0, 0); }
        }
        const char* nB = has_next ? S.bptr(nxt) : cB;
#pragma unroll 1
        for (int t = 0; t < nt; t += 2) {
            const bool last = (t == nt - 2);
            if (last && has_next) { if constexpr (Sched::GATHER_IDS) S.aoff_lds((const LAS int*)(lds + TOKTAB_OFF + (ui & 1) * 1024), tid, vS); else S.aoff(nxt, tid, vS); }
            const char* a1 = A0 + (size_t)(t + 1) * kstep;
            const char* a2 = last ? A0 : A0 + (size_t)(t + 2) * kstep; const char* b2 = last ? nB : cB + (size_t)(t + 2) * kstep;
            const char* a3 = a2 + kstep; const char* b3 = b2 + kstep;
            PG8_LDB(B0, 0, 0); PG8_LDB(B1, 0, 1); PG8_SCHED; PG8_LDA(At, 0, 0); PG8_STAGE(PG8_SA(1, 1), a1, vA[1]);
            PG8_WAIT_V(8); PG8_WAIT_L(0); PG8_BAR; PG8_MMA(0, 0, At, B0); PG8_MMA(0, 1, At, B1); PG8_BAR; PG8_SCHED;
            PG8_LDA(At, 0, 1); PG8_STAGE(PG8_SB(0, 0), b2, voffB); PG8_STAGE(PG8_SB(0, 1), b2 + hstepB, voffB); PG8_STAGE(PG8_SA(0, 0), a2, vS[0]);
            PG8_WAIT_V(8); PG8_WAIT_L(0); PG8_BAR; if (full) { PG8_MMA(1, 0, At, B0); PG8_MMA(1, 1, At, B1); } PG8_BAR; PG8_SCHED;
            PG8_LDB(B0, 1, 0); PG8_LDB(B1, 1, 1); PG8_SCHED; PG8_LDA(At, 1, 0); PG8_STAGE(PG8_SA(0, 1), a2, vS[1]);
            PG8_WAIT_V(8); PG8_WAIT_L(0); PG8_BAR; PG8_MMA(0, 0, At, B0); PG8_MMA(0, 1, At, B1); PG8_BAR; PG8_SCHED;
            PG8_LDA(At, 1, 1); PG8_STAGE(PG8_SB(1, 0), b3, voffB); PG8_STAGE(PG8_SB(1, 1), b3 + hstepB, voffB); PG8_STAGE(PG8_SA(1, 0), a3, vS[0]);
            PG8_WAIT_V(8); PG8_WAIT_L(0); PG8_BAR; if (full) { PG8_MMA(1, 0, At, B0); PG8_MMA(1, 1, At, B1); } PG8_BAR; PG8_SCHED;
        }
        if (wr == 0) PG8_BAR;
        if constexpr (FP8) asm volatile("s_nop 7\n\ts_nop 7\n\ts_nop 7" ::: "memory");
        { const int t2 = phase_tid(), l2 = t2 & 63; E(acc, cur, wr, wc, l2 & 15, l2 >> 4, (const LAS float*)(lds + SCTAB_OFF + (ui & 1) * 1024)); }
        if (!has_next) break;
#pragma unroll
        for (int a = 0; a < 2; ++a)
#pragma unroll
            for (int b = 0; b < 2; ++b)
#pragma unroll
                for (int m = 0; m < 4; ++m)
#pragma unroll
                    for (int n = 0; n < 2; ++n) acc[a][b][m][n] = (f32x4){0.f, 0.f, 0.f, 0.f};
        cur = nxt; cB = nB; ++ui;
#pragma unroll
        for (int h = 0; h < 2; ++h)
#pragma unroll
            for (int i = 0; i < 2; ++i) vA[h][i] = vS[h][i];
        if (wr == 1) PG8_BAR;
    }
    PG8_WAIT_V(0);
    PG8_BAR;
#undef PG8_SA
#undef PG8_SB
#undef PG8_STAGE
#undef PG8_LDA
#undef PG8_LDB
#undef PG8_MMA
#undef PG8_WAIT_V
#undef PG8_WAIT_L
#undef PG8_BAR
#undef PG8_SCHED
}

__device__ __forceinline__ u32x4 pack_rows(const f32x4 v0, const f32x4 v1) { u32x4 w; w.x = cvt_pk_bf16(v0[0], v0[1]); w.y = cvt_pk_bf16(v0[2], v0[3]); w.z = cvt_pk_bf16(v1[0], v1[1]); w.w = cvt_pk_bf16(v1[2], v1[3]); return w; }
struct EpiG1 {
    static constexpr bool WIDE = false;
    bf16_t* ZB;
    __device__ __forceinline__ void operator()(const f32x4 (&acc)[2][2][4][2], const Unit& u, int wr, int wc, int fr, int fq, const LAS float* sct) const {
        const int row0 = u.pm * BM + wr * 64 + fr;
#pragma unroll
        for (int ai = 0; ai < 2; ++ai)
#pragma unroll
            for (int m = 0; m < 4; ++m) { bf16_t* rowp = ZB + (size_t)(row0 + ai * HALF + m * 16) * D;
                if (u.pn < 8) { *(u32x4*)(rowp + u.pn * 128 + wc * 32 + 8 * fq) = pack_rows(acc[ai][0][m][0] * acc[ai][1][m][0], acc[ai][0][m][1] * acc[ai][1][m][1]); }
                else {
#pragma unroll
                    for (int bj = 0; bj < 2; ++bj) *(u32x4*)(rowp + (size_t)T * D + (u.pn - 8) * BM + bj * HALF + wc * 32 + 8 * fq) = pack_rows(acc[ai][bj][m][0], acc[ai][bj][m][1]); } }
    }
};
template <bool SCALED> struct EpiRes {
    static constexpr bool WIDE = true;
    const bf16_t* res; bf16_t* X; unsigned char* XQ; const float* rinv; const float* gcol;
    __device__ __forceinline__ void operator()(const f32x4 (&acc)[2][2][4][2], const Unit& u, int wr, int wc, int fr, int fq, const LAS float* sct) const {
        const int row0 = u.pm * BM + wr * 64 + fr, col0 = u.pn * BM + wc * 64 + 16 * fq;
        float gi[2][8];
        if (SCALED) {
#pragma unroll
            for (int bj = 0; bj < 2; ++bj) { const f32x4 g0 = *(const f32x4*)(gcol + col0 + 8 * bj), g1 = *(const f32x4*)(gcol + col0 + 8 * bj + 4);
                gi[bj][0] = __builtin_amdgcn_rcpf(g0.x); gi[bj][1] = __builtin_amdgcn_rcpf(g0.y); gi[bj][2] = __builtin_amdgcn_rcpf(g0.z); gi[bj][3] = __builtin_amdgcn_rcpf(g0.w);
                gi[bj][4] = __builtin_amdgcn_rcpf(g1.x); gi[bj][5] = __builtin_amdgcn_rcpf(g1.y); gi[bj][6] = __builtin_amdgcn_rcpf(g1.z); gi[bj][7] = __builtin_amdgcn_rcpf(g1.w); } }
#pragma unroll
        for (int ai = 0; ai < 2; ++ai) {
            u32x4 rb[4][2]; float ri[4];
#pragma unroll
            for (int m = 0; m < 4; ++m) { const size_t off = (size_t)(row0 + ai * HALF + m * 16) * D + col0; ri[m] = SCALED ? rinv[row0 + ai * HALF + m * 16] : 1.0f;
#pragma unroll
                for (int bj = 0; bj < 2; ++bj) rb[m][bj] = __builtin_nontemporal_load((const u32x4*)(res + off + 8 * bj)); }
#pragma unroll
            for (int m = 0; m < 4; ++m) { const size_t off = (size_t)(row0 + ai * HALF + m * 16) * D + col0; u32x4 q;
#pragma unroll
                for (int bj = 0; bj < 2; ++bj) { float f[8]; unpack8(rb[m][bj], f);
                    if (SCALED) {
#pragma unroll
                        for (int e = 0; e < 8; ++e) f[e] = f[e] * ri[m] * gi[bj][e]; }
                    const f32x4 o0 = (f32x4){f[0], f[1], f[2], f[3]} + acc[ai][bj][m][0], o1 = (f32x4){f[4], f[5], f[6], f[7]} + acc[ai][bj][m][1];
                    *(u32x4*)(X + off + 8 * bj) = pack_rows(o0, o1);
                    q[2 * bj] = pk4_fp8(2.f * o0[0], 2.f * o0[1], 2.f * o0[2], 2.f * o0[3]); q[2 * bj + 1] = pk4_fp8(2.f * o1[0], 2.f * o1[1], 2.f * o1[2], 2.f * o1[3]); }
                *(u32x4*)(XQ + off) = q; }
        }
    }
};
struct EpiG3 {
    static constexpr bool WIDE = false;
    const float* lrs; unsigned char* H;
    __device__ __forceinline__ void operator()(const f32x4 (&acc)[2][2][4][2], const Unit& u, int wr, int wc, int fr, int fq, const LAS float* sct) const {
        float scv[2][4];
#pragma unroll
        for (int ai = 0; ai < 2; ++ai)
#pragma unroll
            for (int m = 0; m < 4; ++m) { const int r = ai * HALF + wr * 64 + m * 16 + fr; scv[ai][m] = sct[r]; }
#pragma unroll
        for (int ai = 0; ai < 2; ++ai)
#pragma unroll
            for (int m = 0; m < 4; ++m) { const int r = ai * HALF + wr * 64 + m * 16 + fr;
                if (r < u.nrows) { const float sc = scv[ai][m] * (1.0f / 64.0f); f32x4 o[2];
#pragma unroll
                    for (int n = 0; n < 2; ++n)
#pragma unroll
                        for (int j = 0; j < 4; ++j) o[n][j] = 4.0f * silu(sc * acc[ai][0][m][n][j]) * (sc * acc[ai][1][m][n][j]);
                    u32x2 q; q.x = pk4_fp8(o[0][0], o[0][1], o[0][2], o[0][3]); q.y = pk4_fp8(o[1][0], o[1][1], o[1][2], o[1][3]);
                    *(u32x2*)(H + (size_t)(u.slot0 + r) * F + u.pn * 128 + wc * 32 + 8 * fq) = q; } }
    }
};
struct EpiG4 {
    static constexpr bool WIDE = true;
    const float* lgate; unsigned char* YS;
    __device__ __forceinline__ void operator()(const f32x4 (&acc)[2][2][4][2], const Unit& u, int wr, int wc, int fr, int fq, const LAS float* sct) const {
        float gv[2][4];
#pragma unroll
        for (int ai = 0; ai < 2; ++ai)
#pragma unroll
            for (int m = 0; m < 4; ++m) { const int r = ai * HALF + wr * 64 + m * 16 + fr; gv[ai][m] = sct[r]; }
#pragma unroll
        for (int ai = 0; ai < 2; ++ai)
#pragma unroll
            for (int m = 0; m < 4; ++m) { const int r = ai * HALF + wr * 64 + m * 16 + fr;
                if (r < u.nrows) { const float g = gv[ai][m] * (16.0f / 128.0f);
                    u32x4 q;
#pragma unroll
                    for (int bj = 0; bj < 2; ++bj) { const f32x4 o0 = acc[ai][bj][m][0] * g, o1 = acc[ai][bj][m][1] * g; q[2 * bj] = pk4_fp8(o0[0], o0[1], o0[2], o0[3]); q[2 * bj + 1] = pk4_fp8(o1[0], o1[1], o1[2], o1[3]); }
                    *(u32x4*)(YS + (size_t)(u.slot0 + r) * D + u.pn * BM + wc * 64 + 16 * fq) = q; } }
    }
};
struct EpiG5 {
    static constexpr bool WIDE = true;
    const float* rs; const float* bias; bf16_t* UV; f32x2* lnp;
    __device__ __forceinline__ void operator()(const f32x4 (&acc)[2][2][4][2], const Unit& u, int wr, int wc, int fr, int fq, const LAS float* sct) const {
        const int row0 = u.pm * BM + wr * 64 + fr, col0 = u.pn * BM + wc * 64 + 16 * fq;
        f32x4 bv[2][2];
#pragma unroll
        for (int bj = 0; bj < 2; ++bj)
#pragma unroll
            for (int n = 0; n < 2; ++n) bv[bj][n] = *(const f32x4*)(bias + col0 + 8 * bj + 4 * n);
        float scv[2][4];
#pragma unroll
        for (int ai = 0; ai < 2; ++ai)
#pragma unroll
            for (int m = 0; m < 4; ++m) scv[ai][m] = rs[row0 + ai * HALF + m * 16];
#pragma unroll
        for (int ai = 0; ai < 2; ++ai) { float mps = 0.f, mpq = 0.f;
#pragma unroll
            for (int m = 0; m < 4; ++m) { const int row = row0 + ai * HALF + m * 16; const float sc = scv[ai][m];
                float ps = 0.f, pq = 0.f;
#pragma unroll
                for (int bj = 0; bj < 2; ++bj) { f32x4 o[2];
#pragma unroll
                    for (int n = 0; n < 2; ++n)
#pragma unroll
                        for (int j = 0; j < 4; ++j) { o[n][j] = gelu_tanh(sc * acc[ai][bj][m][n][j] + bv[bj][n][j]); ps += o[n][j]; pq += o[n][j] * o[n][j]; }
                    *(u32x4*)(UV + (u.pn >= 4 ? (size_t)T * D : (size_t)0) + (size_t)row * D + (col0 & (D - 1)) + 8 * bj) = pack_rows(o[0], o[1]); }
                if (u.pn >= 4) { ps += __shfl_xor(ps, 16); ps += __shfl_xor(ps, 32); pq += __shfl_xor(pq, 16); pq += __shfl_xor(pq, 32);
                    if (m == fq) { mps = ps; mpq = pq; } }
                if (m == 3 && u.pn >= 4) lnp[(size_t)(row0 + ai * HALF + fq * 16) * 16 + (u.pn - 4) * 4 + wc] = (f32x2){mps, mpq}; }
        }
    }
};

struct Part { int base_row, nrows, j, nb; };
__device__ __forceinline__ void ph_prep_x(const float* __restrict__ x, const float* __restrict__ g, bf16_t* __restrict__ xn, float* __restrict__ rinv) {
    const int tid = phase_tid(), lane = tid & 63, gw = ((int)blockIdx.x * NT + tid) >> 6, ngw = ((int)gridDim.x * NT) >> 6;
    f32x4 gv[4];
#pragma unroll
    for (int j = 0; j < 4; ++j) gv[j] = *(const f32x4*)(g + (j >> 1) * 512 + lane * 8 + (j & 1) * 4);
    for (int row = gw; row < T; row += 2 * ngw) {
        const int row2 = row + ngw;
        const bool has2 = row2 < T;
        const float* xr = x + (size_t)row * D; const float* xr2 = x + (size_t)(has2 ? row2 : row) * D;
        f32x4 v[4], w[4]; float s = 0.f, s2 = 0.f;
#pragma unroll
        for (int j = 0; j < 4; ++j) { v[j] = __builtin_nontemporal_load((const f32x4*)(xr + (j >> 1) * 512 + lane * 8 + (j & 1) * 4)); w[j] = __builtin_nontemporal_load((const f32x4*)(xr2 + (j >> 1) * 512 + lane * 8 + (j & 1) * 4)); }
#pragma unroll
        for (int j = 0; j < 4; ++j) { s += (v[j].x * v[j].x + v[j].y * v[j].y) + (v[j].z * v[j].z + v[j].w * v[j].w); s2 += (w[j].x * w[j].x + w[j].y * w[j].y) + (w[j].z * w[j].z + w[j].w * w[j].w); }
        const float r = rsqrtf(wave_sum(s) * (1.0f / D) + EPS), r2 = rsqrtf(wave_sum(s2) * (1.0f / D) + EPS);
        if (lane == 0) { rinv[row] = 1.0f / r; if (has2) rinv[row2] = 1.0f / r2; }
#pragma unroll
        for (int h = 0; h < 2; ++h) { u32x4 q; q.x = pk2(v[2 * h].x * r * gv[2 * h].x, v[2 * h].y * r * gv[2 * h].y); q.y = pk2(v[2 * h].z * r * gv[2 * h].z, v[2 * h].w * r * gv[2 * h].w);
            q.z = pk2(v[2 * h + 1].x * r * gv[2 * h + 1].x, v[2 * h + 1].y * r * gv[2 * h + 1].y); q.w = pk2(v[2 * h + 1].z * r * gv[2 * h + 1].z, v[2 * h + 1].w * r * gv[2 * h + 1].w);
            *(u32x4*)(xn + (size_t)row * D + h * 512 + lane * 8) = q; }
        if (has2) {
#pragma unroll
            for (int h = 0; h < 2; ++h) { u32x4 q; q.x = pk2(w[2 * h].x * r2 * gv[2 * h].x, w[2 * h].y * r2 * gv[2 * h].y); q.y = pk2(w[2 * h].z * r2 * gv[2 * h].z, w[2 * h].w * r2 * gv[2 * h].w);
                q.z = pk2(w[2 * h + 1].x * r2 * gv[2 * h + 1].x, w[2 * h + 1].y * r2 * gv[2 * h + 1].y); q.w = pk2(w[2 * h + 1].z * r2 * gv[2 * h + 1].z, w[2 * h + 1].w * r2 * gv[2 * h + 1].w);
                *(u32x4*)(xn + (size_t)row2 * D + h * 512 + lane * 8) = q; } }
    }
}
__device__ __forceinline__ int map_row(int mapkind, int n) {
    if (mapkind == 0) return n;
    if (mapkind == 1) { if (n < D) return 2 * D + n; const int ch = (n - D) & (D - 1), second = (n >= 2 * D); return 256 * (ch >> 7) + 128 * second + (ch & 127); }
    return 256 * (n >> 7) + (mapkind == 3 ? 128 : 0) + (n & 127);
}
struct TrItem { const float* src; int k0, n0; };
__device__ __forceinline__ void tr_load(const float* __restrict__ W, int N, int item, int lane, f32x4 (&v)[16]) {
    const int nblk = N / 64, kb = item / nblk, nb = item % nblk, k0 = 64 * kb, n0 = 64 * nb, kq = lane >> 4, nn = 4 * (lane & 15);
#pragma unroll
    for (int i = 0; i < 16; ++i) v[i] = __builtin_nontemporal_load((const f32x4*)(W + (size_t)(k0 + 4 * i + kq) * N + n0 + nn));
}
template <bool FP8OUT> __device__ __forceinline__ void tr_process(const f32x4 (&v)[16], int K, int N, void* __restrict__ WTv, int mapkind, const float* __restrict__ kscale, LAS float* scr, int item, int lane) {
    const int nblk = N / 64, kb = item / nblk, nb = item % nblk, k0 = 64 * kb, n0 = 64 * nb, kq = lane >> 4, nn = 4 * (lane & 15);
#pragma unroll
    for (int i = 0; i < 16; ++i) { const int kk = 4 * i + kq; const float sc = (kscale ? kscale[k0 + kk] : 1.0f) * (FP8OUT ? 32.0f : 1.0f); LAS float* d = scr + kk * 65 + nn;
        d[0] = v[i].x * sc; d[1] = v[i].y * sc; d[2] = v[i].z * sc; d[3] = v[i].w * sc; }
    LDS_WAIT();
    if constexpr (!FP8OUT) {
        bf16_t* WT = (bf16_t*)WTv; const int c = lane & 7;
#pragma unroll
        for (int j = 0; j < 8; ++j) { const int n = (lane >> 3) + 8 * j; const LAS float* sp = scr + (8 * c) * 65 + n;
            u32x4 o; o.x = pk2(sp[0 * 65], sp[1 * 65]); o.y = pk2(sp[2 * 65], sp[3 * 65]); o.z = pk2(sp[4 * 65], sp[5 * 65]); o.w = pk2(sp[6 * 65], sp[7 * 65]);
            *(u32x4*)(WT + (size_t)map_row(mapkind, n0 + n) * K + k0 + 8 * c) = o; }
    } else {
        unsigned char* WT = (unsigned char*)WTv; const int c = lane & 3;
#pragma unroll
        for (int j = 0; j < 4; ++j) { const int n = (lane >> 2) + 16 * j; const LAS float* sp = scr + (16 * c) * 65 + n;
            u32x4 o; o.x = pk4_fp8(sp[0 * 65], sp[1 * 65], sp[2 * 65], sp[3 * 65]); o.y = pk4_fp8(sp[4 * 65], sp[5 * 65], sp[6 * 65], sp[7 * 65]);
            o.z = pk4_fp8(sp[8 * 65], sp[9 * 65], sp[10 * 65], sp[11 * 65]); o.w = pk4_fp8(sp[12 * 65], sp[13 * 65], sp[14 * 65], sp[15 * 65]);
            *(u32x4*)(WT + (size_t)map_row(mapkind, n0 + n) * K + k0 + 16 * c) = o; }
    }
    LDS_WAIT();
}
template <bool FP8OUT> __device__ __forceinline__ void ph_transpose(LAS unsigned char* lds, const float* W, int K, int N, void* WT, int mapkind, const float* kscale, int nbatch, size_t sstride, size_t dstride, int shift = 0) {
    const int tid = phase_tid(), lane = tid & 63, wave = tid >> 6, ngw = (int)gridDim.x * NWAVES, gw = ((int)blockIdx.x * NWAVES + wave + ngw - (shift % ngw)) % ngw;
    LAS float* scr = (LAS float*)(lds + wave * 16640);
    const int per = (K / 64) * (N / 64), nitems = per * nbatch;
    f32x4 v[16], vn[16];
    int it = gw;
    if (it < nitems) tr_load(W + (size_t)(it / per) * sstride, N, it % per, lane, v);
    while (it < nitems) {
        const int nx = it + ngw;
        if (nx < nitems) tr_load(W + (size_t)(nx / per) * sstride, N, nx % per, lane, vn);
        tr_process<FP8OUT>(v, K, N, (unsigned char*)WT + (size_t)(it / per) * dstride * (FP8OUT ? 1 : 2), mapkind, kscale, scr, it % per, lane);
#pragma unroll
        for (int i = 0; i < 16; ++i) v[i] = vn[i];
        it = nx;
    }
}
__device__ __forceinline__ void ph_prep_experts(LAS unsigned char* lds, int layer, const float* w_gate, const float* w_up, const float* w_down, const float* ln2, unsigned char* WGU, unsigned char* WD) {
    ph_transpose<true>(lds, w_gate + (size_t)layer * NE * D * F, D, F, WGU, 2, ln2 + layer * D, NE, (size_t)D * F, (size_t)1024 * D);
    ph_transpose<true>(lds, w_up + (size_t)layer * NE * D * F, D, F, WGU, 3, ln2 + layer * D, NE, (size_t)D * F, (size_t)1024 * D);
    ph_transpose<true>(lds, w_down + (size_t)layer * NE * F * D, F, D, WD, 0, nullptr, NE, (size_t)F * D, (size_t)D * F);
}
__device__ __forceinline__ void ph_prep_router(const float* __restrict__ ln2, const float* __restrict__ wg, const float* __restrict__ we, bf16_t* __restrict__ wr) {
    for (int i = (int)blockIdx.x * NT + phase_tid(); i < 2 * 48 * D; i += (int)gridDim.x * NT) {
        const int l = i / (48 * D), j = (i / D) % 48, k = i % D;
        float w = 0.f;
        if (j < 4) w = wg[((size_t)l * D + k) * NG + j]; else if (j < 36) w = we[((size_t)l * D + k) * NE + (j - 4)];
        w *= ln2[l * D + k];
        const unsigned hi = f2bf(w); const unsigned lo = f2bf(w - bf2f(hi));
        wr[((size_t)l * 2 + 0) * 48 * D + (size_t)j * D + k] = (bf16_t)hi; wr[((size_t)l * 2 + 1) * 48 * D + (size_t)j * D + k] = (bf16_t)lo;
    }
}
__device__ __forceinline__ void ph_prep_wm(const float* __restrict__ ws, bf16_t* __restrict__ wm) {
    for (int i = (int)blockIdx.x * NT + phase_tid(); i < NH * CHUNK * CHUNK; i += (int)gridDim.x * NT) { const int t = (i / CHUNK) % CHUNK, s = i % CHUNK; wm[i] = (bf16_t)f2bf(t >= s ? ws[i] : 0.f); }
}
__device__ __forceinline__ void ph_conv(const Part P, const bf16_t* __restrict__ ZB, const float* __restrict__ cw, bf16_t* __restrict__ Y) {
    constexpr int RB = 8;
    const int nitems = (P.nrows / RB) * (D / 8);
    for (int it = P.j * NT + phase_tid(); it < nitems; it += P.nb * NT) {
        const int cg8 = it & 127, rb = it >> 7, r0 = P.base_row + rb * RB, ch = cg8 * 8, t0 = r0 & (SEQ - 1);
        float w[3][8];
#pragma unroll
        for (int k = 0; k < 3; ++k)
#pragma unroll
            for (int i = 0; i < 8; ++i) w[k][i] = cw[k * D + ch + i];
        float zm2[8], zm1[8];
        if (t0 >= 2) { unpack8(__builtin_nontemporal_load((const u32x4*)(ZB + (size_t)(r0 - 2) * D + ch)), zm2); unpack8(__builtin_nontemporal_load((const u32x4*)(ZB + (size_t)(r0 - 1) * D + ch)), zm1); }
        else {
#pragma unroll
            for (int i = 0; i < 8; ++i) { zm2[i] = 0.f; zm1[i] = 0.f; } }
#pragma unroll
        for (int r = 0; r < RB; ++r) {
            float z[8], b[8], o[8];
            unpack8(__builtin_nontemporal_load((const u32x4*)(ZB + (size_t)(r0 + r) * D + ch)), z); unpack8(__builtin_nontemporal_load((const u32x4*)(ZB + (size_t)T * D + (size_t)(r0 + r) * D + ch)), b);
#pragma unroll
            for (int i = 0; i < 8; ++i) { o[i] = b[i] * (w[0][i] * zm2[i] + w[1][i] * zm1[i] + w[2][i] * z[i]); zm2[i] = zm1[i]; zm1[i] = z[i]; }
            *(u32x4*)(Y + (size_t)(r0 + r) * D + ch) = pack8(o);
        }
    }
}
__device__ __forceinline__ void ph_route(const Part P, LAS unsigned char* lds, const bf16_t* __restrict__ X, const bf16_t* __restrict__ wrh, const float* __restrict__ bg, const float* __restrict__ be,
                                         unsigned* __restrict__ cnt, unsigned* __restrict__ asg, int* __restrict__ ltok, float* __restrict__ lgate, float* __restrict__ lrs) {
    const int tid = phase_tid(), wave = tid >> 6, lane = tid & 63, fr = lane & 15, fq = lane >> 4;
    LAS float* lgs = (LAS float*)(lds + wave * 4096);
    LAS int* s_e = (LAS int*)(lds + 32768); LAS float* s_g = (LAS float*)(lds + 32768 + 1024); LAS float* s_r = (LAS float*)(lds + 32768 + 2048);
    LAS unsigned* s_cnt = (LAS unsigned*)(lds + 32768 + 3072); LAS unsigned* s_base = (LAS unsigned*)(lds + 32768 + 3200); LAS unsigned* s_rank = (LAS unsigned*)(lds + 32768 + 3328);
    const bf16_t* wrl = wrh + 48 * D;
    for (int tbl = P.j * 128; tbl < P.nrows; tbl += P.nb * 128) {
        const int tb = P.base_row + tbl;
        if (tid < NE) s_cnt[tid] = 0u;
        const int tok0 = tb + wave * 16;
        f32x4 acc[3]; float ss = 0.f;
#pragma unroll
        for (int n = 0; n < 3; ++n) acc[n] = (f32x4){0.f, 0.f, 0.f, 0.f};
        constexpr int WCH_PITCH = 272, WCH_BYTES = 2 * 48 * WCH_PITCH;
        LAS unsigned char* wbuf = lds + 49152;
        u32x4 wreg[3], araw[4];
#pragma unroll
        for (int p = 0; p < 3; ++p) { const int pc = tid + 512 * p, hl = pc / 768, row = (pc % 768) >> 4, kc = pc & 15; wreg[p] = *(const u32x4*)(wrh + (size_t)hl * 48 * D + (size_t)row * D + kc * 8); }
#pragma unroll
        for (int q = 0; q < 4; ++q) araw[q] = *(const u32x4*)(X + (size_t)(tok0 + fr) * D + q * 32 + fq * 8);
#pragma unroll 1
        for (int kb = 0; kb < D / 128; ++kb) {
            LAS unsigned char* wb = wbuf + (kb & 1) * WCH_BYTES;
#pragma unroll
            for (int p = 0; p < 3; ++p) { const int pc = tid + 512 * p, hl = pc / 768, row = (pc % 768) >> 4, kc = pc & 15; *(LAS u32x4*)(wb + (hl * 48 + row) * WCH_PITCH + kc * 16) = wreg[p]; }
            u32x4 acur[4];
#pragma unroll
            for (int q = 0; q < 4; ++q) acur[q] = araw[q];
            __syncthreads();
            if (kb + 1 < D / 128) {
#pragma unroll
                for (int p = 0; p < 3; ++p) { const int pc = tid + 512 * p, hl = pc / 768, row = (pc % 768) >> 4, kc = pc & 15; wreg[p] = *(const u32x4*)(wrh + (size_t)hl * 48 * D + (size_t)row * D + (kb + 1) * 128 + kc * 8); }
#pragma unroll
                for (int q = 0; q < 4; ++q) araw[q] = *(const u32x4*)(X + (size_t)(tok0 + fr) * D + ((kb + 1) * 4 + q) * 32 + fq * 8);
            }
#pragma unroll
            for (int q = 0; q < 4; ++q) {
                float af[8]; unpack8(acur[q], af);
#pragma unroll
                for (int e = 0; e < 8; ++e) ss += af[e] * af[e];
                const bf16x8 a = __builtin_bit_cast(bf16x8, acur[q]);
#pragma unroll
                for (int n = 0; n < 3; ++n) {
                    const bf16x8 bh = *(const LAS bf16x8*)(wb + (n * 16 + fr) * WCH_PITCH + (q * 32 + fq * 8) * 2);
                    const bf16x8 bl = *(const LAS bf16x8*)(wb + (48 + n * 16 + fr) * WCH_PITCH + (q * 32 + fq * 8) * 2);
                    acc[n] = __builtin_amdgcn_mfma_f32_16x16x32_bf16(a, bh, acc[n], 0, 0, 0); acc[n] = __builtin_amdgcn_mfma_f32_16x16x32_bf16(a, bl, acc[n], 0, 0, 0); }
            }
        }
        __syncthreads();
        ss += __shfl_xor(ss, 16); ss += __shfl_xor(ss, 32);
#pragma unroll
        for (int n = 0; n < 3; ++n)
#pragma unroll
            for (int j = 0; j < 4; ++j) lgs[(fq * 4 + j) * 49 + n * 16 + fr] = acc[n][j];
        if (fq == 0) lgs[16 * 49 + fr] = rsqrtf(ss * (1.0f / D) + EPS);
        LDS_WAIT();
        if (lane < 16) {
            const float r = lgs[16 * 49 + lane]; const LAS float* L = lgs + lane * 49;
            float lg[36];
#pragma unroll
            for (int j = 0; j < 36; ++j) lg[j] = L[j] * r + (j < 4 ? bg[j] : be[j - 4]);
            int gi = 0; float gm = lg[0];
#pragma unroll
            for (int j = 1; j < 4; ++j) if (lg[j] > gm) { gm = lg[j]; gi = j; }
            float gs = 0.f;
#pragma unroll
            for (int j = 0; j < 4; ++j) gs += __expf(lg[j] - gm);
            const float gp = 1.0f / gs;
            float el[8];
#pragma unroll
            for (int j = 0; j < 8; ++j) { el[j] = lg[4 + j];
#pragma unroll
                for (int g = 1; g < 4; ++g) el[j] = (gi == g) ? lg[4 + g * 8 + j] : el[j]; }
            int i0 = 0; float m0 = el[0];
#pragma unroll
            for (int j = 1; j < 8; ++j) if (el[j] > m0) { m0 = el[j]; i0 = j; }
            int i1 = 0; float m1 = -3.0e38f;
#pragma unroll
            for (int j = 0; j < 8; ++j) if (j != i0 && el[j] > m1) { m1 = el[j]; i1 = j; }
            const float eb = __expf(m1 - m0), den = 1.0f / (1.0f + eb);
            const int tl = wave * 16 + lane;
            s_e[2 * tl] = gi * 8 + i0; s_e[2 * tl + 1] = gi * 8 + i1; s_g[2 * tl] = gp * den; s_g[2 * tl + 1] = gp * eb * den; s_r[tl] = r;
        }
        __syncthreads();
        if (tid < 256) s_rank[tid] = atomicAdd((unsigned*)&s_cnt[s_e[tid]], 1u);
        __syncthreads();
        if (tid < NE) s_base[tid] = s_cnt[tid] ? atomicAdd(&cnt[tid], s_cnt[tid]) : 0u;
        __syncthreads();
        if (tid < 256) { const int e = s_e[tid], tok = tb + (tid >> 1); const unsigned pos = s_base[e] + s_rank[tid];
            ltok[(size_t)e * T + pos] = tok; lgate[(size_t)e * T + pos] = s_g[tid]; lrs[(size_t)e * T + pos] = s_r[tid >> 1];
            asg[(size_t)tok * 4 + (tid & 1) * 2] = ((unsigned)e << 24) | pos; asg[(size_t)tok * 4 + (tid & 1) * 2 + 1] = __float_as_uint(s_g[tid]); }
        __syncthreads();
    }
}
__device__ __forceinline__ int build_tile_table(LAS unsigned char* lds, const unsigned* __restrict__ cnt) {
    LAS int* tab = (LAS int*)(lds + TAB_OFF); LAS int* tabn = (LAS int*)(lds + TABN_OFF);
    const int tid = phase_tid();
    if (tid < NE) {
        int bacc = 0, sacc_small = 0, sacc = 0, mine = 0, nbig_all = 0, nsmall_all = 0;
        for (int e = 0; e < NE; ++e) { const int n = (int)cnt[e], full = n / BM, rem = n % BM, nb = full + (rem > HALF ? 1 : 0), ns = (rem > 0 && rem <= HALF) ? 1 : 0;
            if (e == tid) mine = n; if (e < tid) { bacc += nb; sacc_small += ns; sacc += n; } nbig_all += nb; nsmall_all += ns; }
        const int full = mine / BM, rem = mine % BM, nb = full + (rem > HALF ? 1 : 0);
        for (int j = 0; j < nb; ++j) { const int ti = bacc + j; if (ti < TAB_MAX) { tab[ti * 4 + 0] = tid; tab[ti * 4 + 1] = j * BM; tab[ti * 4 + 2] = min(BM, mine - j * BM); tab[ti * 4 + 3] = sacc + j * BM; } }
        if (rem > 0 && rem <= HALF) { const int ti = nbig_all + sacc_small; if (ti < TAB_MAX) { tab[ti * 4 + 0] = tid; tab[ti * 4 + 1] = full * BM; tab[ti * 4 + 2] = rem; tab[ti * 4 + 3] = sacc + full * BM; } }
        if (tid == NE - 1) tabn[0] = min(nbig_all + nsmall_all, TAB_MAX);
    }
    __syncthreads();
    return __builtin_amdgcn_readfirstlane(tabn[0]);
}
template <bool FINAL> __device__ __forceinline__ void ph_combine(const Part P, const bf16_t* __restrict__ X, const unsigned char* __restrict__ YS, const unsigned* __restrict__ cnt, const unsigned* __restrict__ asg,
                                                                 bf16_t* __restrict__ Xo, float* __restrict__ rs, const float* __restrict__ g, float* __restrict__ out) {
    const int tid = phase_tid(), lane = tid & 63, gw = (P.j * NT + tid) >> 6, ngw = (P.nb * NT) >> 6;
    unsigned c = lane < NE ? cnt[lane] : 0u, inc = c;
#pragma unroll
    for (int o = 1; o < 32; o <<= 1) { const unsigned t = __shfl_up(inc, o); if (lane >= o) inc += t; }
    const unsigned excl = inc - c;
    for (int rowl = gw; rowl < P.nrows; rowl += 2 * ngw) {
        int rows[2]; rows[0] = P.base_row + rowl; rows[1] = (rowl + ngw < P.nrows) ? P.base_row + rowl + ngw : rows[0];
        unsigned sa[2], sb[2];
#pragma unroll
        for (int q = 0; q < 2; ++q) { const u32x4 cw = *(const u32x4*)(asg + (size_t)rows[q] * 4); sa[q] = __shfl(excl, (int)(cw.x >> 24)) + (cw.x & 0xffffffu); sb[q] = __shfl(excl, (int)(cw.z >> 24)) + (cw.z & 0xffffffu); }
        u32x4 xr[2][2]; u32x2 ar[2][2], br[2][2];
#pragma unroll
        for (int q = 0; q < 2; ++q)
#pragma unroll
            for (int h = 0; h < 2; ++h) { xr[q][h] = __builtin_nontemporal_load((const u32x4*)(X + (size_t)rows[q] * D + h * 512 + lane * 8)); ar[q][h] = __builtin_nontemporal_load((const u32x2*)(YS + (size_t)sa[q] * D + h * 512 + lane * 8)); br[q][h] = __builtin_nontemporal_load((const u32x2*)(YS + (size_t)sb[q] * D + h * 512 + lane * 8)); }
#pragma unroll
        for (int q = 0; q < 2; ++q) {
            if (q == 1 && rows[1] == rows[0]) break;
            const int row = rows[q];
            float v[16];
#pragma unroll
            for (int h = 0; h < 2; ++h) { float x8[8], a[8], b[8]; unpack8(xr[q][h], x8); unpack8_fp8(ar[q][h], a); unpack8_fp8(br[q][h], b);
#pragma unroll
                for (int i = 0; i < 8; ++i) v[h * 8 + i] = x8[i] + (a[i] + b[i]) * (1.0f / 16.0f); }
            if (!FINAL) {
                float ss = 0.f;
#pragma unroll
                for (int h = 0; h < 2; ++h) { float o8[8];
#pragma unroll
                    for (int i = 0; i < 8; ++i) { o8[i] = bf2f(f2bf(v[h * 8 + i])); ss += o8[i] * o8[i]; }
                    *(u32x4*)(Xo + (size_t)row * D + h * 512 + lane * 8) = pack8(o8); }
                const float r = rsqrtf(wave_sum(ss) * (1.0f / D) + EPS);
                if (lane == 0) rs[row] = r;
            } else {
                float ss = 0.f;
#pragma unroll
                for (int i = 0; i < 16; ++i) ss += v[i] * v[i];
                const float r = rsqrtf(wave_sum(ss) * (1.0f / D) + EPS);
#pragma unroll
                for (int h = 0; h < 2; ++h) { const f32x4 g0 = *(const f32x4*)(g + h * 512 + lane * 8), g1 = *(const f32x4*)(g + h * 512 + lane * 8 + 4);
                    f32x4 o0, o1; o0.x = v[h * 8 + 0] * r * g0.x; o0.y = v[h * 8 + 1] * r * g0.y; o0.z = v[h * 8 + 2] * r * g0.z; o0.w = v[h * 8 + 3] * r * g0.w;
                    o1.x = v[h * 8 + 4] * r * g1.x; o1.y = v[h * 8 + 5] * r * g1.y; o1.z = v[h * 8 + 6] * r * g1.z; o1.w = v[h * 8 + 7] * r * g1.w;
                    __builtin_nontemporal_store(o0, (f32x4*)(out + (size_t)row * D + h * 512 + lane * 8)); __builtin_nontemporal_store(o1, (f32x4*)(out + (size_t)row * D + h * 512 + lane * 8 + 4)); }
            }
        }
    }
}
constexpr int MIX_PITCH = 272, MIX_BUF = CHUNK * MIX_PITCH, MIX_STAT_OFF = 2 * MIX_BUF;
typedef short s16x4 __attribute__((ext_vector_type(4)));
__device__ __forceinline__ void ph_mix(const Part P, LAS unsigned char* lds, const bf16_t* __restrict__ UV, const f32x2* __restrict__ lnp, const float* __restrict__ vg, const float* __restrict__ vbeta,
                                       const bf16_t* __restrict__ wm, const float* __restrict__ bs, bf16_t* __restrict__ YM) {
    const int tid = phase_tid(), wave = tid >> 6, lane = tid & 63, fr = lane & 15, fq = lane >> 4, wt = wave >> 1, wd = wave & 1;
    LAS float* stat = (LAS float*)(lds + MIX_STAT_OFF);
    const int ch = tid & 15, srow = tid >> 4;
    const int cgrp = ch >> 2, ca = ch & 3;
    for (int bcl = P.j; bcl < P.nrows / CHUNK; bcl += P.nb) {
        const int row0 = P.base_row + bcl * CHUNK;
        if (tid < CHUNK) { const f32x4* pp = (const f32x4*)(lnp + (size_t)(row0 + tid) * 16); float sm = 0.f, sq = 0.f;
#pragma unroll
            for (int i = 0; i < 8; ++i) { const f32x4 pv = pp[i]; sm += pv.x + pv.z; sq += pv.y + pv.w; }
            const float mu = sm * (1.0f / D), var = fmaxf(sq * (1.0f / D) - mu * mu, 0.f);
            stat[2 * tid] = mu; stat[2 * tid + 1] = rsqrtf(var + EPS); }
        __syncthreads();
        u32x4 vraw[4];
#pragma unroll
        for (int p = 0; p < 4; ++p) vraw[p] = __builtin_nontemporal_load((const u32x4*)(UV + (size_t)T * D + (size_t)(row0 + srow + 32 * p) * D + 0 * 128 + 8 * ch));
#pragma unroll 1
        for (int h = 0; h < NH; ++h) {
            LAS unsigned char* buf = lds + (h & 1) * MIX_BUF;
            float g8[8], b8[8];
            { const f32x4 ga = *(const f32x4*)(vg + h * 128 + 8 * ch), gb = *(const f32x4*)(vg + h * 128 + 8 * ch + 4), ba = *(const f32x4*)(vbeta + h * 128 + 8 * ch), bb = *(const f32x4*)(vbeta + h * 128 + 8 * ch + 4);
              g8[0] = ga.x; g8[1] = ga.y; g8[2] = ga.z; g8[3] = ga.w; g8[4] = gb.x; g8[5] = gb.y; g8[6] = gb.z; g8[7] = gb.w;
              b8[0] = ba.x; b8[1] = ba.y; b8[2] = ba.z; b8[3] = ba.w; b8[4] = bb.x; b8[5] = bb.y; b8[6] = bb.z; b8[7] = bb.w; }
#pragma unroll
            for (int p = 0; p < 4; ++p) { const int sr = srow + 32 * p; float v[8]; unpack8(vraw[p], v);
                const float mu = stat[2 * sr], rstd = stat[2 * sr + 1];
#pragma unroll
                for (int q = 0; q < 8; ++q) v[q] = (v[q] - mu) * rstd * g8[q] + b8[q];
                u32x2 lo, hi; lo.x = pk2(v[0], v[1]); lo.y = pk2(v[2], v[3]); hi.x = pk2(v[4], v[5]); hi.y = pk2(v[6], v[7]);
                *(LAS u32x2*)(buf + sr * MIX_PITCH + (32 * cgrp + 4 * ca) * 2) = lo; *(LAS u32x2*)(buf + sr * MIX_PITCH + (32 * cgrp + 16 + 4 * ca) * 2) = hi; }
            __syncthreads();
            if (h + 1 < NH) {
#pragma unroll
                for (int p = 0; p < 4; ++p) vraw[p] = __builtin_nontemporal_load((const u32x4*)(UV + (size_t)T * D + (size_t)(row0 + srow + 32 * p) * D + (h + 1) * 128 + 8 * ch)); }
            u32x4 uraw[2][2]; float bsv[2];
#pragma unroll
            for (int m = 0; m < 2; ++m) { const int t = 32 * wt + 16 * m + fr; bsv[m] = bs[h * CHUNK + t];
#pragma unroll
                for (int cc = 0; cc < 2; ++cc) uraw[m][cc] = __builtin_nontemporal_load((const u32x4*)(UV + (size_t)(row0 + t) * D + h * 128 + 32 * (2 * wd + cc) + 8 * fq)); }
            bf16x8 af[4][2];
#pragma unroll
            for (int kk = 0; kk < 4; ++kk)
#pragma unroll
                for (int m = 0; m < 2; ++m) af[kk][m] = *(const bf16x8*)(wm + ((size_t)(h * CHUNK + 32 * wt + 16 * m + fr)) * CHUNK + 32 * (kk <= wt ? kk : wt) + 8 * fq);
            f32x4 acc[2][4];
#pragma unroll
            for (int m = 0; m < 2; ++m)
#pragma unroll
                for (int n = 0; n < 4; ++n) acc[m][n] = (f32x4){0.f, 0.f, 0.f, 0.f};
            const int q4 = (lane & 15) >> 2, p4 = lane & 3;
#pragma unroll
            for (int kk = 0; kk < 4; ++kk) {
                if (kk <= wt) {
#pragma unroll
                    for (int n = 0; n < 4; ++n) {
                        const int colpos = 32 * (2 * wd + (n >> 1)) + 16 * (n & 1);
                        LAS unsigned char* base = buf + (32 * kk + 8 * fq + q4) * MIX_PITCH + colpos * 2 + 8 * p4;
                        const s16x4 t0 = __builtin_amdgcn_ds_read_tr16_b64_v4i16((LAS s16x4*)base);
                        const s16x4 t1 = __builtin_amdgcn_ds_read_tr16_b64_v4i16((LAS s16x4*)(base + 4 * MIX_PITCH));
                        bf16x8 bfrag; bfrag[0] = t0[0]; bfrag[1] = t0[1]; bfrag[2] = t0[2]; bfrag[3] = t0[3]; bfrag[4] = t1[0]; bfrag[5] = t1[1]; bfrag[6] = t1[2]; bfrag[7] = t1[3];
#pragma unroll
                        for (int m = 0; m < 2; ++m) acc[m][n] = __builtin_amdgcn_mfma_f32_16x16x32_bf16(bfrag, af[kk][m], acc[m][n], 0, 0, 0);
                    }
                }
            }
#pragma unroll
            for (int m = 0; m < 2; ++m) { const int t = 32 * wt + 16 * m + fr;
#pragma unroll
                for (int cc = 0; cc < 2; ++cc) { const int col = h * 128 + 32 * (2 * wd + cc) + 8 * fq; float u8[8], o8[8];
                    unpack8(uraw[m][cc], u8);
#pragma unroll
                    for (int n = 0; n < 2; ++n)
#pragma unroll
                        for (int r = 0; r < 4; ++r) o8[4 * n + r] = u8[4 * n + r] * (acc[m][2 * cc + n][r] + bsv[m]);
                    *(u32x4*)(YM + (size_t)(row0 + t) * D + col) = pack8(o8); } }
        }
        __syncthreads();
    }
}

#define XB_TMO      128
#define XB_XCNT(j)  (256  + 64 * (j))
#define XB_XSUB(j)  (1280 + 64 * (j))
#define XB_XGEN(j)  (2304 + 64 * (j))
#define XB_TOP      3328
#define XB_TOPGEN   3392
#define XCD_BAR_WORDS 3456
#define XB_SPIN_CAP (1u << 22)
__device__ __forceinline__ unsigned xb_ld(unsigned* p)              { return __hip_atomic_load(p, __ATOMIC_RELAXED, __HIP_MEMORY_SCOPE_AGENT); }
__device__ __forceinline__ unsigned xb_add(unsigned* p, unsigned v) { return __hip_atomic_fetch_add(p, v, __ATOMIC_RELAXED, __HIP_MEMORY_SCOPE_AGENT); }
__device__ __forceinline__ unsigned xb_xcc_id() { return (unsigned)__builtin_amdgcn_s_getreg((3 << 11) | 20) & 0xFu; }
#define XB_SPIN(cond, bar) do { unsigned _sp = 0; while (cond) { __builtin_amdgcn_s_sleep(1); \
    if ((++_sp & 255u) == 0u) { if (xb_ld(&(bar)[XB_TMO])) break; if (_sp > XB_SPIN_CAP) { atomicAdd(&(bar)[XB_TMO], 1u); break; } } } } while (0)
struct XcdBarrier { unsigned* bar; unsigned x; volatile LAS unsigned* st; };
__device__ __forceinline__ XcdBarrier xcd_barrier_post(unsigned* bar, volatile LAS unsigned* st) {
    XcdBarrier b; b.bar = bar; b.x = xb_xcc_id(); b.st = st;
    if (threadIdx.x == 0) st[2] = xb_add(&bar[XB_XCNT(b.x)], 1u);
    return b;
}
__device__ __forceinline__ void xcd_barrier_complete(unsigned* bar, unsigned x, unsigned& nloc, unsigned& nx) {
    const unsigned G = gridDim.x * gridDim.y * gridDim.z;
    unsigned sum, cnt, mine, sp = 0u;
    for (;;) {
        sum = 0u; cnt = 0u; mine = 0u;
#pragma unroll
        for (unsigned j = 0; j < 16; ++j) { const unsigned c = xb_ld(&bar[XB_XCNT(j)]); sum += c; cnt += (c > 0u) ? 1u : 0u; mine = (j == x) ? c : mine; }
        if (sum == G) break;
        __builtin_amdgcn_s_sleep(1);
        if ((++sp & 255u) == 0u) { if (xb_ld(&bar[XB_TMO])) break; if (sp > XB_SPIN_CAP) { atomicAdd(&bar[XB_TMO], 1u); break; } }
    }
    nloc = mine > 0u ? mine : 1u; nx = cnt > 0u ? cnt : 1u;
}
__device__ __forceinline__ void xcd_barrier(const XcdBarrier& b) {
    asm volatile("s_waitcnt vmcnt(0)" ::: "memory");
    __syncthreads();
    if (threadIdx.x == 0) {
        unsigned* bar = b.bar;
        __builtin_amdgcn_s_waitcnt(0);
        unsigned nloc = b.st[0], nx = b.st[1];
        if (nloc == 0u) { xcd_barrier_complete(bar, b.x, nloc, nx); b.st[0] = nloc; b.st[1] = nx; }
        const unsigned old = xb_add(&bar[XB_XSUB(b.x)], 1u);
        const unsigned gen = old / nloc;
        if (old + 1u == (gen + 1u) * nloc) {
            __builtin_amdgcn_fence(__ATOMIC_RELEASE, "agent");
            asm volatile("s_waitcnt vmcnt(0)" ::: "memory");
            const unsigned og = xb_add(&bar[XB_TOP], 1u);
            const unsigned tg = og / nx;
            if (og + 1u == (tg + 1u) * nx) xb_add(&bar[XB_TOPGEN], 1u);
            else XB_SPIN(xb_ld(&bar[XB_TOPGEN]) == tg, bar);
            __builtin_amdgcn_fence(__ATOMIC_ACQUIRE, "agent");
            xb_add(&bar[XB_XGEN(b.x)], 1u);
            asm volatile("s_waitcnt vmcnt(0)" ::: "memory");
        } else {
            XB_SPIN(xb_ld(&bar[XB_XGEN(b.x)]) == gen, bar);
            __builtin_amdgcn_fence(__ATOMIC_ACQUIRE, "agent");
            asm volatile("s_waitcnt vmcnt(0)" ::: "memory");
        }
    }
    __syncthreads();
}

#define XB_LSUB(j)  (3520 + 64 * (j))
#define XB_LGEN(j)  (4544 + 64 * (j))
__device__ __forceinline__ void xcd_local_barrier(const XcdBarrier& b, const unsigned nloc) {
    asm volatile("s_waitcnt vmcnt(0)" ::: "memory");
    __syncthreads();
    if (threadIdx.x == 0) {
        unsigned* bar = b.bar;
        __builtin_amdgcn_s_waitcnt(0);
        const unsigned old = xb_add(&bar[XB_LSUB(b.x)], 1u);
        const unsigned gen = old / nloc;
        if (old + 1u == (gen + 1u) * nloc) xb_add(&bar[XB_LGEN(b.x)], 1u);
        else XB_SPIN(xb_ld(&bar[XB_LGEN(b.x)]) == gen, bar);
        __builtin_amdgcn_fence(__ATOMIC_ACQUIRE, "agent");
        asm volatile("s_waitcnt vmcnt(0)" ::: "memory");
    }
    __syncthreads();
}

#define GSYNC() xcd_barrier(xbar)
struct Params { const float* in[22]; float* out; unsigned char* ws; };
__global__ void __launch_bounds__(NT, 2) mega_fwd(Params P) {
    extern __shared__ __attribute__((aligned(16))) unsigned char lds_raw[];
    LAS unsigned char* lds = (LAS unsigned char*)lds_raw;
    cg::grid_group grid = cg::this_grid();
    const int G = (int)gridDim.x, bid = (int)blockIdx.x;
    if (P.ws == nullptr) grid.sync();
    if (threadIdx.x < 4) ((LAS unsigned*)(lds + BARST_OFF))[threadIdx.x] = 0u;
    __syncthreads();
    const XcdBarrier xbar = xcd_barrier_post((unsigned*)(P.ws + WS_CTL) + CW_BAR, (volatile LAS unsigned*)(lds + BARST_OFF));
    const float* x = P.in[0]; const float* ln_a = P.in[1]; const float* w_in_a = P.in[2]; const float* conv_w = P.in[3];
    const float* w_out_a = P.in[4]; const float* ln_b = P.in[5]; const float* w_in_b = P.in[6]; const float* b_in_b = P.in[7];
    const float* v_ln_g = P.in[8]; const float* v_ln_b = P.in[9]; const float* w_s = P.in[10]; const float* b_s = P.in[11];
    const float* w_out_b = P.in[12]; const float* ln2 = P.in[13]; const float* w_group = P.in[14]; const float* b_group = P.in[15];
    const float* w_expert = P.in[16]; const float* b_expert = P.in[17]; const float* w_gate = P.in[18]; const float* w_up = P.in[19];
    const float* w_down = P.in[20]; const float* ln_f = P.in[21];
    unsigned char* ws = P.ws; float* out = P.out;
    unsigned* ctl = (unsigned*)(ws + WS_CTL); float* RS = (float*)(ws + WS_RS); unsigned* ASG = (unsigned*)(ws + WS_ASG); float* LNS = (float*)(ws + WS_LNS);
    int* LTOK = (int*)(ws + WS_LTOK); float* LGATE = (float*)(ws + WS_LGATE); float* LRS = (float*)(ws + WS_LRS); bf16_t* WR = (bf16_t*)(ws + WS_WR); bf16_t* WM = (bf16_t*)(ws + WS_WM);
    bf16_t* WA_IN = (bf16_t*)(ws + WS_WA_IN); bf16_t* WA_OUT = (bf16_t*)(ws + WS_WA_OUT); bf16_t* WB_IN = (bf16_t*)(ws + WS_WB_IN); bf16_t* WB_OUT = (bf16_t*)(ws + WS_WB_OUT);
    unsigned char* WGU = ws + WS_WGU; unsigned char* WD = ws + WS_WD; unsigned char* XQ = ws + WS_XQ;
    bf16_t* bufA = (bf16_t*)(ws + WS_A); bf16_t* bufB = (bf16_t*)(ws + WS_B); bf16_t* bufC = (bf16_t*)(ws + WS_C); bf16_t* bufD = (bf16_t*)(ws + WS_D);

    int vb = bid; bool loc = false; unsigned nloc = 1u;
    Part part{0, T, bid, G};
#define DENSE_GEMM(EPI_T, epi_init, Aptr, Bptr, NCOLS) do { DenseSched S{T / BM, (NCOLS) / BM, G, vb, D, (Bptr)}; EPI_T E epi_init; gemm_phase<EPI_T, DenseSched>(lds, (Aptr), D, S, E); } while (0)
#define LSYNC() do { if (loc) xcd_local_barrier(xbar, nloc); else xcd_barrier(xbar); } while (0)
#define MOE_PHASES(layer, Xin, Hb) do { \
        unsigned* cnt_ = ctl + CW_CNT + (layer) * NE; \
        ph_route(part, lds, (Xin), WR + (size_t)(layer) * 2 * 48 * D, b_group + (layer) * NG, b_expert + (layer) * NE, cnt_, ASG, LTOK, LGATE, LRS); \
        GSYNC(); \
        { const int ntm = build_tile_table(lds, cnt_); \
          { MoeSched<true> S{ntm, G, vb, D / 2, WGU, LTOK, (const LAS int*)(lds + TAB_OFF), LRS}; EpiG3 E{LRS, (unsigned char*)(Hb)}; gemm_phase<EpiG3, MoeSched<true>, true>(lds, (const bf16_t*)XQ, D / 2, S, E); } \
          LSYNC(); \
          { MoeSched<false> S{ntm, G, vb, F / 2, WD, LTOK, (const LAS int*)(lds + TAB_OFF), LGATE}; EpiG4 E{LGATE, (unsigned char*)bufA}; gemm_phase<EpiG4, MoeSched<false>, true>(lds, (const bf16_t*)(Hb), F / 2, S, E); } } \
        GSYNC(); } while (0)

    ph_prep_x(x, ln_a, bufB, RS);
    ph_transpose<false>(lds, w_in_a, D, 3 * D, WA_IN, 1, nullptr, 1, 0, 0, 0);
    ph_transpose<false>(lds, w_out_a, D, D, WA_OUT, 0, nullptr, 1, 0, 0, 768);
    ph_transpose<false>(lds, w_in_b, D, 2 * D, WB_IN, 0, ln_b, 1, 0, 0, 1024);
    ph_transpose<false>(lds, w_out_b, D, D, WB_OUT, 0, nullptr, 1, 0, 0, 1536);
    ph_prep_router(ln2, w_group, w_expert, WR);
    ph_prep_wm(w_s, WM);
    ph_prep_experts(lds, 0, w_gate, w_up, w_down, ln2, WGU, WD);
    GSYNC();
    {
        unsigned okc = 0u, bad = 0u;
#pragma unroll
        for (unsigned j = 0; j < 16; ++j) { const unsigned cn = xb_ld((unsigned*)(ws + WS_CTL) + CW_BAR + XB_XCNT(j)); if (cn == 32u && j < 8u) ++okc; else if (cn != 0u) ++bad; }
        const unsigned rank = ((volatile LAS unsigned*)(lds + BARST_OFF))[2];
        loc = (G == 256) && (okc == 8u) && (bad == 0u) && (xbar.x < 8u) && (rank < 32u);
        if (loc) { vb = (int)(rank * 8u + xbar.x); nloc = 32u; part = Part{(vb & 7) * SEQ, SEQ, vb >> 3, 32}; }
    }
    DENSE_GEMM(EpiG1, {bufA}, bufB, WA_IN, 3 * D);
    LSYNC();
    ph_conv(part, bufA, conv_w, bufC);
    LSYNC();
    DENSE_GEMM(EpiRes<true>, ({bufB, bufD, XQ, RS, ln_a}), bufC, WA_OUT, D);
    LSYNC();
    MOE_PHASES(0, bufD, bufB);
    ph_combine<false>(part, bufD, (const unsigned char*)bufA, ctl + CW_CNT, ASG, bufC, RS, nullptr, nullptr);
    ph_prep_experts(lds, 1, w_gate, w_up, w_down, ln2, WGU, WD);
    LSYNC();
    DENSE_GEMM(EpiG5, ({RS, b_in_b, bufA, (f32x2*)(ws + WS_LNP)}), bufC, WB_IN, 2 * D);
    LSYNC();
    ph_mix(part, lds, bufA, (const f32x2*)(ws + WS_LNP), v_ln_g, v_ln_b, WM, b_s, bufD);
    LSYNC();
    DENSE_GEMM(EpiRes<false>, ({bufC, bufB, XQ, nullptr, nullptr}), bufD, WB_OUT, D);
    LSYNC();
    MOE_PHASES(1, bufB, bufC);
    ph_combine<true>(part, bufB, (const unsigned char*)bufA, ctl + CW_CNT + NE, ASG, nullptr, nullptr, ln_f, out);
}
}

extern "C" void kernel_launch(void* const* d_in, const int* in_sizes, int n_in, void* d_out, int out_size, void* d_ws, size_t ws_size, hipStream_t stream) {
    if (n_in != 22 || ws_size < WS_END) { fprintf(stderr, "kernel_launch: unexpected n_in %d / ws_size %zu\n", n_in, ws_size); return; }
    static int grid_blocks = 0;
    if (!grid_blocks) {
        int dev = 0, cus = 0, per_cu = 0;
        (void)hipGetDevice(&dev);
        (void)hipDeviceGetAttribute(&cus, hipDeviceAttributeMultiprocessorCount, dev);
        (void)hipFuncSetAttribute((const void*)mega_fwd, hipFuncAttributeMaxDynamicSharedMemorySize, LDS_BYTES);
        (void)hipOccupancyMaxActiveBlocksPerMultiprocessor(&per_cu, (const void*)mega_fwd, NT, LDS_BYTES);
        if (per_cu < 1) fprintf(stderr, "kernel_launch: occupancy query says %d blocks per CU\n", per_cu);
        grid_blocks = cus;
    }
    (void)hipMemsetAsync((unsigned char*)d_ws + WS_CTL, 0, CTL_BYTES, stream);
    Params p{};
    for (int i = 0; i < 22; ++i) p.in[i] = (const float*)d_in[i];
    p.out = (float*)d_out; p.ws = (unsigned char*)d_ws;
    void* args[] = {&p};
    hipError_t e = hipLaunchCooperativeKernel((const void*)mega_fwd, dim3(grid_blocks), dim3(NT), args, LDS_BYTES, stream);
    if (e != hipSuccess) fprintf(stderr, "cooperative launch failed: %s (grid %d)\n", hipGetErrorString(e), grid_blocks);
}
```

```cpp
#include <hip/hip_runtime.h>
#include <hip/hip_cooperative_groups.h>
#include <cstdint>
#include <cstdio>

namespace cg = cooperative_groups;
namespace {
#define LAS __attribute__((address_space(3)))
typedef unsigned short bf16_t;
typedef short bf16x8 __attribute__((ext_vector_type(8)));
typedef float f32x4 __attribute__((ext_vector_type(4)));
typedef float f32x2 __attribute__((ext_vector_type(2)));
typedef unsigned u32x4 __attribute__((ext_vector_type(4)));
typedef unsigned u32x2 __attribute__((ext_vector_type(2)));

constexpr int BATCH = 8, SEQ = 4096, D = 1024, T = BATCH * SEQ;
constexpr int NE = 32, NG = 4, F = 512, CHUNK = 128, NH = 8;
constexpr float EPS = 1e-6f;
constexpr int NT = 512, NWAVES = 8;

constexpr size_t MiB = 1u << 20;
constexpr size_t WS_CTL = 0;
constexpr size_t CTL_BYTES = 65536;
constexpr size_t WS_RS = 1 * MiB;
constexpr size_t WS_ASG = 1 * MiB + 512 * 1024;
constexpr size_t WS_LNS = 2 * MiB;
constexpr size_t WS_WR = 2 * MiB + 512 * 1024;
constexpr size_t WS_WM = 3 * MiB;
constexpr size_t WS_LTOK = 4 * MiB;
constexpr size_t WS_LNP = 112 * MiB;
constexpr size_t WS_LGATE = 8 * MiB;
constexpr size_t WS_LRS = 12 * MiB;
constexpr size_t WS_WA_IN = 16 * MiB;
constexpr size_t WS_WA_OUT = 22 * MiB;
constexpr size_t WS_WB_IN = 24 * MiB;
constexpr size_t WS_WB_OUT = 28 * MiB;
constexpr size_t WS_WGU = 32 * MiB;
constexpr size_t WS_WD = 64 * MiB;
constexpr size_t WS_XQ = 80 * MiB;
constexpr size_t WS_A = 128 * MiB;
constexpr size_t WS_B = 256 * MiB;
constexpr size_t WS_C = 320 * MiB;
constexpr size_t WS_D = 384 * MiB;
constexpr size_t WS_END = 449 * MiB;
constexpr size_t WS_WGU1 = 449 * MiB;
constexpr size_t WS_WD1 = 481 * MiB;
constexpr size_t WS_END2 = 497 * MiB;
constexpr int CW_CNT = 0;
constexpr int CW_BAR = 4096;

constexpr int RING_BYTES = 131072;
constexpr int TAB_OFF = RING_BYTES;
constexpr int TAB_MAX = 320;
constexpr int TABN_OFF = TAB_OFF + TAB_MAX * 16;
constexpr int BARST_OFF = TABN_OFF + 16;
constexpr int TOKTAB_OFF = RING_BYTES + 8192;
constexpr int SCTAB_OFF = TOKTAB_OFF + 2048;
constexpr int LDS_BYTES = 147456;

__device__ __forceinline__ float bf2f(unsigned b) { return __uint_as_float(b << 16); }
__device__ __forceinline__ unsigned f2bf(float f) { unsigned u = __float_as_uint(f); return (u + 0x7fffu + ((u >> 16) & 1u)) >> 16; }
__device__ __forceinline__ unsigned pk2(float lo, float hi) { return f2bf(lo) | (f2bf(hi) << 16); }
__device__ __forceinline__ unsigned cvt_pk_bf16(float lo, float hi) { unsigned r; asm volatile("v_cvt_pk_bf16_f32 %0, %1, %2" : "=v"(r) : "v"(lo), "v"(hi)); return r; }
__device__ __forceinline__ float wave_sum(float v) {
#pragma unroll
    for (int o = 1; o < 64; o <<= 1) v += __shfl_xor(v, o);
    return v;
}
__device__ __forceinline__ void unpack8(const u32x4 v, float (&f)[8]) {
    f[0] = bf2f(v.x & 0xffffu); f[1] = bf2f(v.x >> 16); f[2] = bf2f(v.y & 0xffffu); f[3] = bf2f(v.y >> 16);
    f[4] = bf2f(v.z & 0xffffu); f[5] = bf2f(v.z >> 16); f[6] = bf2f(v.w & 0xffffu); f[7] = bf2f(v.w >> 16);
}
__device__ __forceinline__ u32x4 pack8(const float (&f)[8]) {
    u32x4 o; o.x = pk2(f[0], f[1]); o.y = pk2(f[2], f[3]); o.z = pk2(f[4], f[5]); o.w = pk2(f[6], f[7]); return o;
}
__device__ __forceinline__ float gelu_tanh(float x) {
    const float x2 = x * x;
    const float t = x * (x2 * (-0.044715f * 2.0f * 0.7978845608028654f * 1.4426950408889634f) + (-2.0f * 0.7978845608028654f * 1.4426950408889634f));
    return x * __builtin_amdgcn_rcpf(1.0f + __builtin_amdgcn_exp2f(t));
}
__device__ __forceinline__ float silu(float x) { return x * __builtin_amdgcn_rcpf(1.0f + __builtin_amdgcn_exp2f(x * -1.4426950408889634f)); }
#define LDS_WAIT() asm volatile("s_waitcnt lgkmcnt(0)" ::: "memory")
__device__ __forceinline__ float clamp_fp8(float v) { return __builtin_amdgcn_fmed3f(v, -448.0f, 448.0f); }
__device__ __forceinline__ unsigned pk4_fp8(float a, float b, float c, float d) { unsigned w = 0u; a = clamp_fp8(a); b = clamp_fp8(b); c = clamp_fp8(c); d = clamp_fp8(d); w = __builtin_amdgcn_cvt_pk_fp8_f32(a, b, w, false); w = __builtin_amdgcn_cvt_pk_fp8_f32(c, d, w, true); return w; }
__device__ __forceinline__ void unpack8_fp8(const u32x2 v, float (&f)[8]) {
    const f32x2 a = __builtin_amdgcn_cvt_pk_f32_fp8(v.x, false), b = __builtin_amdgcn_cvt_pk_f32_fp8(v.x, true), c = __builtin_amdgcn_cvt_pk_f32_fp8(v.y, false), d = __builtin_amdgcn_cvt_pk_f32_fp8(v.y, true);
    f[0] = a.x; f[1] = a.y; f[2] = b.x; f[3] = b.y; f[4] = c.x; f[5] = c.y; f[6] = d.x; f[7] = d.y;
}
typedef int i32x8 __attribute__((ext_vector_type(8)));
typedef int i32x4 __attribute__((ext_vector_type(4)));
__device__ __forceinline__ int phase_tid() { int t = (int)threadIdx.x; asm volatile("" : "+v"(t)); return t; }

constexpr int BM = 256, BK = 64, HALF = 128, HTB = HALF * BK * 2, NXCD = 8, WGM = 8;
__device__ __forceinline__ int lds_byte(int r, int c) { const int st = (r >> 4) * 2 + (c >> 5), rr = r & 15, cc = c & 31, ob = rr * 64 + cc * 2; return st * 1024 + (ob ^ (((ob >> 9) & 1) << 5)); }
__device__ __forceinline__ void stage_rc(int b, int& R, int& C) { const int st = b / 1024, sb = b % 1024, swz = sb ^ (((sb >> 9) & 1) << 5); R = (st >> 1) * 16 + swz / 64; C = (st & 1) * 32 + (swz % 64) / 2; }
__device__ __forceinline__ int perm32(int rho) { const int n = rho >> 4, i = rho & 15; return 8 * (i >> 2) + 4 * n + (i & 3); }

struct Unit { int pm, pn, e, row0, nrows, slot0; };
__device__ __forceinline__ bool order_next(int i, int G, int c, int nM, int nN, int& pm, int& pn) {
    const int nwg = nM * nN; const long L = (long)i * G + c; if (L >= nwg) return false;
    int wgid = (int)L; { const int q = nwg / NXCD, r = nwg % NXCD, xcd = wgid % NXCD, off = wgid / NXCD; wgid = (xcd < r ? xcd * (q + 1) : r * (q + 1) + (xcd - r) * q) + off; }
    const int wgm = (nN == 8) ? 4 : WGM;
    const int nig = wgm * nN, gid = wgid / nig, fm = gid * wgm, gsz = (nM - fm) < wgm ? (nM - fm) : wgm;
    pm = fm + ((wgid % nig) % gsz); pn = (wgid % nig) / gsz; return true;
}
struct DenseSched {
    static constexpr bool ROWTAB = false, GATHER_IDS = false;
    int nM, nN, G, c, K; const bf16_t* Bt;
    __device__ __forceinline__ bool next(int i, Unit& u) const { u.e = 0; u.row0 = 0; u.nrows = BM; u.slot0 = 0; return order_next(i, G, c, nM, nN, u.pm, u.pn); }
    __device__ __forceinline__ void aoff(const Unit& u, int tid, unsigned (&v)[2][2]) const {
        int R[2], C[2]; stage_rc(tid * 16, R[0], C[0]); stage_rc(tid * 16 + 8192, R[1], C[1]);
#pragma unroll
        for (int h = 0; h < 2; ++h)
#pragma unroll
            for (int i = 0; i < 2; ++i) v[h][i] = (unsigned)((u.pm * BM + h * HALF + R[i]) * K + C[i]) * 2u;
    }
    __device__ __forceinline__ const char* bptr(const Unit& u) const { return (const char*)Bt + (size_t)u.pn * BM * K * 2; }
};
struct G1FSched {
    static constexpr bool ROWTAB = false, GATHER_IDS = false;
    int G, c, K; const bf16_t* Bt; const float* rowscal; const int* ltok;
    __device__ __forceinline__ bool next(int i, Unit& u) const {
        if (i >= 6) return false;
        const int t = i / 3, k = i - 3 * t, x = c & 7, rank = c >> 3, tr = 32 * t + rank, q = tr & 3;
        u.pm = 16 * x + (tr >> 2); u.pn = (k == 2) ? 8 + q : 2 * q + k; u.e = 0; u.row0 = 0; u.nrows = BM; u.slot0 = 0; return true;
    }
    __device__ __forceinline__ void aoff(const Unit& u, int tid, unsigned (&v)[2][2]) const {
        int R[2], C[2]; stage_rc(tid * 16, R[0], C[0]); stage_rc(tid * 16 + 8192, R[1], C[1]);
#pragma unroll
        for (int h = 0; h < 2; ++h)
#pragma unroll
            for (int i = 0; i < 2; ++i) v[h][i] = (unsigned)((u.pm * BM + h * HALF + R[i]) * K + C[i]) * 2u;
    }
    __device__ __forceinline__ void aoff_lds(const LAS int*, int, unsigned (&)[2][2]) const {}
    __device__ __forceinline__ const char* bptr(const Unit& u) const { return (const char*)Bt + (size_t)u.pn * BM * K * 2; }
};
template <bool GATHER> struct MoeSched {
    static constexpr bool ROWTAB = true, GATHER_IDS = GATHER;
    int nM, G, c, K; const unsigned char* W; const int* ltok; const LAS int* tab; const float* rowscal;
    __device__ __forceinline__ bool next(int i, Unit& u) const {
        if (G == 256) { const int rt = i * 64 + 8 * (c & 7) + ((c >> 3) & 7); if (rt >= nM) return false; u.pm = rt; u.pn = c >> 6; }
        else if (!order_next(i, G, c, nM, 4, u.pm, u.pn)) return false;
        u.e = __builtin_amdgcn_readfirstlane(tab[u.pm * 4 + 0]); u.row0 = __builtin_amdgcn_readfirstlane(tab[u.pm * 4 + 1]); u.nrows = __builtin_amdgcn_readfirstlane(tab[u.pm * 4 + 2]); u.slot0 = __builtin_amdgcn_readfirstlane(tab[u.pm * 4 + 3]); return true;
    }
    __device__ __forceinline__ void aoff(const Unit& u, int tid, unsigned (&v)[2][2]) const {
        int R[2], C[2]; stage_rc(tid * 16, R[0], C[0]); stage_rc(tid * 16 + 8192, R[1], C[1]);
#pragma unroll
        for (int h = 0; h < 2; ++h)
#pragma unroll
            for (int i = 0; i < 2; ++i) {
                if (GATHER) { const int rr = min(h * HALF + R[i], u.nrows - 1); const int tok = ltok[(size_t)u.e * T + u.row0 + rr]; v[h][i] = (unsigned)(tok * K + C[i]) * 2u; }
                else v[h][i] = (unsigned)((u.slot0 + h * HALF + R[i]) * K + C[i]) * 2u;
            }
    }
    __device__ __forceinline__ void aoff_lds(const LAS int* toktab, int tid, unsigned (&v)[2][2]) const {
        int R[2], C[2]; stage_rc(tid * 16, R[0], C[0]); stage_rc(tid * 16 + 8192, R[1], C[1]);
#pragma unroll
        for (int h = 0; h < 2; ++h)
#pragma unroll
            for (int i = 0; i < 2; ++i) v[h][i] = (unsigned)(toktab[h * HALF + R[i]] * K + C[i]) * 2u;
    }
    __device__ __forceinline__ const char* bptr(const Unit& u) const { return (const char*)W + ((size_t)u.e * 1024 + (size_t)u.pn * BM) * K * 2; }
};

template <class Epi, class Sched, bool FP8 = false>
__device__ __forceinline__ void gemm_phase(LAS unsigned char* lds, const bf16_t* Abase, const int K, const Sched& S, const Epi& E) {
    const int tid = phase_tid(), wid = __builtin_amdgcn_readfirstlane(tid >> 6), lane = tid & 63, wr = wid >> 2, wc = wid & 3, fr = lane & 15, fq = lane >> 4;
    const int nt = K / BK;
    unsigned voffB[2];
#pragma unroll
    for (int i = 0; i < 2; ++i) { int sR, sC; stage_rc(tid * 16 + i * 8192, sR, sC);
        const int Rb = Epi::WIDE ? (64 * (sR >> 5) + 16 * ((sR & 15) >> 2) + 4 * ((sR >> 4) & 1) + (sR & 3)) : ((sR & ~31) + perm32(sR & 31)); voffB[i] = (unsigned)(Rb * K + sC) * 2u; }
    const size_t kstep = (size_t)(BK * 2);
    const size_t hstepB = (size_t)(Epi::WIDE ? 8 : HALF) * K * 2;
    const unsigned ldsw = (unsigned)wid * 1024u;
    const int aoff = lds_byte(wr * 64 + fr, fq * 8), boff = lds_byte(wc * 32 + fr, fq * 8);
#define PG8_SA(b, h) (((b) * 2 + (h)) * HTB)
#define PG8_SB(b, h) ((4 + (b) * 2 + (h)) * HTB)
#define PG8_STAGE(bufoff, gbase, voff) do { _Pragma("unroll") for (int _i = 0; _i < 2; ++_i) \
        __builtin_amdgcn_global_load_lds((const unsigned*)((const char*)(gbase) + (voff)[_i]), (LAS unsigned*)(lds + (bufoff) + ldsw + _i * 8192), 16, 0, 0); } while (0)
#define PG8_LDA(dst, b, h) do { _Pragma("unroll") for (int m = 0; m < 4; ++m) { \
        const i32x4 lo_ = *(const LAS i32x4*)(lds + PG8_SA(b, h) + aoff + m * 2048), hi_ = *(const LAS i32x4*)(lds + PG8_SA(b, h) + aoff + m * 2048 + 1024); \
        if constexpr (FP8) dst##8[m] = __builtin_shufflevector(lo_, hi_, 0, 1, 2, 3, 4, 5, 6, 7); else { dst[m][0] = __builtin_bit_cast(bf16x8, lo_); dst[m][1] = __builtin_bit_cast(bf16x8, hi_); } } } while (0)
#define PG8_LDB(dst, b, h) do { _Pragma("unroll") for (int n = 0; n < 2; ++n) { \
        const i32x4 lo_ = *(const LAS i32x4*)(lds + PG8_SB(b, h) + boff + n * 2048), hi_ = *(const LAS i32x4*)(lds + PG8_SB(b, h) + boff + n * 2048 + 1024); \
        if constexpr (FP8) dst##8[n] = __builtin_shufflevector(lo_, hi_, 0, 1, 2, 3, 4, 5, 6, 7); else { dst[n][0] = __builtin_bit_cast(bf16x8, lo_); dst[n][1] = __builtin_bit_cast(bf16x8, hi_); } } } while (0)
#define PG8_MMA(ai, bj, At, Bt) do { __builtin_amdgcn_s_setprio(1); \
        if constexpr (FP8) { \
            asm volatile("s_nop 1\n\t" \
                "v_mfma_f32_16x16x128_f8f6f4 %0, %8, %10, %0\n\t" "v_mfma_f32_16x16x128_f8f6f4 %1, %9, %10, %1\n\t" \
                "v_mfma_f32_16x16x128_f8f6f4 %2, %8, %11, %2\n\t" "v_mfma_f32_16x16x128_f8f6f4 %3, %9, %11, %3\n\t" \
                "v_mfma_f32_16x16x128_f8f6f4 %4, %8, %12, %4\n\t" "v_mfma_f32_16x16x128_f8f6f4 %5, %9, %12, %5\n\t" \
                "v_mfma_f32_16x16x128_f8f6f4 %6, %8, %13, %6\n\t" "v_mfma_f32_16x16x128_f8f6f4 %7, %9, %13, %7" \
                : "+v"(acc[ai][bj][0][0]), "+v"(acc[ai][bj][0][1]), "+v"(acc[ai][bj][1][0]), "+v"(acc[ai][bj][1][1]), \
                  "+v"(acc[ai][bj][2][0]), "+v"(acc[ai][bj][2][1]), "+v"(acc[ai][bj][3][0]), "+v"(acc[ai][bj][3][1]) \
                : "v"(Bt##8[0]), "v"(Bt##8[1]), "v"(At##8[0]), "v"(At##8[1]), "v"(At##8[2]), "v"(At##8[3])); \
        } else { _Pragma("unroll") for (int m = 0; m < 4; ++m) _Pragma("unroll") for (int n = 0; n < 2; ++n) _Pragma("unroll") for (int k = 0; k < 2; ++k) \
            acc[ai][bj][m][n] = __builtin_amdgcn_mfma_f32_16x16x32_bf16(Bt[n][k], At[m][k], acc[ai][bj][m][n], 0, 0, 0); } \
        __builtin_amdgcn_s_setprio(0); } while (0)
#define PG8_WAIT_V(n) asm volatile("s_waitcnt vmcnt(" #n ")" ::: "memory")
#define PG8_WAIT_L(n) asm volatile("s_waitcnt lgkmcnt(" #n ")" ::: "memory")
#define PG8_BAR __builtin_amdgcn_s_barrier()
#define PG8_SCHED __builtin_amdgcn_sched_barrier(0)
    Unit cur, nxt; int ui = 0;
    if (!S.next(0, cur)) return;
    f32x4 acc[2][2][4][2];
#pragma unroll
    for (int a = 0; a < 2; ++a)
#pragma unroll
        for (int b = 0; b < 2; ++b)
#pragma unroll
            for (int m = 0; m < 4; ++m)
#pragma unroll
                for (int n = 0; n < 2; ++n) acc[a][b][m][n] = (f32x4){0.f, 0.f, 0.f, 0.f};
    bf16x8 At[4][2], B0[2][2], B1[2][2]; i32x8 At8[4], B08[2], B18[2];
    unsigned vA[2][2], vS[2][2];
    S.aoff(cur, tid, vA);
#pragma unroll
    for (int h = 0; h < 2; ++h)
#pragma unroll
        for (int i = 0; i < 2; ++i) vS[h][i] = vA[h][i];
    const char* const A0 = (const char*)Abase;
    const char* cB = S.bptr(cur);
    PG8_STAGE(PG8_SB(0, 0), cB, voffB); PG8_STAGE(PG8_SB(0, 1), cB + hstepB, voffB); PG8_STAGE(PG8_SA(0, 0), A0, vA[0]); PG8_STAGE(PG8_SA(0, 1), A0, vA[1]);
    if (wr == 1) PG8_BAR;
    PG8_WAIT_V(2); PG8_BAR;
    PG8_STAGE(PG8_SB(1, 0), cB + kstep, voffB); PG8_STAGE(PG8_SA(1, 0), A0 + kstep, vA[0]); PG8_STAGE(PG8_SB(1, 1), cB + hstepB + kstep, voffB);
    PG8_WAIT_V(6); PG8_BAR;
    for (;;) {
        const bool has_next = S.next(ui + 1, nxt);
        const bool full = cur.nrows > HALF;
        if constexpr (Sched::ROWTAB) {
            if (wid < 4) { const int row = wid * 64 + lane;
                __builtin_amdgcn_global_load_lds((const unsigned*)(S.rowscal + (size_t)cur.e * T + cur.row0 + min(row, cur.nrows - 1)), (LAS unsigned*)(lds + SCTAB_OFF + (ui & 1) * 1024 + wid * 256), 4, 0, 0);
                if (Sched::GATHER_IDS && has_next) __builtin_amdgcn_global_load_lds((const unsigned*)(S.ltok + (size_t)nxt.e * T + nxt.row0 + min(row, nxt.nrows - 1)), (LAS unsigned*)(lds + TOKTAB_OFF + (ui & 1) * 1024 + wid * 256), 4, 0, 0); }
        }
        const char* nB = has_next ? S.bptr(nxt) : cB;
#pragma unroll 1
        for (int t = 0; t < nt; t += 2) {
            const bool last = (t == nt - 2);
            if (last && has_next) { if constexpr (Sched::GATHER_IDS) S.aoff_lds((const LAS int*)(lds + TOKTAB_OFF + (ui & 1) * 1024), tid, vS); else S.aoff(nxt, tid, vS); }
            const char* a1 = A0 + (size_t)(t + 1) * kstep;
            const char* a2 = last ? A0 : A0 + (size_t)(t + 2) * kstep; const char* b2 = last ? nB : cB + (size_t)(t + 2) * kstep;
            const char* a3 = a2 + kstep; const char* b3 = b2 + kstep;
            PG8_LDB(B0, 0, 0); PG8_LDB(B1, 0, 1); PG8_SCHED; PG8_LDA(At, 0, 0); PG8_STAGE(PG8_SA(1, 1), a1, vA[1]);
            PG8_WAIT_V(8); PG8_WAIT_L(0); PG8_BAR; PG8_MMA(0, 0, At, B0); PG8_MMA(0, 1, At, B1); PG8_BAR; PG8_SCHED;
            PG8_LDA(At, 0, 1); PG8_STAGE(PG8_SB(0, 0), b2, voffB); PG8_STAGE(PG8_SB(0, 1), b2 + hstepB, voffB); PG8_STAGE(PG8_SA(0, 0), a2, vS[0]);
            PG8_WAIT_V(8); PG8_WAIT_L(0); PG8_BAR; if (full) { PG8_MMA(1, 0, At, B0); PG8_MMA(1, 1, At, B1); } PG8_BAR; PG8_SCHED;
            PG8_LDB(B0, 1, 0); PG8_LDB(B1, 1, 1); PG8_SCHED; PG8_LDA(At, 1, 0); PG8_STAGE(PG8_SA(0, 1), a2, vS[1]);
            PG8_WAIT_V(8); PG8_WAIT_L(0); PG8_BAR; PG8_MMA(0, 0, At, B0); PG8_MMA(0, 1, At, B1); PG8_BAR; PG8_SCHED;
            PG8_LDA(At, 1, 1); PG8_STAGE(PG8_SB(1, 0), b3, voffB); PG8_STAGE(PG8_SB(1, 1), b3 + hstepB, voffB); PG8_STAGE(PG8_SA(1, 0), a3, vS[0]);
            PG8_WAIT_V(8); PG8_WAIT_L(0); PG8_BAR; if (full) { PG8_MMA(1, 0, At, B0); PG8_MMA(1, 1, At, B1); } PG8_BAR; PG8_SCHED;
        }
        if (wr == 0) PG8_BAR;
        if constexpr (FP8) asm volatile("s_nop 7\n\ts_nop 7\n\ts_nop 7" ::: "memory");
        { const int t2 = phase_tid(), l2 = t2 & 63; E(acc, cur, wr, wc, l2 & 15, l2 >> 4, (const LAS float*)(lds + SCTAB_OFF + (ui & 1) * 1024)); }
        if (!has_next) break;
#pragma unroll
        for (int a = 0; a < 2; ++a)
#pragma unroll
            for (int b = 0; b < 2; ++b)
#pragma unroll
                for (int m = 0; m < 4; ++m)
#pragma unroll
                    for (int n = 0; n < 2; ++n) acc[a][b][m][n] = (f32x4){0.f, 0.f, 0.f, 0.f};
        cur = nxt; cB = nB; ++ui;
#pragma unroll
        for (int h = 0; h < 2; ++h)
#pragma unroll
            for (int i = 0; i < 2; ++i) vA[h][i] = vS[h][i];
        if (wr == 1) PG8_BAR;
    }
    PG8_WAIT_V(0);
    PG8_BAR;
#undef PG8_SA
#undef PG8_SB
#undef PG8_STAGE
#undef PG8_LDA
#undef PG8_LDB
#undef PG8_MMA
#undef PG8_WAIT_V
#undef PG8_WAIT_L
#undef PG8_BAR
#undef PG8_SCHED
}

__device__ __forceinline__ u32x4 pack_rows(const f32x4 v0, const f32x4 v1) { u32x4 w; w.x = cvt_pk_bf16(v0[0], v0[1]); w.y = cvt_pk_bf16(v0[2], v0[3]); w.z = cvt_pk_bf16(v1[0], v1[1]); w.w = cvt_pk_bf16(v1[2], v1[3]); return w; }
struct EpiG1 {
    static constexpr bool WIDE = false;
    bf16_t* ZB;
    __device__ __forceinline__ void operator()(const f32x4 (&acc)[2][2][4][2], const Unit& u, int wr, int wc, int fr, int fq, const LAS float* sct) const {
        const int row0 = u.pm * BM + wr * 64 + fr;
#pragma unroll
        for (int ai = 0; ai < 2; ++ai)
#pragma unroll
            for (int m = 0; m < 4; ++m) { bf16_t* rowp = ZB + (size_t)(row0 + ai * HALF + m * 16) * D;
                if (u.pn < 8) { *(u32x4*)(rowp + u.pn * 128 + wc * 32 + 8 * fq) = pack_rows(acc[ai][0][m][0] * acc[ai][1][m][0], acc[ai][0][m][1] * acc[ai][1][m][1]); }
                else {
#pragma unroll
                    for (int bj = 0; bj < 2; ++bj) *(u32x4*)(rowp + (size_t)T * D + (u.pn - 8) * BM + bj * HALF + wc * 32 + 8 * fq) = pack_rows(acc[ai][bj][m][0], acc[ai][bj][m][1]); } }
    }
};
struct EpiG1F {
    static constexpr bool WIDE = false;
    bf16_t* Z; bf16_t* Y; bf16_t* BH; const float* cw;
    __device__ __forceinline__ void operator()(const f32x4 (&acc)[2][2][4][2], const Unit& u, int wr, int wc, int fr, int fq, const LAS float* sct) const {
        const int row0 = u.pm * BM + wr * 64 + fr;
        if (u.pn < 8) {
#pragma unroll
            for (int ai = 0; ai < 2; ++ai)
#pragma unroll
                for (int m = 0; m < 4; ++m) *(u32x4*)(Z + (size_t)(row0 + ai * HALF + m * 16) * D + u.pn * 128 + wc * 32 + 8 * fq) = pack_rows(acc[ai][0][m][0] * acc[ai][1][m][0], acc[ai][0][m][1] * acc[ai][1][m][1]);
            return;
        }
#pragma unroll
        for (int bj = 0; bj < 2; ++bj) {
            const int ch = (u.pn - 8) * BM + bj * HALF + wc * 32 + 8 * fq;
            float w0[8], w1[8], w2[8];
            { const f32x4 a0 = *(const f32x4*)(cw + ch), a1 = *(const f32x4*)(cw + ch + 4), b0 = *(const f32x4*)(cw + D + ch), b1 = *(const f32x4*)(cw + D + ch + 4), c0 = *(const f32x4*)(cw + 2 * D + ch), c1 = *(const f32x4*)(cw + 2 * D + ch + 4);
              w0[0] = a0.x; w0[1] = a0.y; w0[2] = a0.z; w0[3] = a0.w; w0[4] = a1.x; w0[5] = a1.y; w0[6] = a1.z; w0[7] = a1.w;
              w1[0] = b0.x; w1[1] = b0.y; w1[2] = b0.z; w1[3] = b0.w; w1[4] = b1.x; w1[5] = b1.y; w1[6] = b1.z; w1[7] = b1.w;
              w2[0] = c0.x; w2[1] = c0.y; w2[2] = c0.z; w2[3] = c0.w; w2[4] = c1.x; w2[5] = c1.y; w2[6] = c1.z; w2[7] = c1.w; }
#pragma unroll
            for (int ai = 0; ai < 2; ++ai) {
                u32x4 zg[5];
#pragma unroll
                for (int g = 0; g < 5; ++g) zg[g] = *(const u32x4*)(Z + (size_t)(row0 + ai * HALF + (g - 1) * 16) * D + ch);
#pragma unroll
                for (int m = 0; m < 4; ++m) { const int row = row0 + ai * HALF + m * 16; float z0[8], z1[8], z2[8], o[8];
                    u32x4 t1, t2;
#pragma unroll
                    for (int d = 0; d < 4; ++d) { const int pv = (int)zg[m][d], cv = (int)zg[m + 1][d];
                        t1[d] = (unsigned)__builtin_amdgcn_update_dpp(__builtin_amdgcn_update_dpp(0, pv, 0x121, 0xF, 0xF, false), cv, 0x111, 0xF, 0xF, false);
                        t2[d] = (unsigned)__builtin_amdgcn_update_dpp(__builtin_amdgcn_update_dpp(0, pv, 0x122, 0xF, 0xF, false), cv, 0x112, 0xF, 0xF, false); }
                    unpack8(zg[m + 1], z0); unpack8(t1, z1); unpack8(t2, z2);
                    const f32x4 b0 = acc[ai][bj][m][0], b1 = acc[ai][bj][m][1];
#pragma unroll
                    for (int e = 0; e < 8; ++e) { const float bv = e < 4 ? b0[e] : b1[e - 4]; o[e] = bv * (w0[e] * z2[e] + w1[e] * z1[e] + w2[e] * z0[e]); }
                    *(u32x4*)(Y + (size_t)row * D + ch) = pack8(o);
                    if (ai == 0 && m == 0 && wr == 0 && fr < 2) *(u32x4*)(BH + ((size_t)u.pm * 2 + fr) * D + ch) = pack_rows(b0, b1); }
            }
        }
    }
};
__device__ __forceinline__ void patch_panel_rows(int pm, const bf16_t* __restrict__ Z, const bf16_t* __restrict__ BH, const float* __restrict__ cw, bf16_t* __restrict__ Y) {
    const int tid = phase_tid(), rr = tid >> 8, ch = (tid & 255) * 4, row = pm * BM + rr, t = row & (SEQ - 1);
    const u32x2 zv0 = *(const u32x2*)(Z + (size_t)row * D + ch);
    const u32x2 zv1 = t >= 1 ? *(const u32x2*)(Z + (size_t)(row - 1) * D + ch) : (u32x2){0u, 0u};
    const u32x2 zv2 = t >= 2 ? *(const u32x2*)(Z + (size_t)(row - 2) * D + ch) : (u32x2){0u, 0u};
    const u32x2 bv = *(const u32x2*)(BH + ((size_t)pm * 2 + rr) * D + ch);
    const f32x4 w0 = *(const f32x4*)(cw + ch), w1 = *(const f32x4*)(cw + D + ch), w2 = *(const f32x4*)(cw + 2 * D + ch);
    float z0[4] = {bf2f(zv0.x & 0xffffu), bf2f(zv0.x >> 16), bf2f(zv0.y & 0xffffu), bf2f(zv0.y >> 16)};
    float z1[4] = {bf2f(zv1.x & 0xffffu), bf2f(zv1.x >> 16), bf2f(zv1.y & 0xffffu), bf2f(zv1.y >> 16)};
    float z2[4] = {bf2f(zv2.x & 0xffffu), bf2f(zv2.x >> 16), bf2f(zv2.y & 0xffffu), bf2f(zv2.y >> 16)};
    float b[4] = {bf2f(bv.x & 0xffffu), bf2f(bv.x >> 16), bf2f(bv.y & 0xffffu), bf2f(bv.y >> 16)};
    float o[4];
#pragma unroll
    for (int e = 0; e < 4; ++e) o[e] = b[e] * (w0[e] * z2[e] + w1[e] * z1[e] + w2[e] * z0[e]);
    u32x2 q; q.x = pk2(o[0], o[1]); q.y = pk2(o[2], o[3]);
    *(u32x2*)(Y + (size_t)row * D + ch) = q;
}
template <bool SCALED> struct EpiRes {
    static constexpr bool WIDE = true;
    const bf16_t* res; bf16_t* X; unsigned char* XQ; const float* rinv; const float* gcol;
    __device__ __forceinline__ void operator()(const f32x4 (&acc)[2][2][4][2], const Unit& u, int wr, int wc, int fr, int fq, const LAS float* sct) const {
        const int row0 = u.pm * BM + wr * 64 + fr, col0 = u.pn * BM + wc * 64 + 16 * fq;
        float gi[2][8];
        if (SCALED) {
#pragma unroll
            for (int bj = 0; bj < 2; ++bj) { const f32x4 g0 = *(const f32x4*)(gcol + col0 + 8 * bj), g1 = *(const f32x4*)(gcol + col0 + 8 * bj + 4);
                gi[bj][0] = __builtin_amdgcn_rcpf(g0.x); gi[bj][1] = __builtin_amdgcn_rcpf(g0.y); gi[bj][2] = __builtin_amdgcn_rcpf(g0.z); gi[bj][3] = __builtin_amdgcn_rcpf(g0.w);
                gi[bj][4] = __builtin_amdgcn_rcpf(g1.x); gi[bj][5] = __builtin_amdgcn_rcpf(g1.y); gi[bj][6] = __builtin_amdgcn_rcpf(g1.z); gi[bj][7] = __builtin_amdgcn_rcpf(g1.w); } }
#pragma unroll
        for (int ai = 0; ai < 2; ++ai) {
            u32x4 rb[4][2]; float ri[4];
#pragma unroll
            for (int m = 0; m < 4; ++m) { const size_t off = (size_t)(row0 + ai * HALF + m * 16) * D + col0; ri[m] = SCALED ? rinv[row0 + ai * HALF + m * 16] : 1.0f;
#pragma unroll
                for (int bj = 0; bj < 2; ++bj) rb[m][bj] = __builtin_nontemporal_load((const u32x4*)(res + off + 8 * bj)); }
#pragma unroll
            for (int m = 0; m < 4; ++m) { const size_t off = (size_t)(row0 + ai * HALF + m * 16) * D + col0; u32x4 q;
#pragma unroll
                for (int bj = 0; bj < 2; ++bj) { float f[8]; unpack8(rb[m][bj], f);
                    if (SCALED) {
#pragma unroll
                        for (int e = 0; e < 8; ++e) f[e] = f[e] * ri[m] * gi[bj][e]; }
                    const f32x4 o0 = (f32x4){f[0], f[1], f[2], f[3]} + acc[ai][bj][m][0], o1 = (f32x4){f[4], f[5], f[6], f[7]} + acc[ai][bj][m][1];
                    *(u32x4*)(X + off + 8 * bj) = pack_rows(o0, o1);
                    q[2 * bj] = pk4_fp8(2.f * o0[0], 2.f * o0[1], 2.f * o0[2], 2.f * o0[3]); q[2 * bj + 1] = pk4_fp8(2.f * o1[0], 2.f * o1[1], 2.f * o1[2], 2.f * o1[3]); }
                *(u32x4*)(XQ + off) = q; }
        }
    }
};
struct EpiG3 {
    static constexpr bool WIDE = false;
    const float* lrs; unsigned char* H;
    __device__ __forceinline__ void operator()(const f32x4 (&acc)[2][2][4][2], const Unit& u, int wr, int wc, int fr, int fq, const LAS float* sct) const {
        float scv[2][4];
#pragma unroll
        for (int ai = 0; ai < 2; ++ai)
#pragma unroll
            for (int m = 0; m < 4; ++m) { const int r = ai * HALF + wr * 64 + m * 16 + fr; scv[ai][m] = sct[r]; }
#pragma unroll
        for (int ai = 0; ai < 2; ++ai)
#pragma unroll
            for (int m = 0; m < 4; ++m) { const int r = ai * HALF + wr * 64 + m * 16 + fr;
                if (r < u.nrows) { const float sc = scv[ai][m] * (1.0f / 64.0f), k1 = sc * -1.4426950408889634f, k2 = 4.0f * sc * sc; f32x4 o[2];
#pragma unroll
                    for (int n = 0; n < 2; ++n)
#pragma unroll
                        for (int j = 0; j < 4; j += 2) {
                            const f32x2 g = {acc[ai][0][m][n][j], acc[ai][0][m][n][j + 1]}, uu = {acc[ai][1][m][n][j], acc[ai][1][m][n][j + 1]};
                            const f32x2 t = g * k1; f32x2 e; e.x = __builtin_amdgcn_exp2f(t.x); e.y = __builtin_amdgcn_exp2f(t.y);
                            const f32x2 d = e + 1.0f; f32x2 rc; rc.x = __builtin_amdgcn_rcpf(d.x); rc.y = __builtin_amdgcn_rcpf(d.y);
                            const f32x2 h = ((g * uu) * k2) * rc; o[n][j] = h.x; o[n][j + 1] = h.y; }
                    u32x2 q; q.x = pk4_fp8(o[0][0], o[0][1], o[0][2], o[0][3]); q.y = pk4_fp8(o[1][0], o[1][1], o[1][2], o[1][3]);
                    *(u32x2*)(H + (size_t)(u.slot0 + r) * F + u.pn * 128 + wc * 32 + 8 * fq) = q; } }
    }
};
struct EpiG4 {
    static constexpr bool WIDE = true;
    const float* lgate; unsigned char* YS;
    __device__ __forceinline__ void operator()(const f32x4 (&acc)[2][2][4][2], const Unit& u, int wr, int wc, int fr, int fq, const LAS float* sct) const {
        float gv[2][4];
#pragma unroll
        for (int ai = 0; ai < 2; ++ai)
#pragma unroll
            for (int m = 0; m < 4; ++m) { const int r = ai * HALF + wr * 64 + m * 16 + fr; gv[ai][m] = sct[r]; }
#pragma unroll
        for (int ai = 0; ai < 2; ++ai)
#pragma unroll
            for (int m = 0; m < 4; ++m) { const int r = ai * HALF + wr * 64 + m * 16 + fr;
                if (r < u.nrows) { const float g = gv[ai][m] * (16.0f / 128.0f);
                    u32x4 q;
#pragma unroll
                    for (int bj = 0; bj < 2; ++bj) { const f32x4 o0 = acc[ai][bj][m][0] * g, o1 = acc[ai][bj][m][1] * g; q[2 * bj] = pk4_fp8(o0[0], o0[1], o0[2], o0[3]); q[2 * bj + 1] = pk4_fp8(o1[0], o1[1], o1[2], o1[3]); }
                    *(u32x4*)(YS + (size_t)(u.slot0 + r) * D + u.pn * BM + wc * 64 + 16 * fq) = q; } }
    }
};
struct EpiG5 {
    static constexpr bool WIDE = true;
    const float* rs; const float* bias; bf16_t* U; bf16_t* V; f32x2* lnp;
    __device__ __forceinline__ void operator()(const f32x4 (&acc)[2][2][4][2], const Unit& u, int wr, int wc, int fr, int fq, const LAS float* sct) const {
        const int row0 = u.pm * BM + wr * 64 + fr, col0 = u.pn * BM + wc * 64 + 16 * fq;
        f32x4 bv[2][2];
#pragma unroll
        for (int bj = 0; bj < 2; ++bj)
#pragma unroll
            for (int n = 0; n < 2; ++n) bv[bj][n] = *(const f32x4*)(bias + col0 + 8 * bj + 4 * n);
        float scv[2][4];
#pragma unroll
        for (int ai = 0; ai < 2; ++ai)
#pragma unroll
            for (int m = 0; m < 4; ++m) scv[ai][m] = rs[row0 + ai * HALF + m * 16];
#pragma unroll
        for (int ai = 0; ai < 2; ++ai) { float mps = 0.f, mpq = 0.f;
#pragma unroll
            for (int m = 0; m < 4; ++m) { const int row = row0 + ai * HALF + m * 16; const float sc = scv[ai][m];
                float ps = 0.f, pq = 0.f;
#pragma unroll
                for (int bj = 0; bj < 2; ++bj) { f32x4 o[2];
#pragma unroll
                    for (int n = 0; n < 2; ++n)
#pragma unroll
                        for (int j = 0; j < 4; ++j) { o[n][j] = gelu_tanh(sc * acc[ai][bj][m][n][j] + bv[bj][n][j]); ps += o[n][j]; pq += o[n][j] * o[n][j]; }
                    *(u32x4*)((u.pn >= 4 ? V : U) + (size_t)row * D + (col0 & (D - 1)) + 8 * bj) = pack_rows(o[0], o[1]); }
                if (u.pn >= 4) { ps += __shfl_xor(ps, 16); ps += __shfl_xor(ps, 32); pq += __shfl_xor(pq, 16); pq += __shfl_xor(pq, 32);
                    if (m == fq) { mps = ps; mpq = pq; } }
                if (m == 3 && u.pn >= 4) lnp[(size_t)(row0 + ai * HALF + fq * 16) * 16 + (u.pn - 4) * 4 + wc] = (f32x2){mps, mpq}; }
        }
    }
};

struct Part { int base_row, nrows, j, nb; };
__device__ __forceinline__ void ph_prep_x(const float* __restrict__ x, const float* __restrict__ g, bf16_t* __restrict__ xn, float* __restrict__ rinv) {
    const int tid = phase_tid(), lane = tid & 63, gw = ((int)blockIdx.x * NT + tid) >> 6, ngw = ((int)gridDim.x * NT) >> 6;
    f32x4 gv[4];
#pragma unroll
    for (int j = 0; j < 4; ++j) gv[j] = *(const f32x4*)(g + (j >> 1) * 512 + lane * 8 + (j & 1) * 4);
    for (int row = gw; row < T; row += 2 * ngw) {
        const int row2 = row + ngw;
        const bool has2 = row2 < T;
        const float* xr = x + (size_t)row * D; const float* xr2 = x + (size_t)(has2 ? row2 : row) * D;
        f32x4 v[4], w[4]; float s = 0.f, s2 = 0.f;
#pragma unroll
        for (int j = 0; j < 4; ++j) { v[j] = __builtin_nontemporal_load((const f32x4*)(xr + (j >> 1) * 512 + lane * 8 + (j & 1) * 4)); w[j] = __builtin_nontemporal_load((const f32x4*)(xr2 + (j >> 1) * 512 + lane * 8 + (j & 1) * 4)); }
#pragma unroll
        for (int j = 0; j < 4; ++j) { s += (v[j].x * v[j].x + v[j].y * v[j].y) + (v[j].z * v[j].z + v[j].w * v[j].w); s2 += (w[j].x * w[j].x + w[j].y * w[j].y) + (w[j].z * w[j].z + w[j].w * w[j].w); }
        const float r = rsqrtf(wave_sum(s) * (1.0f / D) + EPS), r2 = rsqrtf(wave_sum(s2) * (1.0f / D) + EPS);
        if (lane == 0) { rinv[row] = 1.0f / r; if (has2) rinv[row2] = 1.0f / r2; }
#pragma unroll
        for (int h = 0; h < 2; ++h) { u32x4 q; q.x = pk2(v[2 * h].x * r * gv[2 * h].x, v[2 * h].y * r * gv[2 * h].y); q.y = pk2(v[2 * h].z * r * gv[2 * h].z, v[2 * h].w * r * gv[2 * h].w);
            q.z = pk2(v[2 * h + 1].x * r * gv[2 * h + 1].x, v[2 * h + 1].y * r * gv[2 * h + 1].y); q.w = pk2(v[2 * h + 1].z * r * gv[2 * h + 1].z, v[2 * h + 1].w * r * gv[2 * h + 1].w);
            *(u32x4*)(xn + (size_t)row * D + h * 512 + lane * 8) = q; }
        if (has2) {
#pragma unroll
            for (int h = 0; h < 2; ++h) { u32x4 q; q.x = pk2(w[2 * h].x * r2 * gv[2 * h].x, w[2 * h].y * r2 * gv[2 * h].y); q.y = pk2(w[2 * h].z * r2 * gv[2 * h].z, w[2 * h].w * r2 * gv[2 * h].w);
                q.z = pk2(w[2 * h + 1].x * r2 * gv[2 * h + 1].x, w[2 * h + 1].y * r2 * gv[2 * h + 1].y); q.w = pk2(w[2 * h + 1].z * r2 * gv[2 * h + 1].z, w[2 * h + 1].w * r2 * gv[2 * h + 1].w);
                *(u32x4*)(xn + (size_t)row2 * D + h * 512 + lane * 8) = q; } }
    }
}
__device__ __forceinline__ int map_row(int mapkind, int n) {
    if (mapkind == 0) return n;
    if (mapkind == 1) { if (n < D) return 2 * D + n; const int ch = (n - D) & (D - 1), second = (n >= 2 * D); return 256 * (ch >> 7) + 128 * second + (ch & 127); }
    return 256 * (n >> 7) + (mapkind == 3 ? 128 : 0) + (n & 127);
}
struct TrItem { const float* src; int k0, n0; };
__device__ __forceinline__ void tr_load(const float* __restrict__ W, int N, int item, int lane, f32x4 (&v)[16]) {
    const int nblk = N / 64, kb = item / nblk, nb = item % nblk, k0 = 64 * kb, n0 = 64 * nb, kq = lane >> 4, nn = 4 * (lane & 15);
#pragma unroll
    for (int i = 0; i < 16; ++i) v[i] = __builtin_nontemporal_load((const f32x4*)(W + (size_t)(k0 + 4 * i + kq) * N + n0 + nn));
}
template <bool FP8OUT> __device__ __forceinline__ void tr_process(const f32x4 (&v)[16], int K, int N, void* __restrict__ WTv, int mapkind, const float* __restrict__ kscale, LAS float* scr, int item, int lane) {
    const int nblk = N / 64, kb = item / nblk, nb = item % nblk, k0 = 64 * kb, n0 = 64 * nb, kq = lane >> 4, nn = 4 * (lane & 15);
#pragma unroll
    for (int i = 0; i < 16; ++i) { const int kk = 4 * i + kq; const float sc = (kscale ? kscale[k0 + kk] : 1.0f) * (FP8OUT ? 32.0f : 1.0f); LAS float* d = scr + kk * 65 + nn;
        d[0] = v[i].x * sc; d[1] = v[i].y * sc; d[2] = v[i].z * sc; d[3] = v[i].w * sc; }
    LDS_WAIT();
    if constexpr (!FP8OUT) {
        bf16_t* WT = (bf16_t*)WTv; const int c = lane & 7;
#pragma unroll
        for (int j = 0; j < 8; ++j) { const int n = (lane >> 3) + 8 * j; const LAS float* sp = scr + (8 * c) * 65 + n;
            u32x4 o; o.x = pk2(sp[0 * 65], sp[1 * 65]); o.y = pk2(sp[2 * 65], sp[3 * 65]); o.z = pk2(sp[4 * 65], sp[5 * 65]); o.w = pk2(sp[6 * 65], sp[7 * 65]);
            *(u32x4*)(WT + (size_t)map_row(mapkind, n0 + n) * K + k0 + 8 * c) = o; }
    } else {
        unsigned char* WT = (unsigned char*)WTv; const int c = lane & 3;
#pragma unroll
        for (int j = 0; j < 4; ++j) { const int n = (lane >> 2) + 16 * j; const LAS float* sp = scr + (16 * c) * 65 + n;
            u32x4 o; o.x = pk4_fp8(sp[0 * 65], sp[1 * 65], sp[2 * 65], sp[3 * 65]); o.y = pk4_fp8(sp[4 * 65], sp[5 * 65], sp[6 * 65], sp[7 * 65]);
            o.z = pk4_fp8(sp[8 * 65], sp[9 * 65], sp[10 * 65], sp[11 * 65]); o.w = pk4_fp8(sp[12 * 65], sp[13 * 65], sp[14 * 65], sp[15 * 65]);
            __builtin_nontemporal_store(o, (u32x4*)(WT + (size_t)map_row(mapkind, n0 + n) * K + k0 + 16 * c)); }
    }
    LDS_WAIT();
}
template <bool FP8OUT> __device__ __forceinline__ void ph_transpose(LAS unsigned char* lds, const float* W, int K, int N, void* WT, int mapkind, const float* kscale, int nbatch, size_t sstride, size_t dstride, int shift = 0) {
    const int tid = phase_tid(), lane = tid & 63, wave = tid >> 6, ngw = (int)gridDim.x * NWAVES, gw = ((int)blockIdx.x * NWAVES + wave + ngw - (shift % ngw)) % ngw;
    LAS float* scr = (LAS float*)(lds + wave * 16640);
    const int per = (K / 64) * (N / 64), nitems = per * nbatch;
    f32x4 v[16], vn[16];
    int it = gw;
    if (it < nitems) tr_load(W + (size_t)(it / per) * sstride, N, it % per, lane, v);
    while (it < nitems) {
        const int nx = it + ngw;
        if (nx < nitems) tr_load(W + (size_t)(nx / per) * sstride, N, nx % per, lane, vn);
        tr_process<FP8OUT>(v, K, N, (unsigned char*)WT + (size_t)(it / per) * dstride * (FP8OUT ? 1 : 2), mapkind, kscale, scr, it % per, lane);
#pragma unroll
        for (int i = 0; i < 16; ++i) v[i] = vn[i];
        it = nx;
    }
}
struct PrepArgs { const float* w_gate; const float* w_up; const float* w_down; const float* ln2; unsigned char* WGU; unsigned char* WD; };
constexpr int PREP_ROUND = 2048, PREP_ROUNDS = 6;
__device__ __forceinline__ void prep_item(const PrepArgs& A, int layer, int item, const float*& W, int& K, int& N, unsigned char*& WT, int& mapkind, const float*& kscale, int& sub) {
    const int m = item >> 12, within = item & 4095, e = within >> 7; sub = within & 127;
    if (m < 2) { W = (m == 0 ? A.w_gate : A.w_up) + ((size_t)layer * NE + e) * D * F; K = D; N = F; WT = A.WGU + (size_t)e * 1024 * D; mapkind = 2 + m; kscale = A.ln2 + layer * D; }
    else { W = A.w_down + ((size_t)layer * NE + e) * F * D; K = F; N = D; WT = A.WD + (size_t)e * D * F; mapkind = 0; kscale = nullptr; }
}
__device__ __forceinline__ void prep_rounds(LAS unsigned char* lds, const PrepArgs& A, int layer, int r0, int nr) {
    if (nr <= 0) return;
    const int tid = phase_tid(), lane = tid & 63, wave = tid >> 6, ngw = (int)gridDim.x * NWAVES, gw = (int)blockIdx.x * NWAVES + wave;
    LAS float* scr = (LAS float*)(lds + wave * 16640);
    const int end = (r0 + nr) * PREP_ROUND;
    f32x4 v[16], vn[16];
    int it = r0 * PREP_ROUND + gw;
    const float* W; int K, N, mapkind, sub; unsigned char* WT; const float* kscale;
    if (it < end) { prep_item(A, layer, it, W, K, N, WT, mapkind, kscale, sub); tr_load(W, N, sub, lane, v); }
    while (it < end) {
        const int nx = it + ngw;
        const float* Wn = W; int Kn = K, Nn = N, mapn = mapkind, subn = sub; unsigned char* WTn = WT; const float* ksn = kscale;
        if (nx < end) { prep_item(A, layer, nx, Wn, Kn, Nn, WTn, mapn, ksn, subn); tr_load(Wn, Nn, subn, lane, vn); }
        tr_process<true>(v, K, N, WT, mapkind, kscale, scr, sub, lane);
#pragma unroll
        for (int i = 0; i < 16; ++i) v[i] = vn[i];
        it = nx; W = Wn; K = Kn; N = Nn; WT = WTn; mapkind = mapn; kscale = ksn; sub = subn;
    }
}
__device__ __forceinline__ void ph_prep_router(const float* __restrict__ ln2, const float* __restrict__ wg, const float* __restrict__ we, bf16_t* __restrict__ wr) {
    for (int i = (int)blockIdx.x * NT + phase_tid(); i < 2 * 48 * D; i += (int)gridDim.x * NT) {
        const int l = i / (48 * D), j = (i / D) % 48, k = i % D;
        float w = 0.f;
        if (j < 4) w = wg[((size_t)l * D + k) * NG + j]; else if (j < 36) w = we[((size_t)l * D + k) * NE + (j - 4)];
        w *= ln2[l * D + k];
        const unsigned hi = f2bf(w); const unsigned lo = f2bf(w - bf2f(hi));
        wr[((size_t)l * 2 + 0) * 48 * D + (size_t)j * D + k] = (bf16_t)hi; wr[((size_t)l * 2 + 1) * 48 * D + (size_t)j * D + k] = (bf16_t)lo;
    }
}
__device__ __forceinline__ void ph_prep_wm(const float* __restrict__ ws, bf16_t* __restrict__ wm) {
    for (int i = (int)blockIdx.x * NT + phase_tid(); i < NH * CHUNK * CHUNK; i += (int)gridDim.x * NT) { const int t = (i / CHUNK) % CHUNK, s = i % CHUNK; wm[i] = (bf16_t)f2bf(t >= s ? ws[i] : 0.f); }
}
__device__ __forceinline__ void ph_conv(const Part P, const bf16_t* __restrict__ ZB, const float* __restrict__ cw, bf16_t* __restrict__ Y) {
    constexpr int RB = 8;
    const int nitems = (P.nrows / RB) * (D / 8);
    for (int it = P.j * NT + phase_tid(); it < nitems; it += P.nb * NT) {
        const int cg8 = it & 127, rb = it >> 7, r0 = P.base_row + rb * RB, ch = cg8 * 8, t0 = r0 & (SEQ - 1);
        float w[3][8];
#pragma unroll
        for (int k = 0; k < 3; ++k)
#pragma unroll
            for (int i = 0; i < 8; ++i) w[k][i] = cw[k * D + ch + i];
        float zm2[8], zm1[8];
        if (t0 >= 2) { unpack8(__builtin_nontemporal_load((const u32x4*)(ZB + (size_t)(r0 - 2) * D + ch)), zm2); unpack8(__builtin_nontemporal_load((const u32x4*)(ZB + (size_t)(r0 - 1) * D + ch)), zm1); }
        else {
#pragma unroll
            for (int i = 0; i < 8; ++i) { zm2[i] = 0.f; zm1[i] = 0.f; } }
#pragma unroll
        for (int r = 0; r < RB; ++r) {
            float z[8], b[8], o[8];
            unpack8(__builtin_nontemporal_load((const u32x4*)(ZB + (size_t)(r0 + r) * D + ch)), z); unpack8(__builtin_nontemporal_load((const u32x4*)(ZB + (size_t)T * D + (size_t)(r0 + r) * D + ch)), b);
#pragma unroll
            for (int i = 0; i < 8; ++i) { o[i] = b[i] * (w[0][i] * zm2[i] + w[1][i] * zm1[i] + w[2][i] * z[i]); zm2[i] = zm1[i]; zm1[i] = z[i]; }
            *(u32x4*)(Y + (size_t)(r0 + r) * D + ch) = pack8(o);
        }
    }
}
__device__ __forceinline__ void ph_route(const Part P, LAS unsigned char* lds, const bf16_t* __restrict__ X, const bf16_t* __restrict__ wrh, const float* __restrict__ bg, const float* __restrict__ be,
                                         unsigned* __restrict__ cnt, unsigned* __restrict__ asg, int* __restrict__ ltok, float* __restrict__ lgate, float* __restrict__ lrs) {
    const int tid = phase_tid(), wave = tid >> 6, lane = tid & 63, fr = lane & 15, fq = lane >> 4;
    LAS float* lgs = (LAS float*)(lds + wave * 4096);
    LAS int* s_e = (LAS int*)(lds + 32768); LAS float* s_g = (LAS float*)(lds + 32768 + 1024); LAS float* s_r = (LAS float*)(lds + 32768 + 2048);
    LAS unsigned* s_cnt = (LAS unsigned*)(lds + 32768 + 3072); LAS unsigned* s_base = (LAS unsigned*)(lds + 32768 + 3200); LAS unsigned* s_rank = (LAS unsigned*)(lds + 32768 + 3328);
    const bf16_t* wrl = wrh + 48 * D;
    for (int tbl = P.j * 128; tbl < P.nrows; tbl += P.nb * 128) {
        const int tb = P.base_row + tbl;
        if (tid < NE) s_cnt[tid] = 0u;
        const int tok0 = tb + wave * 16;
        f32x4 acc[3]; float ss = 0.f;
#pragma unroll
        for (int n = 0; n < 3; ++n) acc[n] = (f32x4){0.f, 0.f, 0.f, 0.f};
        constexpr int WCH_PITCH = 272, WCH_BYTES = 2 * 48 * WCH_PITCH;
        LAS unsigned char* wbuf = lds + 49152;
        u32x4 wreg[3], araw[4];
#pragma unroll
        for (int p = 0; p < 3; ++p) { const int pc = tid + 512 * p, hl = pc / 768, row = (pc % 768) >> 4, kc = pc & 15; wreg[p] = *(const u32x4*)(wrh + (size_t)hl * 48 * D + (size_t)row * D + kc * 8); }
#pragma unroll
        for (int q = 0; q < 4; ++q) araw[q] = __builtin_nontemporal_load((const u32x4*)(X + (size_t)(tok0 + fr) * D + q * 32 + fq * 8));
#pragma unroll 1
        for (int kb = 0; kb < D / 128; ++kb) {
            LAS unsigned char* wb = wbuf + (kb & 1) * WCH_BYTES;
#pragma unroll
            for (int p = 0; p < 3; ++p) { const int pc = tid + 512 * p, hl = pc / 768, row = (pc % 768) >> 4, kc = pc & 15; *(LAS u32x4*)(wb + (hl * 48 + row) * WCH_PITCH + kc * 16) = wreg[p]; }
            u32x4 acur[4];
#pragma unroll
            for (int q = 0; q < 4; ++q) acur[q] = araw[q];
            __syncthreads();
            if (kb + 1 < D / 128) {
#pragma unroll
                for (int p = 0; p < 3; ++p) { const int pc = tid + 512 * p, hl = pc / 768, row = (pc % 768) >> 4, kc = pc & 15; wreg[p] = *(const u32x4*)(wrh + (size_t)hl * 48 * D + (size_t)row * D + (kb + 1) * 128 + kc * 8); }
#pragma unroll
                for (int q = 0; q < 4; ++q) araw[q] = __builtin_nontemporal_load((const u32x4*)(X + (size_t)(tok0 + fr) * D + ((kb + 1) * 4 + q) * 32 + fq * 8));
            }
#pragma unroll
            for (int q = 0; q < 4; ++q) {
                float af[8]; unpack8(acur[q], af);
#pragma unroll
                for (int e = 0; e < 8; ++e) ss += af[e] * af[e];
                const bf16x8 a = __builtin_bit_cast(bf16x8, acur[q]);
#pragma unroll
                for (int n = 0; n < 3; ++n) {
                    const bf16x8 bh = *(const LAS bf16x8*)(wb + (n * 16 + fr) * WCH_PITCH + (q * 32 + fq * 8) * 2);
                    const bf16x8 bl = *(const LAS bf16x8*)(wb + (48 + n * 16 + fr) * WCH_PITCH + (q * 32 + fq * 8) * 2);
                    acc[n] = __builtin_amdgcn_mfma_f32_16x16x32_bf16(a, bh, acc[n], 0, 0, 0); acc[n] = __builtin_amdgcn_mfma_f32_16x16x32_bf16(a, bl, acc[n], 0, 0, 0); }
            }
        }
        __syncthreads();
        ss += __shfl_xor(ss, 16); ss += __shfl_xor(ss, 32);
#pragma unroll
        for (int n = 0; n < 3; ++n)
#pragma unroll
            for (int j = 0; j < 4; ++j) lgs[(fq * 4 + j) * 49 + n * 16 + fr] = acc[n][j];
        if (fq == 0) lgs[16 * 49 + fr] = rsqrtf(ss * (1.0f / D) + EPS);
        LDS_WAIT();
        if (lane < 16) {
            const float r = lgs[16 * 49 + lane]; const LAS float* L = lgs + lane * 49;
            float lg[36];
#pragma unroll
            for (int j = 0; j < 36; ++j) lg[j] = L[j] * r + (j < 4 ? bg[j] : be[j - 4]);
            int gi = 0; float gm = lg[0];
#pragma unroll
            for (int j = 1; j < 4; ++j) if (lg[j] > gm) { gm = lg[j]; gi = j; }
            float gs = 0.f;
#pragma unroll
            for (int j = 0; j < 4; ++j) gs += __expf(lg[j] - gm);
            const float gp = 1.0f / gs;
            float el[8];
#pragma unroll
            for (int j = 0; j < 8; ++j) { el[j] = lg[4 + j];
#pragma unroll
                for (int g = 1; g < 4; ++g) el[j] = (gi == g) ? lg[4 + g * 8 + j] : el[j]; }
            int i0 = 0; float m0 = el[0];
#pragma unroll
            for (int j = 1; j < 8; ++j) if (el[j] > m0) { m0 = el[j]; i0 = j; }
            int i1 = 0; float m1 = -3.0e38f;
#pragma unroll
            for (int j = 0; j < 8; ++j) if (j != i0 && el[j] > m1) { m1 = el[j]; i1 = j; }
            const float eb = __expf(m1 - m0), den = 1.0f / (1.0f + eb);
            const int tl = wave * 16 + lane;
            s_e[2 * tl] = gi * 8 + i0; s_e[2 * tl + 1] = gi * 8 + i1; s_g[2 * tl] = gp * den; s_g[2 * tl + 1] = gp * eb * den; s_r[tl] = r;
        }
        __syncthreads();
        if (tid < 256) s_rank[tid] = atomicAdd((unsigned*)&s_cnt[s_e[tid]], 1u);
        __syncthreads();
        if (tid < NE) s_base[tid] = s_cnt[tid] ? atomicAdd(&cnt[tid], s_cnt[tid]) : 0u;
        __syncthreads();
        if (tid < 256) { const int e = s_e[tid], tok = tb + (tid >> 1); const unsigned pos = s_base[e] + s_rank[tid];
            ltok[(size_t)e * T + pos] = tok; lgate[(size_t)e * T + pos] = s_g[tid]; lrs[(size_t)e * T + pos] = s_r[tid >> 1];
            asg[(size_t)tok * 4 + (tid & 1) * 2] = ((unsigned)e << 24) | pos; asg[(size_t)tok * 4 + (tid & 1) * 2 + 1] = __float_as_uint(s_g[tid]); }
        __syncthreads();
    }
}
__device__ __forceinline__ int build_tile_table(LAS unsigned char* lds, const unsigned* __restrict__ cnt) {
    LAS int* tab = (LAS int*)(lds + TAB_OFF); LAS int* tabn = (LAS int*)(lds + TABN_OFF);
    const int tid = phase_tid();
    if (tid < NE) {
        int bacc = 0, sacc_small = 0, sacc = 0, mine = 0, nbig_all = 0, nsmall_all = 0;
        for (int e = 0; e < NE; ++e) { const int n = (int)cnt[e], full = n / BM, rem = n % BM, nb = full + (rem > HALF ? 1 : 0), ns = (rem > 0 && rem <= HALF) ? 1 : 0;
            if (e == tid) mine = n; if (e < tid) { bacc += nb; sacc_small += ns; sacc += n; } nbig_all += nb; nsmall_all += ns; }
        const int full = mine / BM, rem = mine % BM, nb = full + (rem > HALF ? 1 : 0);
        for (int j = 0; j < nb; ++j) { const int ti = bacc + j; if (ti < TAB_MAX) { tab[ti * 4 + 0] = tid; tab[ti * 4 + 1] = j * BM; tab[ti * 4 + 2] = min(BM, mine - j * BM); tab[ti * 4 + 3] = sacc + j * BM; } }
        if (rem > 0 && rem <= HALF) { const int ti = nbig_all + sacc_small; if (ti < TAB_MAX) { tab[ti * 4 + 0] = tid; tab[ti * 4 + 1] = full * BM; tab[ti * 4 + 2] = rem; tab[ti * 4 + 3] = sacc + full * BM; } }
        if (tid == NE - 1) tabn[0] = min(nbig_all + nsmall_all, TAB_MAX);
    }
    __syncthreads();
    return __builtin_amdgcn_readfirstlane(tabn[0]);
}
template <bool FINAL> __device__ __forceinline__ void ph_combine(const Part P, const bf16_t* __restrict__ X, const unsigned char* __restrict__ YS, const unsigned* __restrict__ cnt, const unsigned* __restrict__ asg,
                                                                 bf16_t* __restrict__ Xo, float* __restrict__ rs, const float* __restrict__ g, float* __restrict__ out) {
    const int tid = phase_tid(), lane = tid & 63, gw = (P.j * NT + tid) >> 6, ngw = (P.nb * NT) >> 6;
    unsigned c = lane < NE ? cnt[lane] : 0u, inc = c;
#pragma unroll
    for (int o = 1; o < 32; o <<= 1) { const unsigned t = __shfl_up(inc, o); if (lane >= o) inc += t; }
    const unsigned excl = inc - c;
    for (int rowl = gw; rowl < P.nrows; rowl += 2 * ngw) {
        int rows[2]; rows[0] = P.base_row + rowl; rows[1] = (rowl + ngw < P.nrows) ? P.base_row + rowl + ngw : rows[0];
        unsigned sa[2], sb[2];
#pragma unroll
        for (int q = 0; q < 2; ++q) { const u32x4 cw = *(const u32x4*)(asg + (size_t)rows[q] * 4); sa[q] = __shfl(excl, (int)(cw.x >> 24)) + (cw.x & 0xffffffu); sb[q] = __shfl(excl, (int)(cw.z >> 24)) + (cw.z & 0xffffffu); }
        u32x4 xr[2][2]; u32x2 ar[2][2], br[2][2];
#pragma unroll
        for (int q = 0; q < 2; ++q)
#pragma unroll
            for (int h = 0; h < 2; ++h) { xr[q][h] = __builtin_nontemporal_load((const u32x4*)(X + (size_t)rows[q] * D + h * 512 + lane * 8)); ar[q][h] = __builtin_nontemporal_load((const u32x2*)(YS + (size_t)sa[q] * D + h * 512 + lane * 8)); br[q][h] = __builtin_nontemporal_load((const u32x2*)(YS + (size_t)sb[q] * D + h * 512 + lane * 8)); }
#pragma unroll
        for (int q = 0; q < 2; ++q) {
            if (q == 1 && rows[1] == rows[0]) break;
            const int row = rows[q];
            float v[16];
#pragma unroll
            for (int h = 0; h < 2; ++h) { float x8[8], a[8], b[8]; unpack8(xr[q][h], x8); unpack8_fp8(ar[q][h], a); unpack8_fp8(br[q][h], b);
#pragma unroll
                for (int i = 0; i < 8; ++i) v[h * 8 + i] = x8[i] + (a[i] + b[i]) * (1.0f / 16.0f); }
            if (!FINAL) {
                float ss = 0.f;
#pragma unroll
                for (int h = 0; h < 2; ++h) { float o8[8];
#pragma unroll
                    for (int i = 0; i < 8; ++i) { o8[i] = bf2f(f2bf(v[h * 8 + i])); ss += o8[i] * o8[i]; }
                    *(u32x4*)(Xo + (size_t)row * D + h * 512 + lane * 8) = pack8(o8); }
                const float r = rsqrtf(wave_sum(ss) * (1.0f / D) + EPS);
                if (lane == 0) rs[row] = r;
            } else {
                float ss = 0.f;
#pragma unroll
                for (int i = 0; i < 16; ++i) ss += v[i] * v[i];
                const float r = rsqrtf(wave_sum(ss) * (1.0f / D) + EPS);
#pragma unroll
                for (int h = 0; h < 2; ++h) { const f32x4 g0 = *(const f32x4*)(g + h * 512 + lane * 8), g1 = *(const f32x4*)(g + h * 512 + lane * 8 + 4);
                    f32x4 o0, o1; o0.x = v[h * 8 + 0] * r * g0.x; o0.y = v[h * 8 + 1] * r * g0.y; o0.z = v[h * 8 + 2] * r * g0.z; o0.w = v[h * 8 + 3] * r * g0.w;
                    o1.x = v[h * 8 + 4] * r * g1.x; o1.y = v[h * 8 + 5] * r * g1.y; o1.z = v[h * 8 + 6] * r * g1.z; o1.w = v[h * 8 + 7] * r * g1.w;
                    __builtin_nontemporal_store(o0, (f32x4*)(out + (size_t)row * D + h * 512 + lane * 8)); __builtin_nontemporal_store(o1, (f32x4*)(out + (size_t)row * D + h * 512 + lane * 8 + 4)); }
            }
        }
    }
}
constexpr int MIX_PITCH = 272, MIX_BUF = CHUNK * MIX_PITCH, MIX_STAT_OFF = 2 * MIX_BUF;
typedef short s16x4 __attribute__((ext_vector_type(4)));
__device__ __forceinline__ void ph_mix(const Part P, LAS unsigned char* lds, const bf16_t* __restrict__ U, const bf16_t* __restrict__ V, const f32x2* __restrict__ lnp, const float* __restrict__ vg, const float* __restrict__ vbeta,
                                       const bf16_t* __restrict__ wm, const float* __restrict__ bs, bf16_t* __restrict__ YM) {
    const int tid = phase_tid(), wave = tid >> 6, lane = tid & 63, fr = lane & 15, fq = lane >> 4, wt = wave >> 1, wd = wave & 1;
    LAS float* stat = (LAS float*)(lds + MIX_STAT_OFF);
    const int ch = tid & 15, srow = tid >> 4;
    const int cgrp = ch >> 2, ca = ch & 3;
    for (int bcl = P.j; bcl < P.nrows / CHUNK; bcl += P.nb) {
        const int row0 = P.base_row + bcl * CHUNK;
        if (tid < CHUNK) { const f32x4* pp = (const f32x4*)(lnp + (size_t)(row0 + tid) * 16); float sm = 0.f, sq = 0.f;
#pragma unroll
            for (int i = 0; i < 8; ++i) { const f32x4 pv = pp[i]; sm += pv.x + pv.z; sq += pv.y + pv.w; }
            const float mu = sm * (1.0f / D), var = fmaxf(sq * (1.0f / D) - mu * mu, 0.f);
            stat[2 * tid] = mu; stat[2 * tid + 1] = rsqrtf(var + EPS); }
        __syncthreads();
        u32x4 vraw[4], vnx[4], vn2[4];
#pragma unroll
        for (int p = 0; p < 4; ++p) { vraw[p] = __builtin_nontemporal_load((const u32x4*)(V + (size_t)(row0 + srow + 32 * p) * D + 0 * 128 + 8 * ch));
            vnx[p] = __builtin_nontemporal_load((const u32x4*)(V + (size_t)(row0 + srow + 32 * p) * D + 1 * 128 + 8 * ch)); vn2[p] = (u32x4){0u, 0u, 0u, 0u}; }
#pragma unroll 1
        for (int h = 0; h < NH; ++h) {
            LAS unsigned char* buf = lds + (h & 1) * MIX_BUF;
            u32x4 uraw[2][2]; float bsv[2];
#pragma unroll
            for (int m = 0; m < 2; ++m) { const int t = 32 * wt + 16 * m + fr; bsv[m] = bs[h * CHUNK + t];
#pragma unroll
                for (int cc = 0; cc < 2; ++cc) uraw[m][cc] = __builtin_nontemporal_load((const u32x4*)(U + (size_t)(row0 + t) * D + h * 128 + 32 * (2 * wd + cc) + 8 * fq)); }
            bf16x8 af[4][2];
#pragma unroll
            for (int kk = 0; kk < 4; ++kk)
#pragma unroll
                for (int m = 0; m < 2; ++m) af[kk][m] = *(const bf16x8*)(wm + ((size_t)(h * CHUNK + 32 * wt + 16 * m + fr)) * CHUNK + 32 * (kk <= wt ? kk : wt) + 8 * fq);
            float g8[8], b8[8];
            { const f32x4 ga = *(const f32x4*)(vg + h * 128 + 8 * ch), gb = *(const f32x4*)(vg + h * 128 + 8 * ch + 4), ba = *(const f32x4*)(vbeta + h * 128 + 8 * ch), bb = *(const f32x4*)(vbeta + h * 128 + 8 * ch + 4);
              g8[0] = ga.x; g8[1] = ga.y; g8[2] = ga.z; g8[3] = ga.w; g8[4] = gb.x; g8[5] = gb.y; g8[6] = gb.z; g8[7] = gb.w;
              b8[0] = ba.x; b8[1] = ba.y; b8[2] = ba.z; b8[3] = ba.w; b8[4] = bb.x; b8[5] = bb.y; b8[6] = bb.z; b8[7] = bb.w; }
#pragma unroll
            for (int p = 0; p < 4; ++p) { const int sr = srow + 32 * p; float v[8]; if (h & 1) unpack8(vnx[p], v); else unpack8(vraw[p], v);
                const float mu = stat[2 * sr], rstd = stat[2 * sr + 1];
#pragma unroll
                for (int q = 0; q < 8; ++q) v[q] = (v[q] - mu) * rstd * g8[q] + b8[q];
                u32x2 lo, hi; lo.x = pk2(v[0], v[1]); lo.y = pk2(v[2], v[3]); hi.x = pk2(v[4], v[5]); hi.y = pk2(v[6], v[7]);
                *(LAS u32x2*)(buf + sr * MIX_PITCH + (32 * cgrp + 4 * ca) * 2) = lo; *(LAS u32x2*)(buf + sr * MIX_PITCH + (32 * cgrp + 16 + 4 * ca) * 2) = hi; }
            __syncthreads();
            if ((h & 1) == 0 && h + 2 < NH) {
#pragma unroll
                for (int p = 0; p < 4; ++p) { vraw[p] = __builtin_nontemporal_load((const u32x4*)(V + (size_t)(row0 + srow + 32 * p) * D + (h + 2) * 128 + 8 * ch));
                    vn2[p] = __builtin_nontemporal_load((const u32x4*)(V + (size_t)(row0 + srow + 32 * p) * D + (h + 3) * 128 + 8 * ch)); } }
            f32x4 acc[2][4];
#pragma unroll
            for (int m = 0; m < 2; ++m)
#pragma unroll
                for (int n = 0; n < 4; ++n) acc[m][n] = (f32x4){0.f, 0.f, 0.f, 0.f};
            const int q4 = (lane & 15) >> 2, p4 = lane & 3;
#pragma unroll
            for (int kk = 0; kk < 4; ++kk) {
                if (kk <= wt) {
#pragma unroll
                    for (int n = 0; n < 4; ++n) {
                        const int colpos = 32 * (2 * wd + (n >> 1)) + 16 * (n & 1);
                        LAS unsigned char* base = buf + (32 * kk + 8 * fq + q4) * MIX_PITCH + colpos * 2 + 8 * p4;
                        const s16x4 t0 = __builtin_amdgcn_ds_read_tr16_b64_v4i16((LAS s16x4*)base);
                        const s16x4 t1 = __builtin_amdgcn_ds_read_tr16_b64_v4i16((LAS s16x4*)(base + 4 * MIX_PITCH));
                        bf16x8 bfrag; bfrag[0] = t0[0]; bfrag[1] = t0[1]; bfrag[2] = t0[2]; bfrag[3] = t0[3]; bfrag[4] = t1[0]; bfrag[5] = t1[1]; bfrag[6] = t1[2]; bfrag[7] = t1[3];
#pragma unroll
                        for (int m = 0; m < 2; ++m) acc[m][n] = __builtin_amdgcn_mfma_f32_16x16x32_bf16(bfrag, af[kk][m], acc[m][n], 0, 0, 0);
                    }
                }
            }
#pragma unroll
            for (int m = 0; m < 2; ++m) { const int t = 32 * wt + 16 * m + fr;
#pragma unroll
                for (int cc = 0; cc < 2; ++cc) { const int col = h * 128 + 32 * (2 * wd + cc) + 8 * fq; float u8[8], o8[8];
                    unpack8(uraw[m][cc], u8);
#pragma unroll
                    for (int n = 0; n < 2; ++n)
#pragma unroll
                        for (int r = 0; r < 4; ++r) o8[4 * n + r] = u8[4 * n + r] * (acc[m][2 * cc + n][r] + bsv[m]);
                    *(u32x4*)(YM + (size_t)(row0 + t) * D + col) = pack8(o8); } }
            if (h & 1) {
#pragma unroll
                for (int p = 0; p < 4; ++p) vnx[p] = vn2[p]; }
        }
        __syncthreads();
    }
}

#define XB_TMO      128
#define XB_XCNT(j)  (256  + 64 * (j))
#define XB_XSUB(j)  (1280 + 64 * (j))
#define XB_XGEN(j)  (2304 + 64 * (j))
#define XB_TOP      3328
#define XB_TOPGEN   3392
#define XCD_BAR_WORDS 3456
#define XB_SPIN_CAP (1u << 22)
__device__ __forceinline__ unsigned xb_ld(unsigned* p)              { return __hip_atomic_load(p, __ATOMIC_RELAXED, __HIP_MEMORY_SCOPE_AGENT); }
__device__ __forceinline__ unsigned xb_add(unsigned* p, unsigned v) { return __hip_atomic_fetch_add(p, v, __ATOMIC_RELAXED, __HIP_MEMORY_SCOPE_AGENT); }
__device__ __forceinline__ unsigned xb_xcc_id() { return (unsigned)__builtin_amdgcn_s_getreg((3 << 11) | 20) & 0xFu; }
#define XB_SPIN(cond, bar) do { unsigned _sp = 0; while (cond) { __builtin_amdgcn_s_sleep(1); \
    if ((++_sp & 255u) == 0u) { if (xb_ld(&(bar)[XB_TMO])) break; if (_sp > XB_SPIN_CAP) { atomicAdd(&(bar)[XB_TMO], 1u); break; } } } } while (0)
struct XcdBarrier { unsigned* bar; unsigned x; volatile LAS unsigned* st; };
__device__ __forceinline__ XcdBarrier xcd_barrier_post(unsigned* bar, volatile LAS unsigned* st) {
    XcdBarrier b; b.bar = bar; b.x = xb_xcc_id(); b.st = st;
    if (threadIdx.x == 0) st[2] = xb_add(&bar[XB_XCNT(b.x)], 1u);
    return b;
}
__device__ __forceinline__ void xcd_barrier_complete(unsigned* bar, unsigned x, unsigned& nloc, unsigned& nx) {
    const unsigned G = gridDim.x * gridDim.y * gridDim.z;
    unsigned sum, cnt, mine, sp = 0u;
    for (;;) {
        sum = 0u; cnt = 0u; mine = 0u;
#pragma unroll
        for (unsigned j = 0; j < 16; ++j) { const unsigned c = xb_ld(&bar[XB_XCNT(j)]); sum += c; cnt += (c > 0u) ? 1u : 0u; mine = (j == x) ? c : mine; }
        if (sum == G) break;
        __builtin_amdgcn_s_sleep(1);
        if ((++sp & 255u) == 0u) { if (xb_ld(&bar[XB_TMO])) break; if (sp > XB_SPIN_CAP) { atomicAdd(&bar[XB_TMO], 1u); break; } }
    }
    nloc = mine > 0u ? mine : 1u; nx = cnt > 0u ? cnt : 1u;
}
__device__ __forceinline__ void xcd_barrier(const XcdBarrier& b) {
    asm volatile("s_waitcnt vmcnt(0)" ::: "memory");
    __syncthreads();
    if (threadIdx.x == 0) {
        unsigned* bar = b.bar;
        __builtin_amdgcn_s_waitcnt(0);
        unsigned nloc = b.st[0], nx = b.st[1];
        if (nloc == 0u) { xcd_barrier_complete(bar, b.x, nloc, nx); b.st[0] = nloc; b.st[1] = nx; }
        const unsigned old = xb_add(&bar[XB_XSUB(b.x)], 1u);
        const unsigned gen = old / nloc;
        if (old + 1u == (gen + 1u) * nloc) {
            __builtin_amdgcn_fence(__ATOMIC_RELEASE, "agent");
            asm volatile("s_waitcnt vmcnt(0)" ::: "memory");
            const unsigned og = xb_add(&bar[XB_TOP], 1u);
            const unsigned tg = og / nx;
            if (og + 1u == (tg + 1u) * nx) xb_add(&bar[XB_TOPGEN], 1u);
            else XB_SPIN(xb_ld(&bar[XB_TOPGEN]) == tg, bar);
            __builtin_amdgcn_fence(__ATOMIC_ACQUIRE, "agent");
            asm volatile("s_waitcnt vmcnt(0)" ::: "memory");
            xb_add(&bar[XB_XGEN(b.x)], 1u);
            asm volatile("s_waitcnt vmcnt(0)" ::: "memory");
        } else {
            __builtin_amdgcn_fence(__ATOMIC_ACQUIRE, "agent");
            XB_SPIN(xb_ld(&bar[XB_XGEN(b.x)]) == gen, bar);
            asm volatile("s_waitcnt vmcnt(0)" ::: "memory");
        }
    }
    __syncthreads();
}

struct BarTok { unsigned gen, role, tg; };
__device__ __forceinline__ BarTok xcd_barrier_arrive(const XcdBarrier& b) {
    BarTok t; t.gen = 0u; t.role = 0u; t.tg = 0u;
    asm volatile("s_waitcnt vmcnt(0)" ::: "memory");
    __syncthreads();
    if (threadIdx.x == 0) {
        unsigned* bar = b.bar;
        __builtin_amdgcn_s_waitcnt(0);
        unsigned nloc = b.st[0], nx = b.st[1];
        if (nloc == 0u) { xcd_barrier_complete(bar, b.x, nloc, nx); b.st[0] = nloc; b.st[1] = nx; }
        const unsigned old = xb_add(&bar[XB_XSUB(b.x)], 1u);
        t.gen = old / nloc;
        if (old + 1u == (t.gen + 1u) * nloc) {
            __builtin_amdgcn_fence(__ATOMIC_RELEASE, "agent");
            asm volatile("s_waitcnt vmcnt(0)" ::: "memory");
            const unsigned og = xb_add(&bar[XB_TOP], 1u);
            t.tg = og / nx;
            if (og + 1u == (t.tg + 1u) * nx) { xb_add(&bar[XB_TOPGEN], 1u); t.role = 2u; } else t.role = 1u;
        } else __builtin_amdgcn_fence(__ATOMIC_ACQUIRE, "agent");
    }
    return t;
}
__device__ __forceinline__ void xcd_barrier_wait(const XcdBarrier& b, const BarTok t) {
    asm volatile("s_waitcnt vmcnt(0)" ::: "memory");
    __syncthreads();
    if (threadIdx.x == 0) {
        unsigned* bar = b.bar;
        if (t.role != 0u) {
            if (t.role == 1u) XB_SPIN(xb_ld(&bar[XB_TOPGEN]) == t.tg, bar);
            __builtin_amdgcn_fence(__ATOMIC_ACQUIRE, "agent");
            asm volatile("s_waitcnt vmcnt(0)" ::: "memory");
            xb_add(&bar[XB_XGEN(b.x)], 1u);
            asm volatile("s_waitcnt vmcnt(0)" ::: "memory");
        } else {
            XB_SPIN(xb_ld(&bar[XB_XGEN(b.x)]) == t.gen, bar);
            asm volatile("s_waitcnt vmcnt(0)" ::: "memory");
        }
    }
    __syncthreads();
}

#define XB_LSUB(j)  (3520 + 64 * (j))
#define XB_LGEN(j)  (4544 + 64 * (j))
__device__ __forceinline__ void xcd_local_barrier(const XcdBarrier& b, const unsigned nloc) {
    asm volatile("s_waitcnt vmcnt(0)" ::: "memory");
    __syncthreads();
    if (threadIdx.x == 0) {
        unsigned* bar = b.bar;
        __builtin_amdgcn_s_waitcnt(0);
        const unsigned old = xb_add(&bar[XB_LSUB(b.x)], 1u);
        const unsigned gen = old / nloc;
        __builtin_amdgcn_fence(__ATOMIC_ACQUIRE, "agent");
        if (old + 1u == (gen + 1u) * nloc) xb_add(&bar[XB_LGEN(b.x)], 1u);
        else XB_SPIN(xb_ld(&bar[XB_LGEN(b.x)]) == gen, bar);
        asm volatile("s_waitcnt vmcnt(0)" ::: "memory");
    }
    __syncthreads();
}

__device__ __forceinline__ BarTok xcd_local_arrive(const XcdBarrier& b, const unsigned nloc) {
    BarTok t; t.gen = 0u; t.role = 0u; t.tg = 0u;
    asm volatile("s_waitcnt vmcnt(0)" ::: "memory");
    __syncthreads();
    if (threadIdx.x == 0) {
        unsigned* bar = b.bar;
        __builtin_amdgcn_s_waitcnt(0);
        const unsigned old = xb_add(&bar[XB_LSUB(b.x)], 1u);
        t.gen = old / nloc;
        __builtin_amdgcn_fence(__ATOMIC_ACQUIRE, "agent");
        if (old + 1u == (t.gen + 1u) * nloc) { xb_add(&bar[XB_LGEN(b.x)], 1u); t.role = 1u; }
    }
    return t;
}
__device__ __forceinline__ void xcd_local_wait(const XcdBarrier& b, const BarTok t) {
    asm volatile("s_waitcnt vmcnt(0)" ::: "memory");
    __syncthreads();
    if (threadIdx.x == 0) {
        unsigned* bar = b.bar;
        if (t.role == 0u) XB_SPIN(xb_ld(&bar[XB_LGEN(b.x)]) == t.gen, bar);
        asm volatile("s_waitcnt vmcnt(0)" ::: "memory");
    }
    __syncthreads();
}

#define GSYNC() xcd_barrier(xbar)
#define GSYNC_FILL(pa, layer, r0, nr) do { const BarTok tk_ = xcd_barrier_arrive(xbar); prep_rounds(lds, (pa), (layer), (r0), (nr)); xcd_barrier_wait(xbar, tk_); } while (0)
struct Params { const float* in[22]; float* out; unsigned char* ws; int sep1; int pad; };
__global__ void __launch_bounds__(NT, 2) mega_fwd(Params P) {
    extern __shared__ __attribute__((aligned(16))) unsigned char lds_raw[];
    LAS unsigned char* lds = (LAS unsigned char*)lds_raw;
    cg::grid_group grid = cg::this_grid();
    const int G = (int)gridDim.x, bid = (int)blockIdx.x;
    if (P.ws == nullptr) grid.sync();
    if (threadIdx.x < 4) ((LAS unsigned*)(lds + BARST_OFF))[threadIdx.x] = 0u;
    __syncthreads();
    const XcdBarrier xbar = xcd_barrier_post((unsigned*)(P.ws + WS_CTL) + CW_BAR, (volatile LAS unsigned*)(lds + BARST_OFF));
    const float* x = P.in[0]; const float* ln_a = P.in[1]; const float* w_in_a = P.in[2]; const float* conv_w = P.in[3];
    const float* w_out_a = P.in[4]; const float* ln_b = P.in[5]; const float* w_in_b = P.in[6]; const float* b_in_b = P.in[7];
    const float* v_ln_g = P.in[8]; const float* v_ln_b = P.in[9]; const float* w_s = P.in[10]; const float* b_s = P.in[11];
    const float* w_out_b = P.in[12]; const float* ln2 = P.in[13]; const float* w_group = P.in[14]; const float* b_group = P.in[15];
    const float* w_expert = P.in[16]; const float* b_expert = P.in[17]; const float* w_gate = P.in[18]; const float* w_up = P.in[19];
    const float* w_down = P.in[20]; const float* ln_f = P.in[21];
    unsigned char* ws = P.ws; float* out = P.out;
    unsigned* ctl = (unsigned*)(ws + WS_CTL); float* RS = (float*)(ws + WS_RS); unsigned* ASG = (unsigned*)(ws + WS_ASG); float* LNS = (float*)(ws + WS_LNS);
    int* LTOK = (int*)(ws + WS_LTOK); float* LGATE = (float*)(ws + WS_LGATE); float* LRS = (float*)(ws + WS_LRS); bf16_t* WR = (bf16_t*)(ws + WS_WR); bf16_t* WM = (bf16_t*)(ws + WS_WM);
    bf16_t* WA_IN = (bf16_t*)(ws + WS_WA_IN); bf16_t* WA_OUT = (bf16_t*)(ws + WS_WA_OUT); bf16_t* WB_IN = (bf16_t*)(ws + WS_WB_IN); bf16_t* WB_OUT = (bf16_t*)(ws + WS_WB_OUT);
    unsigned char* WGU = ws + WS_WGU; unsigned char* WD = ws + WS_WD; unsigned char* XQ = ws + WS_XQ;
    bf16_t* bufA = (bf16_t*)(ws + WS_A); bf16_t* bufB = (bf16_t*)(ws + WS_B); bf16_t* bufC = (bf16_t*)(ws + WS_C); bf16_t* bufD = (bf16_t*)(ws + WS_D);

    int vb = bid; bool loc = false; unsigned nloc = 1u;
    Part part{0, T, bid, G};
#define DENSE_GEMM(EPI_T, epi_init, Aptr, Bptr, NCOLS) do { DenseSched S{T / BM, (NCOLS) / BM, G, vb, D, (Bptr)}; EPI_T E epi_init; gemm_phase<EPI_T, DenseSched>(lds, (Aptr), D, S, E); } while (0)
#define LSYNC() do { if (loc) xcd_local_barrier(xbar, nloc); else xcd_barrier(xbar); } while (0)
#define LSYNC_FILL(pa, layer, r0, nr) do { const BarTok tk_ = loc ? xcd_local_arrive(xbar, nloc) : xcd_barrier_arrive(xbar); prep_rounds(lds, (pa), (layer), (r0), (nr)); \
        if (loc) xcd_local_wait(xbar, tk_); else xcd_barrier_wait(xbar, tk_); } while (0)
#define MOE_PHASES(layer, Xin, Hb, WGUp, WDp, FILL_A, FILL_B) do { \
        unsigned* cnt_ = ctl + CW_CNT + (layer) * NE; \
        ph_route(part, lds, (Xin), WR + (size_t)(layer) * 2 * 48 * D, b_group + (layer) * NG, b_expert + (layer) * NE, cnt_, ASG, LTOK, LGATE, LRS); \
        FILL_A; \
        { const int ntm = build_tile_table(lds, cnt_); \
          { MoeSched<true> S{ntm, G, vb, D / 2, (WGUp), LTOK, (const LAS int*)(lds + TAB_OFF), LRS}; EpiG3 E{LRS, (unsigned char*)(Hb)}; gemm_phase<EpiG3, MoeSched<true>, true>(lds, (const bf16_t*)XQ, D / 2, S, E); } \
          LSYNC();                                                            \
          { MoeSched<false> S{ntm, G, vb, F / 2, (WDp), LTOK, (const LAS int*)(lds + TAB_OFF), LGATE}; EpiG4 E{LGATE, (unsigned char*)bufA}; gemm_phase<EpiG4, MoeSched<false>, true>(lds, (const bf16_t*)(Hb), F / 2, S, E); } } \
        FILL_B; } while (0)

    ph_prep_x(x, ln_a, bufB, RS);
    ph_transpose<false>(lds, w_in_a, D, 3 * D, WA_IN, 1, nullptr, 1, 0, 0, 0);
    ph_transpose<false>(lds, w_out_a, D, D, WA_OUT, 0, nullptr, 1, 0, 0, 768);
    ph_transpose<false>(lds, w_in_b, D, 2 * D, WB_IN, 0, ln_b, 1, 0, 0, 1024);
    ph_transpose<false>(lds, w_out_b, D, D, WB_OUT, 0, nullptr, 1, 0, 0, 1536);
    ph_prep_router(ln2, w_group, w_expert, WR);
    ph_prep_wm(w_s, WM);
    const bool sep1 = P.sep1 != 0;
    unsigned char* WGU1 = sep1 ? ws + WS_WGU1 : WGU; unsigned char* WD1 = sep1 ? ws + WS_WD1 : WD;
    const PrepArgs pa0{w_gate, w_up, w_down, ln2, WGU, WD}, pa1{w_gate, w_up, w_down, ln2, WGU1, WD1};
    GSYNC_FILL(pa0, 0, 0, 2);
    {
        unsigned okc = 0u, bad = 0u;
#pragma unroll
        for (unsigned j = 0; j < 16; ++j) { const unsigned cn = xb_ld((unsigned*)(ws + WS_CTL) + CW_BAR + XB_XCNT(j)); if (cn == 32u && j < 8u) ++okc; else if (cn != 0u) ++bad; }
        const unsigned rank = ((volatile LAS unsigned*)(lds + BARST_OFF))[2];
        loc = (G == 256) && (okc == 8u) && (bad == 0u) && (xbar.x < 8u) && (rank < 32u);
        if (loc) { vb = (int)(rank * 8u + xbar.x); nloc = 32u; part = Part{(vb & 7) * SEQ, SEQ, vb >> 3, 32}; }
    }
    if (G == 256) {
        G1FSched S{G, vb, D, WA_IN, nullptr, nullptr}; EpiG1F E{bufA, bufC, bufA + (size_t)T * D, conv_w}; gemm_phase<EpiG1F, G1FSched>(lds, bufB, D, S, E);
        LSYNC_FILL(pa0, 0, 2, 2);
        { Unit u0, u1; DenseSched S2{T / BM, D / BM, G, vb, D, WA_OUT};
          if (S2.next(0, u0)) { patch_panel_rows(u0.pm, bufA, bufA + (size_t)T * D, conv_w, bufC); if (S2.next(1, u1) && u1.pm != u0.pm) patch_panel_rows(u1.pm, bufA, bufA + (size_t)T * D, conv_w, bufC); }
          asm volatile("s_waitcnt vmcnt(0)" ::: "memory"); __syncthreads(); }
    } else {
        DENSE_GEMM(EpiG1, {bufA}, bufB, WA_IN, 3 * D);
        LSYNC_FILL(pa0, 0, 2, 2);
        ph_conv(part, bufA, conv_w, bufC);
        LSYNC();
    }
    DENSE_GEMM(EpiRes<true>, ({bufB, bufD, XQ, RS, ln_a}), bufC, WA_OUT, D);
    LSYNC_FILL(pa0, 0, 4, 2);
    MOE_PHASES(0, bufD, bufB, WGU, WD, GSYNC_FILL(pa1, 1, 0, sep1 ? 2 : 0), GSYNC_FILL(pa1, 1, 2, sep1 ? 2 : 0));
    if (!sep1) prep_rounds(lds, pa1, 1, 0, 4);
    ph_combine<false>(part, bufD, (const unsigned char*)bufA, ctl + CW_CNT, ASG, bufC, RS, nullptr, nullptr);
    LSYNC_FILL(pa1, 1, 4, 1);
    DENSE_GEMM(EpiG5, ({RS, b_in_b, bufA + (size_t)T * D, bufB, (f32x2*)(ws + WS_LNP)}), bufC, WB_IN, 2 * D);
    LSYNC();
    ph_mix(part, lds, bufA + (size_t)T * D, bufB, (const f32x2*)(ws + WS_LNP), v_ln_g, v_ln_b, WM, b_s, bufD);
    LSYNC_FILL(pa1, 1, 5, 1);
    DENSE_GEMM(EpiRes<false>, ({bufC, bufB, XQ, nullptr, nullptr}), bufD, WB_OUT, D);
    LSYNC();
    MOE_PHASES(1, bufB, bufC, WGU1, WD1, GSYNC(), GSYNC());
    ph_combine<true>(part, bufB, (const unsigned char*)bufA, ctl + CW_CNT + NE, ASG, nullptr, nullptr, ln_f, out);
}
}

extern "C" void kernel_launch(void* const* d_in, const int* in_sizes, int n_in, void* d_out, int out_size, void* d_ws, size_t ws_size, hipStream_t stream) {
    if (n_in != 22 || ws_size < WS_END) { fprintf(stderr, "kernel_launch: unexpected n_in %d / ws_size %zu\n", n_in, ws_size); return; }
    static int grid_blocks = 0;
    if (!grid_blocks) {
        int dev = 0, cus = 0, per_cu = 0;
        (void)hipGetDevice(&dev);
        (void)hipDeviceGetAttribute(&cus, hipDeviceAttributeMultiprocessorCount, dev);
        (void)hipFuncSetAttribute((const void*)mega_fwd, hipFuncAttributeMaxDynamicSharedMemorySize, LDS_BYTES);
        (void)hipOccupancyMaxActiveBlocksPerMultiprocessor(&per_cu, (const void*)mega_fwd, NT, LDS_BYTES);
        if (per_cu < 1) fprintf(stderr, "kernel_launch: occupancy query says %d blocks per CU\n", per_cu);
        grid_blocks = cus;
    }
    (void)hipMemsetAsync((unsigned char*)d_ws + WS_CTL, 0, CTL_BYTES, stream);
    Params p{};
    p.sep1 = ws_size >= WS_END2 ? 1 : 0; p.pad = 0;
    for (int i = 0; i < 22; ++i) p.in[i] = (const float*)d_in[i];
    p.out = (float*)d_out; p.ws = (unsigned char*)d_ws;
    void* args[] = {&p};
    hipError_t e = hipLaunchCooperativeKernel((const void*)mega_fwd, dim3(grid_blocks), dim3(NT), args, LDS_BYTES, stream);
    if (e != hipSuccess) fprintf(stderr, "cooperative launch failed: %s (grid %d)\n", hipGetErrorString(e), grid_blocks);
}
```
